# Optimizing an MI355X kernel written in HIP

```python
import math
import jax, jax.numpy as jnp
from jax import lax
import numpy as np

D_MODEL = 1024
BATCH = 1
SEQ = 16384
DEPTH = 2
DEC_BATCH = 32
DEC_SEQ = 1
PAST_LEN = 16384
PAGE_SIZE = 128

N_EVEN = (DEPTH + 1) // 2
N_ODD = DEPTH // 2
D_FF = 4 * D_MODEL
PLE_DIM = 256
LRU_WIDTH = D_MODEL // 2
LRU_BLOCKS = 8
LRU_BW = LRU_WIDTH // LRU_BLOCKS
CONV_W = 4
RG_C = 8.0
NSA_HEADS = 8
HEAD_DIM = 64
KV_GROUPS = 2
HPG = NSA_HEADS // KV_GROUPS
CMP_BLOCK = 32
SEL_BLOCK = 64
TOP_N = 16
WINDOW = 512
Q_BLOCK = 128
FORCE_SCORE = 1.0e4
N_BUCKETS = 32
MAX_DIST = 128
CHUNK = 128
SGU_WIDTH = D_MODEL
SGU_GROUPS = 8
SGU_GW = SGU_WIDTH // SGU_GROUPS
Q_W = NSA_HEADS * HEAD_DIM
KV_W = KV_GROUPS * HEAD_DIM
EVEN_SPLITS = (LRU_WIDTH, LRU_WIDTH, Q_W, 6 * KV_W, 3 * NSA_HEADS)
EVEN_IN = sum(EVEN_SPLITS)
EPS = 1e-6
NEG = -1e30

kernel_name = 'hybrid_rglru_nsa_gmlp_decode_step'


def rmsnorm(x, g):
    xf = x.astype(jnp.float32)
    return xf * lax.rsqrt(jnp.mean(xf * xf, axis=-1, keepdims=True) + EPS) * g


def layernorm(x, g, b):
    xf = x.astype(jnp.float32)
    mu = jnp.mean(xf, axis=-1, keepdims=True)
    xc = xf - mu
    return xc * lax.rsqrt(jnp.mean(xc * xc, axis=-1, keepdims=True) + EPS) * g + b


def masked_softmax(s, mask):
    s = jnp.where(mask, s.astype(jnp.float32), NEG)
    return jnp.where(mask, jax.nn.softmax(s, axis=-1), 0.0)


def t5_bucket(dist):
    n = jnp.maximum(dist, 0)
    exact = N_BUCKETS // 2
    nf = jnp.maximum(n, 1).astype(jnp.float32)
    large = exact + (jnp.log(nf / exact) / math.log(MAX_DIST / exact) * (N_BUCKETS - exact)).astype(jnp.int32)
    return jnp.where(n < exact, n, jnp.minimum(large, N_BUCKETS - 1))


def pad_rows(x, mult):
    extra = (-x.shape[1]) % mult
    pad = [(0, 0)] * x.ndim
    pad[1] = (0, extra)
    return jnp.pad(x, pad)


def tail_rows(x, n):
    t = x.shape[1]
    if t >= n:
        return x[:, t - n:]
    pad = [(0, 0)] * x.ndim
    pad[1] = (n - t, 0)
    return jnp.pad(x, pad)


def even_project(hn, w_in, q_gain, k_gain):
    B, T, _ = hn.shape
    z = hn @ w_in
    cuts = [int(c) for c in np.cumsum(EVEN_SPLITS)[:-1]]
    xa, ga, q, kv, gl = jnp.split(z, cuts, axis=-1)
    q = rmsnorm(q.reshape(B, T, NSA_HEADS, HEAD_DIM), q_gain)
    kv = kv.reshape(B, T, 6, KV_GROUPS, HEAD_DIM)
    k_cmp, v_cmp = kv[:, :, 0], kv[:, :, 1]
    k_sel, v_sel = rmsnorm(kv[:, :, 2], k_gain[1]), kv[:, :, 3]
    k_win, v_win = rmsnorm(kv[:, :, 4], k_gain[2]), kv[:, :, 5]
    gates = jax.nn.sigmoid(gl.reshape(B, T, NSA_HEADS, 3).astype(jnp.float32))
    kv_rows = jnp.stack([k_cmp.astype(jnp.float32), v_cmp.astype(jnp.float32), k_sel, v_sel.astype(jnp.float32)], axis=2)
    win_rows = jnp.stack([k_win, v_win.astype(jnp.float32)], axis=2)
    return xa, ga, q, gates, kv_rows, win_rows


def rglru_mixer(xa, conv_state, h0, conv_w, conv_b, w_a, b_a, w_x, b_x, lam):
    B, T, C = xa.shape
    xf = jnp.concatenate([conv_state.astype(jnp.float32), xa.astype(jnp.float32)], axis=1)
    conv = conv_b.astype(jnp.float32)
    for k in range(CONV_W):
        conv = conv + conv_w[k] * xf[:, k:k + T]
    new_conv = xf[:, T:]
    xb = conv.reshape(B, T, LRU_BLOCKS, LRU_BW)
    r = jax.nn.sigmoid(jnp.einsum('btnc,ncd->btnd', xb, w_a).reshape(B, T, C) + b_a)
    i = jax.nn.sigmoid(jnp.einsum('btnc,ncd->btnd', xb, w_x).reshape(B, T, C) + b_x)
    log_a = -RG_C * r * jax.nn.softplus(-lam.astype(jnp.float32))
    a = jnp.exp(log_a)
    b = jnp.sqrt(-jnp.expm1(2.0 * log_a)) * (i * conv)

    def step(h, ab):
        h = ab[0] * h + ab[1]
        return h, h

    h_last, hs = lax.scan(step, h0.astype(jnp.float32), (a.swapaxes(0, 1), b.swapaxes(0, 1)))
    return hs.swapaxes(0, 1), new_conv, h_last


def compress(k_raw, pe, w):
    B, Tp, G, D = k_raw.shape
    nc = Tp // CMP_BLOCK
    blk = k_raw.reshape(B, nc, CMP_BLOCK, G, D) + pe[:, None, :]
    blk = blk.transpose(0, 1, 3, 2, 4).reshape(B, nc, G, CMP_BLOCK * D)
    return blk @ w


def nsa_keys(kv_rows, cmp_w_k, cmp_w_v, pe_k, pe_v, k_gain_cmp):
    kv = pad_rows(kv_rows, SEL_BLOCK)
    B, Tp = kv.shape[:2]
    kc = rmsnorm(compress(kv[:, :, 0], pe_k, cmp_w_k), k_gain_cmp)
    vc = compress(kv[:, :, 1], pe_v, cmp_w_v)
    nsb = Tp // SEL_BLOCK
    ksb = kv[:, :, 2].reshape(B, nsb, SEL_BLOCK, KV_GROUPS, HEAD_DIM).transpose(0, 3, 1, 2, 4)
    vsb = kv[:, :, 3].reshape(B, nsb, SEL_BLOCK, KV_GROUPS, HEAD_DIM).transpose(0, 3, 1, 2, 4)
    return kc, vc, ksb, vsb


def nsa_core(q, qpos, kc, vc, ksb, vsb, kw, vw, wpos, gates, rel_bias):
    B, Tq = q.shape[:2]
    scale = HEAD_DIM ** -0.5
    qg = q.reshape(B, Tq, KV_GROUPS, HPG, HEAD_DIM)
    table = rel_bias.astype(jnp.float32)
    ncb = kc.shape[1]
    cend = jnp.arange(ncb, dtype=jnp.int32) * CMP_BLOCK + (CMP_BLOCK - 1)
    dist_c = qpos[:, None] - cend[None, :]
    bias_c = table[t5_bucket(dist_c)].reshape(Tq, ncb, KV_GROUPS, HPG).transpose(0, 2, 3, 1)
    s_c = jnp.einsum('btgrd,bjgd->btgrj', qg, kc) * scale + bias_c
    p_c = masked_softmax(s_c, (dist_c >= 0)[:, None, None, :])
    o_c = jnp.einsum('btgrj,bjgd->btgrd', p_c, vc)
    nsb = ksb.shape[2]
    ratio = SEL_BLOCK // CMP_BLOCK
    imp = p_c.sum(axis=3).reshape(B, Tq, KV_GROUPS, nsb, ratio).sum(-1)
    jb = jnp.arange(nsb, dtype=jnp.int32)[None, :]
    cur = (qpos // SEL_BLOCK)[:, None]
    forced = (jb == 0) | (jb == cur) | (jb == cur - 1)
    imp = jnp.where(forced[None, :, None, :], FORCE_SCORE, imp)
    imp = jnp.where((jb <= cur)[None, :, None, :], imp, -1.0)
    n_sel = min(TOP_N, nsb)
    _, idx = lax.top_k(imp, n_sel)
    bi = jnp.arange(B)[:, None, None, None]
    gi = jnp.arange(KV_GROUPS)[None, None, :, None]
    kg = ksb[bi, gi, idx]
    vg = vsb[bi, gi, idx]
    kpos = idx[..., None] * SEL_BLOCK + jnp.arange(SEL_BLOCK, dtype=jnp.int32)
    dist_s = qpos[None, :, None, None, None] - kpos
    table_g = table.reshape(N_BUCKETS, KV_GROUPS, HPG).transpose(1, 0, 2)
    bias_s = jnp.moveaxis(table_g[gi[..., None], t5_bucket(dist_s)], -1, 3)
    s_s = jnp.einsum('btgrd,btgnsd->btgrns', qg, kg) * scale + bias_s
    nk = n_sel * SEL_BLOCK
    p_s = masked_softmax(s_s.reshape(B, Tq, KV_GROUPS, HPG, nk),
                         (dist_s >= 0).reshape(B, Tq, KV_GROUPS, 1, nk))
    o_s = jnp.einsum('btgrk,btgkd->btgrd', p_s, vg.reshape(B, Tq, KV_GROUPS, nk, HEAD_DIM))
    lw = kw.shape[1]
    dist_w = qpos[:, None] - wpos[None, :]
    bias_w = table[t5_bucket(dist_w)].reshape(Tq, lw, KV_GROUPS, HPG).transpose(0, 2, 3, 1)
    mask_w = (wpos[None, :] >= 0) & (dist_w >= 0) & (dist_w < WINDOW)
    s_w = jnp.einsum('btgrd,blgd->btgrl', qg, kw) * scale + bias_w
    p_w = masked_softmax(s_w, mask_w[:, None, None, :])
    o_w = jnp.einsum('btgrl,blgd->btgrd', p_w, vw)
    g = gates.reshape(B, Tq, KV_GROUPS, HPG, 3)
    o = g[..., 0:1] * o_c + g[..., 1:2] * o_s + g[..., 2:3] * o_w
    return o.reshape(B, Tq, Q_W)


def even_mixer(hn, lp, rel_bias, past_kv, past_win, conv_state, h0, blocked):
    B, T, _ = hn.shape
    xa, ga, q, gates, kv_rows, win_rows = even_project(hn, lp['w_in'], lp['q_gain'], lp['k_gain'])
    y_a, new_conv, h_last = rglru_mixer(xa, conv_state, h0, lp['conv_w'], lp['conv_b'], lp['w_a'],
                                        lp['b_a'], lp['w_x'], lp['b_x'], lp['lam'])
    y_a = y_a * jax.nn.gelu(ga.astype(jnp.float32))
    w_buf = min(WINDOW, PAST_LEN)
    if past_kv is None:
        full_kv, full_w, pos0, wpos0 = kv_rows, win_rows, 0, 0
    else:
        full_kv = jnp.concatenate([past_kv.astype(jnp.float32), kv_rows], axis=1)
        full_w = jnp.concatenate([past_win.astype(jnp.float32), win_rows], axis=1)
        pos0, wpos0 = PAST_LEN, PAST_LEN - w_buf
    kc, vc, ksb, vsb = nsa_keys(full_kv, lp['cmp_w_k'], lp['cmp_w_v'], lp['pe_k'], lp['pe_v'], lp['k_gain'][0])
    if blocked:
        wpad = jnp.pad(full_w, ((0, 0), (WINDOW, 0), (0, 0), (0, 0), (0, 0)))
        nqb = T // Q_BLOCK

        def block(args):
            qb, gb, qs = args
            wr = lax.dynamic_slice_in_dim(wpad, qs, WINDOW + Q_BLOCK, axis=1)
            wpos = wpos0 - WINDOW + qs + jnp.arange(WINDOW + Q_BLOCK, dtype=jnp.int32)
            qpos = pos0 + qs + jnp.arange(Q_BLOCK, dtype=jnp.int32)
            return nsa_core(qb, qpos, kc, vc, ksb, vsb, wr[:, :, 0], wr[:, :, 1], wpos, gb, rel_bias)

        qbs = q.reshape(B, nqb, Q_BLOCK, NSA_HEADS, HEAD_DIM).swapaxes(0, 1)
        gbs = gates.reshape(B, nqb, Q_BLOCK, NSA_HEADS, 3).swapaxes(0, 1)
        starts = jnp.arange(nqb, dtype=jnp.int32) * Q_BLOCK
        y_b = lax.map(block, (qbs, gbs, starts)).swapaxes(0, 1).reshape(B, T, Q_W)
    else:
        wpos = wpos0 + jnp.arange(full_w.shape[1], dtype=jnp.int32)
        qpos = pos0 + jnp.arange(T, dtype=jnp.int32)
        y_b = nsa_core(q, qpos, kc, vc, ksb, vsb, full_w[:, :, 0], full_w[:, :, 1], wpos, gates, rel_bias)
    out = jnp.concatenate([y_a, y_b.astype(jnp.float32)], axis=-1) @ lp['w_out']
    return out, (kv_rows, tail_rows(full_w, w_buf), new_conv, h_last)


def chunk_gmlp(hn, w_in, ln_g, ln_b, sgu_w, sgu_b, w_out):
    B, T, _ = hn.shape
    z = jax.nn.gelu(hn @ w_in)
    u, v = jnp.split(z, 2, axis=-1)
    vn = layernorm(v, ln_g, ln_b)
    vp = pad_rows(vn, CHUNK)
    nch = vp.shape[1] // CHUNK
    vc = vp.reshape(B, nch, CHUNK, SGU_GROUPS, SGU_GW)
    ws = sgu_w * jnp.tril(jnp.ones((CHUNK, CHUNK), sgu_w.dtype))
    s = jnp.einsum('gts,bcsgd->bctgd', ws, vc) + sgu_b.T[:, :, None]
    s = s.reshape(B, nch * CHUNK, SGU_WIDTH)[:, :T]
    return (u * s) @ w_out, vn


def channel_and_ple(h, p, g_mlp, w_up, w_down, g_ple, w_gate, w_proj):
    h = h + jnp.square(jax.nn.relu(rmsnorm(h, g_mlp) @ w_up)) @ w_down
    gate = jax.nn.sigmoid(rmsnorm(h, g_ple) @ w_gate)
    return h + gate * (p @ w_proj)


def setup_inputs(seed: int = 0) -> dict:
    key = jax.random.key(seed)
    keys = jax.random.split(key, 64)
    ctr = iter(range(64))

    def nrm(shape, scale):
        return scale * jax.random.normal(keys[next(ctr)], shape, jnp.float32)

    n_pages = PAST_LEN // PAGE_SIZE
    used = DEC_BATCH * n_pages
    n_phys = used + max(1, used // 4)
    w_buf = min(WINDOW, PAST_LEN)
    perm = jax.random.permutation(keys[next(ctr)], n_phys)
    page_table = perm[:used].reshape(DEC_BATCH, n_pages).astype(jnp.int32)
    u = jax.random.uniform(keys[next(ctr)], (N_EVEN, LRU_WIDTH), jnp.float32, 0.9, 0.999)
    rg_lambda = jnp.log(u) - jnp.log1p(-u)
    d = D_MODEL
    return {
        'x_prompt': nrm((BATCH, SEQ, d), 1.0),
        'x_sample': nrm((DEC_BATCH, DEC_SEQ, d), 1.0),
        'cache_kv': nrm((N_EVEN, n_phys, PAGE_SIZE, 4, KV_GROUPS, HEAD_DIM), 1.0),
        'cache_win': nrm((N_EVEN, DEC_BATCH, w_buf, 2, KV_GROUPS, HEAD_DIM), 1.0),
        'state_conv': nrm((N_EVEN, DEC_BATCH, CONV_W - 1, LRU_WIDTH), 1.0),
        'state_h': nrm((N_EVEN, DEC_BATCH, LRU_WIDTH), 0.5),
        'page_table': page_table,
        'p_prompt': nrm((DEPTH, BATCH, SEQ, PLE_DIM), 1.0),
        'p_sample': nrm((DEPTH, DEC_BATCH, DEC_SEQ, PLE_DIM), 1.0),
        'rel_bias': nrm((N_BUCKETS, NSA_HEADS), 0.5),
        'g_mix': 1.0 + nrm((DEPTH, d), 0.02),
        'g_mlp': 1.0 + nrm((DEPTH, d), 0.02),
        'w_up': nrm((DEPTH, d, D_FF), d ** -0.5),
        'w_down': nrm((DEPTH, D_FF, d), D_FF ** -0.5),
        'g_ple': 1.0 + nrm((DEPTH, d), 0.02),
        'w_ple_gate': nrm((DEPTH, d, d), d ** -0.5),
        'w_ple_proj': nrm((DEPTH, PLE_DIM, d), PLE_DIM ** -0.5),
        'w_in_even': nrm((N_EVEN, d, EVEN_IN), d ** -0.5),
        'w_out_even': nrm((N_EVEN, LRU_WIDTH + Q_W, d), (LRU_WIDTH + Q_W) ** -0.5),
        'conv_w': nrm((N_EVEN, CONV_W, LRU_WIDTH), CONV_W ** -0.5),
        'conv_b': nrm((N_EVEN, LRU_WIDTH), 0.01),
        'rg_w_a': nrm((N_EVEN, LRU_BLOCKS, LRU_BW, LRU_BW), LRU_BW ** -0.5),
        'rg_b_a': nrm((N_EVEN, LRU_WIDTH), 0.01),
        'rg_w_x': nrm((N_EVEN, LRU_BLOCKS, LRU_BW, LRU_BW), LRU_BW ** -0.5),
        'rg_b_x': nrm((N_EVEN, LRU_WIDTH), 0.01),
        'rg_lambda': rg_lambda,
        'q_gain': 1.0 + nrm((N_EVEN, HEAD_DIM), 0.02),
        'k_gain': 1.0 + nrm((N_EVEN, 3, HEAD_DIM), 0.02),
        'cmp_w_k': nrm((N_EVEN, CMP_BLOCK * HEAD_DIM, HEAD_DIM), (CMP_BLOCK * HEAD_DIM) ** -0.5),
        'cmp_w_v': nrm((N_EVEN, CMP_BLOCK * HEAD_DIM, HEAD_DIM), (CMP_BLOCK * HEAD_DIM) ** -0.5),
        'cmp_pe_k': nrm((N_EVEN, CMP_BLOCK, HEAD_DIM), 0.1),
        'cmp_pe_v': nrm((N_EVEN, CMP_BLOCK, HEAD_DIM), 0.1),
        'w_in_odd': nrm((N_ODD, d, 2 * SGU_WIDTH), d ** -0.5),
        'ln_v_g': 1.0 + nrm((N_ODD, SGU_WIDTH), 0.02),
        'ln_v_b': nrm((N_ODD, SGU_WIDTH), 0.01),
        'sgu_w': nrm((N_ODD, SGU_GROUPS, CHUNK, CHUNK), CHUNK ** -0.5),
        'sgu_b': 1.0 + nrm((N_ODD, SGU_GROUPS, CHUNK), 0.1),
        'w_out_odd': nrm((N_ODD, SGU_WIDTH, d), SGU_WIDTH ** -0.5),
    }


def reference(x_prompt, x_sample, cache_kv, cache_win, state_conv, state_h, page_table, p_prompt, p_sample,
              rel_bias, g_mix, g_mlp, w_up, w_down, g_ple, w_ple_gate, w_ple_proj,
              w_in_even, w_out_even, conv_w, conv_b, rg_w_a, rg_b_a, rg_w_x, rg_b_x, rg_lambda,
              q_gain, k_gain, cmp_w_k, cmp_w_v, cmp_pe_k, cmp_pe_v,
              w_in_odd, ln_v_g, ln_v_b, sgu_w, sgu_b, w_out_odd):
    n_pages = PAST_LEN // PAGE_SIZE
    hp, hs = x_prompt, x_sample
    kvp, kvs, wnp, wns, cvp, cvs, hhp, hhs, vvs = [], [], [], [], [], [], [], [], []
    for i in range(DEPTH):
        if i % 2 == 0:
            e = i // 2
            lp = {'w_in': w_in_even[e], 'w_out': w_out_even[e], 'conv_w': conv_w[e], 'conv_b': conv_b[e],
                  'w_a': rg_w_a[e], 'b_a': rg_b_a[e], 'w_x': rg_w_x[e], 'b_x': rg_b_x[e], 'lam': rg_lambda[e],
                  'q_gain': q_gain[e], 'k_gain': k_gain[e], 'cmp_w_k': cmp_w_k[e], 'cmp_w_v': cmp_w_v[e],
                  'pe_k': cmp_pe_k[e], 'pe_v': cmp_pe_v[e]}
            bp = hp.shape[0]
            out_p, st_p = even_mixer(rmsnorm(hp, g_mix[i]), lp, rel_bias, None, None,
                                     jnp.zeros((bp, CONV_W - 1, LRU_WIDTH), jnp.float32),
                                     jnp.zeros((bp, LRU_WIDTH), jnp.float32), True)
            past = cache_kv[e, page_table].reshape(DEC_BATCH, n_pages * PAGE_SIZE, 4, KV_GROUPS, HEAD_DIM)
            out_s, st_s = even_mixer(rmsnorm(hs, g_mix[i]), lp, rel_bias, past, cache_win[e],
                                     state_conv[e], state_h[e], False)
            kvp.append(st_p[0]); wnp.append(st_p[1]); cvp.append(st_p[2]); hhp.append(st_p[3])
            kvs.append(st_s[0]); wns.append(st_s[1]); cvs.append(st_s[2]); hhs.append(st_s[3])
        else:
            o = i // 2
            out_p, _ = chunk_gmlp(rmsnorm(hp, g_mix[i]), w_in_odd[o], ln_v_g[o], ln_v_b[o],
                                  sgu_w[o], sgu_b[o], w_out_odd[o])
            out_s, v_new = chunk_gmlp(rmsnorm(hs, g_mix[i]), w_in_odd[o], ln_v_g[o], ln_v_b[o],
                                      sgu_w[o], sgu_b[o], w_out_odd[o])
            vvs.append(v_new)
        hp = channel_and_ple(hp + out_p, p_prompt[i], g_mlp[i], w_up[i], w_down[i], g_ple[i],
                             w_ple_gate[i], w_ple_proj[i])
        hs = channel_and_ple(hs + out_s, p_sample[i], g_mlp[i], w_up[i], w_down[i], g_ple[i],
                             w_ple_gate[i], w_ple_proj[i])
    y_prompt = hp
    y_sample = hs
    kv_rows_prompt = jnp.stack(kvp)
    kv_rows_sample = jnp.stack(kvs)
    win_prompt = jnp.stack(wnp)
    win_sample = jnp.stack(wns)
    conv_prompt = jnp.stack(cvp)
    conv_sample = jnp.stack(cvs)
    h_prompt = jnp.stack(hhp)
    h_sample = jnp.stack(hhs)
    v_sample = jnp.stack(vvs) if vvs else jnp.zeros((0, DEC_BATCH, DEC_SEQ, SGU_WIDTH), jnp.float32)
    return (y_prompt, y_sample, kv_rows_prompt, kv_rows_sample, win_prompt, win_sample,
            conv_prompt, conv_sample, h_prompt, h_sample, v_sample)
```

```cpp
#include <hip/hip_runtime.h>
#include <cstdio>
#include <cstdint>
#define DBG_ZERO_OUT 0
#define DBG_SCALE_MASK 0
namespace pg8 {
#define PG8_LAS __attribute__((address_space(3)))
typedef unsigned short bf16_t;
typedef short bf16x8 __attribute__((ext_vector_type(8)));
typedef float f32x4 __attribute__((ext_vector_type(4)));
typedef unsigned u32x4 __attribute__((ext_vector_type(4)));
constexpr int BM = 256, BK = 64, HALF = 128, HTB = HALF * BK * 2  , STAGE_BYTES = 8 * HTB, NXCD = 8, WGM = 8;

__host__ __device__ __forceinline__ int lds_byte(int r, int c) { const int st = (r >> 4) * 2 + (c >> 5), rr = r & 15, cc = c & 31, ob = rr * 64 + cc * 2; return st * 1024 + (ob ^ (((ob >> 9) & 1) << 5)); }
__host__ __device__ __forceinline__ void stage_rc(int b, int& R, int& C) { const int st = b / 1024, sb = b % 1024, swz = sb ^ (((sb >> 9) & 1) << 5); R = (st >> 1) * 16 + swz / 64; C = (st & 1) * 32 + (swz % 64) / 2; }
__host__ __device__ __forceinline__ int perm32(int rho) { const int n = rho >> 4, i = rho & 15; return 8 * (i >> 2) + 4 * n + (i & 3); }

struct Unit { int pm, pn; };
struct Gemm { const bf16_t* A; const bf16_t* Bt; int M, N, K; };

struct StaticOrder {
    int nM, nN, nwg, G, c;
    __host__ __device__ void init(int M, int N, int G_, int c_) { nM = M / BM; nN = N / BM; nwg = nM * nN; G = G_; c = c_; }
    __host__ __device__ bool next(int i, Unit& u) const {
        const long L = (long)i * G + c; if (L >= nwg) return false;
        int wgid = (int)L; { const int q = nwg / NXCD, r = nwg % NXCD, xcd = wgid % NXCD, off = wgid / NXCD; wgid = (xcd < r ? xcd * (q + 1) : r * (q + 1) + (xcd - r) * q) + off; }
        const int nig = WGM * nN, gid = wgid / nig, fm = gid * WGM, gsz = (nM - fm) < WGM ? (nM - fm) : WGM;
        u.pm = fm + ((wgid % nig) % gsz); u.pn = (wgid % nig) / gsz; return true;
    }
    __device__ __forceinline__ void a_ready(const Unit&) const {}
    __device__ __forceinline__ void done(const Unit&) const {}
};


__device__ __forceinline__ unsigned cvt_pk_bf16(float lo, float hi) { unsigned r; asm volatile("v_cvt_pk_bf16_f32 %0, %1, %2" : "=v"(r) : "v"(lo), "v"(hi)); return r; }
typedef unsigned u32x2 __attribute__((ext_vector_type(2)));
__device__ __forceinline__ float dot4(const f32x4 a) { return (a[0] * a[0] + a[1] * a[1]) + (a[2] * a[2] + a[3] * a[3]); }
__device__ __forceinline__ float sum4(const f32x4 a) { return (a[0] + a[1]) + (a[2] + a[3]); }
__device__ __forceinline__ float row_rstd16(const float* rs, int row) {
    const f32x4* p = (const f32x4*)(rs + (size_t)row * 16);
    const f32x4 a = p[0], b = p[1], c = p[2], d = p[3];
    const float s = (sum4(a) + sum4(b)) + (sum4(c) + sum4(d));
    return 1.0f / sqrtf(s * (1.0f / 1024.0f) + 1e-6f);
}
__device__ __forceinline__ float gelu_tanh(float x) { const float u = 0.7978845608028654f * (x + 0.044715f * x * x * x); return x / (1.0f + __expf(-2.0f * u)); }
__device__ __forceinline__ float sigmoidf_(float x) { return 1.0f / (1.0f + __expf(-x)); }
__device__ __forceinline__ void st_bf16x4(bf16_t* p, const f32x4 v) { u32x2 w; w.x = cvt_pk_bf16(v[0], v[1]); w.y = cvt_pk_bf16(v[2], v[3]); *(u32x2*)p = w; }

struct EpiIn0 {
    static constexpr bool PERM = false, AFTER_DRAIN = false;
    const float* rs; float* xa; float* gg; float* qr; float* kvp; float* win; float* gate;
    __device__ __forceinline__ void operator()(const f32x4 (&acc)[2][2][4][2], const Unit& u, int wr, int wc, int fr, int fq) const {
#pragma unroll
        for (int ai = 0; ai < 2; ++ai)
#pragma unroll
            for (int m = 0; m < 4; ++m) {
                const int row = u.pm * BM + ai * HALF + wr * 64 + m * 16 + fr;
                const float rstd = row_rstd16(rs, row);
#pragma unroll
                for (int bj = 0; bj < 2; ++bj)
#pragma unroll
                    for (int n = 0; n < 2; ++n) {
                        const int cb = u.pn * BM + bj * HALF, col = cb + wc * 32 + n * 16 + fq * 4;
                        f32x4 z = acc[ai][bj][m][n] * rstd;
                        if (cb < 512) *(f32x4*)(xa + (size_t)row * 512 + col) = z;
                        else if (cb < 1024) { z[0] = gelu_tanh(z[0]); z[1] = gelu_tanh(z[1]); z[2] = gelu_tanh(z[2]); z[3] = gelu_tanh(z[3]); *(f32x4*)(gg + (size_t)row * 512 + (col - 512)) = z; }
                        else if (cb < 1536) *(f32x4*)(qr + (size_t)row * 512 + (col - 1024)) = z;
                        else if (cb < 2048) *(f32x4*)(kvp + (size_t)row * 512 + (col - 1536)) = z;
                        else if (cb < 2304) *(f32x4*)(win + (size_t)row * 256 + (col - 2048)) = z;
                        else if (col < 2328) { z[0] = sigmoidf_(z[0]); z[1] = sigmoidf_(z[1]); z[2] = sigmoidf_(z[2]); z[3] = sigmoidf_(z[3]); *(f32x4*)(gate + (size_t)row * 24 + (col - 2304)) = z; }
                    }
            }
    }
};
struct EpiRes {
    static constexpr bool PERM = false, AFTER_DRAIN = false;
    const float* resid; float* y; bf16_t* hb; float* rs;
    __device__ __forceinline__ void operator()(const f32x4 (&acc)[2][2][4][2], const Unit& u, int wr, int wc, int fr, int fq) const {
#pragma unroll
        for (int ai = 0; ai < 2; ++ai)
#pragma unroll
            for (int m = 0; m < 4; ++m) {
                const int row = u.pm * BM + ai * HALF + wr * 64 + m * 16 + fr;
                float ss = 0.f;
#pragma unroll
                for (int bj = 0; bj < 2; ++bj)
#pragma unroll
                    for (int n = 0; n < 2; ++n) {
                        const size_t off = (size_t)row * 1024 + (u.pn * BM + bj * HALF + wc * 32 + n * 16 + fq * 4);
                        const f32x4 v = acc[ai][bj][m][n] + *(const f32x4*)(resid + off);
                        *(f32x4*)(y + off) = v; st_bf16x4(hb + off, v); ss += dot4(v);
                    }
                ss += __shfl_xor(ss, 16); ss += __shfl_xor(ss, 32);
                if (fq == 0) rs[(size_t)row * 16 + u.pn * 4 + wc] = ss;
                asm volatile("" ::: "memory");
            }
    }
};
struct EpiUp {
    static constexpr bool PERM = false, AFTER_DRAIN = false;
    const float* rs; bf16_t* o;
    __device__ __forceinline__ void operator()(const f32x4 (&acc)[2][2][4][2], const Unit& u, int wr, int wc, int fr, int fq) const {
#pragma unroll
        for (int ai = 0; ai < 2; ++ai)
#pragma unroll
            for (int m = 0; m < 4; ++m) {
                const int row = u.pm * BM + ai * HALF + wr * 64 + m * 16 + fr;
                const float rstd = row_rstd16(rs, row);
#pragma unroll
                for (int bj = 0; bj < 2; ++bj)
#pragma unroll
                    for (int n = 0; n < 2; ++n) {
                        const size_t off = (size_t)row * 4096 + (u.pn * BM + bj * HALF + wc * 32 + n * 16 + fq * 4);
                        f32x4 z = acc[ai][bj][m][n] * rstd;
#pragma unroll
                        for (int j = 0; j < 4; ++j) { const float t = z[j] > 0.f ? z[j] : 0.f; z[j] = t * t; }
                        st_bf16x4(o + off, z);
                    }
            }
    }
};
struct EpiProj {
    static constexpr bool PERM = false, AFTER_DRAIN = false;
    float* pp;
    __device__ __forceinline__ void operator()(const f32x4 (&acc)[2][2][4][2], const Unit& u, int wr, int wc, int fr, int fq) const {
#pragma unroll
        for (int ai = 0; ai < 2; ++ai)
#pragma unroll
            for (int m = 0; m < 4; ++m) {
                const int row = u.pm * BM + ai * HALF + wr * 64 + m * 16 + fr;
#pragma unroll
                for (int bj = 0; bj < 2; ++bj)
#pragma unroll
                    for (int n = 0; n < 2; ++n) *(f32x4*)(pp + (size_t)row * 1024 + (u.pn * BM + bj * HALF + wc * 32 + n * 16 + fq * 4)) = acc[ai][bj][m][n];
            }
    }
};
struct EpiGate {
    static constexpr bool PERM = false, AFTER_DRAIN = false;
    const float* rs_in; const float* pp; float* y; bf16_t* hb; float* rs_out;
    __device__ __forceinline__ void operator()(const f32x4 (&acc)[2][2][4][2], const Unit& u, int wr, int wc, int fr, int fq) const {
#pragma unroll
        for (int ai = 0; ai < 2; ++ai)
#pragma unroll
            for (int m = 0; m < 4; ++m) {
                const int row = u.pm * BM + ai * HALF + wr * 64 + m * 16 + fr;
                const float rstd = row_rstd16(rs_in, row);
                float ss = 0.f;
#pragma unroll
                for (int bj = 0; bj < 2; ++bj)
#pragma unroll
                    for (int n = 0; n < 2; ++n) {
                        const size_t off = (size_t)row * 1024 + (u.pn * BM + bj * HALF + wc * 32 + n * 16 + fq * 4);
                        const f32x4 z = acc[ai][bj][m][n] * rstd, p = *(const f32x4*)(pp + off); f32x4 v = *(const f32x4*)(y + off);
#pragma unroll
                        for (int j = 0; j < 4; ++j) v[j] += sigmoidf_(z[j]) * p[j];
                        *(f32x4*)(y + off) = v; st_bf16x4(hb + off, v); ss += dot4(v);
                    }
                ss += __shfl_xor(ss, 16); ss += __shfl_xor(ss, 32);
                if (fq == 0) rs_out[(size_t)row * 16 + u.pn * 4 + wc] = ss;
                asm volatile("" ::: "memory");
            }
    }
};
struct EpiIn1 {
    static constexpr bool PERM = false, AFTER_DRAIN = false;
    const float* rs; bf16_t* u1; float* v1; float* lns;
    __device__ __forceinline__ void operator()(const f32x4 (&acc)[2][2][4][2], const Unit& u, int wr, int wc, int fr, int fq) const {
#pragma unroll
        for (int ai = 0; ai < 2; ++ai)
#pragma unroll
            for (int m = 0; m < 4; ++m) {
                const int row = u.pm * BM + ai * HALF + wr * 64 + m * 16 + fr;
                const float rstd = row_rstd16(rs, row);
                float s1 = 0.f, s2 = 0.f;
#pragma unroll
                for (int bj = 0; bj < 2; ++bj)
#pragma unroll
                    for (int n = 0; n < 2; ++n) {
                        const int col = u.pn * BM + bj * HALF + wc * 32 + n * 16 + fq * 4;
                        f32x4 z = acc[ai][bj][m][n] * rstd;
#pragma unroll
                        for (int j = 0; j < 4; ++j) z[j] = gelu_tanh(z[j]);
                        if (col < 1024) st_bf16x4(u1 + (size_t)row * 1024 + col, z);
                        else { *(f32x4*)(v1 + (size_t)row * 1024 + (col - 1024)) = z; s1 += sum4(z); s2 += dot4(z); }
                    }
                if (u.pn >= 4) {
                    s1 += __shfl_xor(s1, 16); s1 += __shfl_xor(s1, 32); s2 += __shfl_xor(s2, 16); s2 += __shfl_xor(s2, 32);
                    if (fq == 0) { float* p = lns + ((size_t)row * 16 + (u.pn - 4) * 4 + wc) * 2; p[0] = s1; p[1] = s2; }
                }
            }
    }
};

template <class Epi, class Sched, bool ALIGN_EPI = false, bool SP2 = false>
__device__ __forceinline__ void gemm_phase(PG8_LAS unsigned char* lds, const Gemm g, const Sched& S, const Epi& E, const int wid_in) {
    int lane_ = (int)__builtin_amdgcn_mbcnt_hi(~0u, __builtin_amdgcn_mbcnt_lo(~0u, 0u)); asm volatile("" : "+v"(lane_));
    const int wid = wid_in, lane = lane_, tid = wid * 64 + lane, wr = wid >> 2, wc = wid & 3, fr = lane & 15, fq = lane >> 4;
    const int K = g.K, nt = K / BK;
    unsigned voffA[2], voffB[2];
#pragma unroll
    for (int i = 0; i < 2; ++i) { int R, C; stage_rc(tid * 16 + i * 8192, R, C); const int Rb = Epi::PERM ? ((R & ~31) + perm32(R & 31)) : R;
        voffA[i] = (unsigned)(R * K + C) * 2u; voffB[i] = (unsigned)(Rb * K + C) * 2u; }
    const size_t kstep = (size_t)(BK * 2);
    const size_t hstep = (size_t)HALF * K * 2;
    const size_t tstep = 2 * hstep;
    const unsigned ldsw = (unsigned)wid * 1024u;
    const int aoff = lds_byte(wr * 64 + fr, fq * 8), boff = lds_byte(wc * 32 + fr, fq * 8);
#define PG8_SA(b, h) (((b) * 2 + (h)) * HTB)
#define PG8_SB(b, h) ((4 + (b) * 2 + (h)) * HTB)
#define PG8_STAGE(bufoff, gbase, voff) do { _Pragma("unroll") for (int _i = 0; _i < 2; ++_i) \
        __builtin_amdgcn_global_load_lds((const unsigned*)((const char*)(gbase) + (voff)[_i]), (PG8_LAS unsigned*)(lds + (bufoff) + ldsw + _i * 8192), 16, 0, 0); } while (0)
#define PG8_LDA(dst, b, h) do { _Pragma("unroll") for (int m = 0; m < 4; ++m) _Pragma("unroll") for (int k = 0; k < 2; ++k) dst[m][k] = *(const PG8_LAS bf16x8*)(lds + PG8_SA(b, h) + aoff + m * 2048 + k * 1024); } while (0)
#define PG8_LDB(dst, b, h) do { _Pragma("unroll") for (int n = 0; n < 2; ++n) _Pragma("unroll") for (int k = 0; k < 2; ++k) dst[n][k] = *(const PG8_LAS bf16x8*)(lds + PG8_SB(b, h) + boff + n * 2048 + k * 1024); } while (0)
#define PG8_MMA(ai, bj, At, Bt) do { __builtin_amdgcn_s_setprio(1); _Pragma("unroll") for (int m = 0; m < 4; ++m) _Pragma("unroll") for (int n = 0; n < 2; ++n) _Pragma("unroll") for (int k = 0; k < 2; ++k) \
        acc[ai][bj][m][n] = __builtin_amdgcn_mfma_f32_16x16x32_bf16(Bt[n][k], At[m][k], acc[ai][bj][m][n], 0, 0, 0); __builtin_amdgcn_s_setprio(0); } while (0)
#define PG8_WAIT_V(n) asm volatile("s_waitcnt vmcnt(" #n ")" ::: "memory")
#define PG8_WAIT_L(n) asm volatile("s_waitcnt lgkmcnt(" #n ")" ::: "memory")
#define PG8_BAR __builtin_amdgcn_s_barrier()
#define PG8_SCHED __builtin_amdgcn_sched_barrier(0)
    Unit cur, nxt; int ui = 0;
    if (!S.next(0, cur)) return;
    f32x4 acc[2][2][4][2];
#pragma unroll
    for (int a = 0; a < 2; ++a)
#pragma unroll
        for (int b = 0; b < 2; ++b)
#pragma unroll
            for (int m = 0; m < 4; ++m)
#pragma unroll
                for (int n = 0; n < 2; ++n) acc[a][b][m][n] = (f32x4){0.f, 0.f, 0.f, 0.f};
    bf16x8 At[4][2], B0[2][2], B1[2][2];
    const char* cA = (const char*)g.A + (size_t)cur.pm * tstep; const char* cB = (const char*)g.Bt + (size_t)cur.pn * tstep;
    S.a_ready(cur);
    if constexpr (SP2) {
        PG8_STAGE(PG8_SB(0, 0), cB, voffB); PG8_STAGE(PG8_SB(0, 1), cB + hstep, voffB); PG8_STAGE(PG8_SA(0, 0), cA, voffA); PG8_STAGE(PG8_SA(0, 1), cA + hstep, voffA);
        if (wr == 1) PG8_BAR;
        PG8_WAIT_V(2); PG8_BAR;
        PG8_STAGE(PG8_SB(1, 0), cB + kstep, voffB); PG8_STAGE(PG8_SA(1, 0), cA + kstep, voffA); PG8_STAGE(PG8_SB(1, 1), cB + hstep + kstep, voffB);
        PG8_WAIT_V(6); PG8_BAR;
    } else {
        PG8_STAGE(PG8_SB(0, 0), cB, voffB); PG8_STAGE(PG8_SA(0, 0), cA, voffA); PG8_STAGE(PG8_SB(0, 1), cB + hstep, voffB); PG8_STAGE(PG8_SA(0, 1), cA + hstep, voffA);
        if (wr == 1) PG8_BAR;
        PG8_WAIT_V(4); PG8_BAR;
        PG8_STAGE(PG8_SB(1, 0), cB + kstep, voffB); PG8_STAGE(PG8_SA(1, 0), cA + kstep, voffA); PG8_STAGE(PG8_SB(1, 1), cB + hstep + kstep, voffB);
        PG8_WAIT_V(6); PG8_BAR;
    }
    for (;;) {
        const bool has_next = S.next(ui + 1, nxt);
        const char* nA = has_next ? (const char*)g.A + (size_t)nxt.pm * tstep : cA; const char* nB = has_next ? (const char*)g.Bt + (size_t)nxt.pn * tstep : cB;
        for (int t = 0; t < nt; t += 2) {
            const bool last = (t == nt - 2);
            const char* a1 = cA + (size_t)(t + 1) * kstep;
            const char* a2 = last ? nA : cA + (size_t)(t + 2) * kstep; const char* b2 = last ? nB : cB + (size_t)(t + 2) * kstep;
            const char* a3 = a2 + kstep; const char* b3 = b2 + kstep;
            if (last && has_next) S.a_ready(nxt);
            if constexpr (SP2) {
            PG8_LDB(B0, 0, 0); PG8_LDB(B1, 0, 1); PG8_SCHED; PG8_LDA(At, 0, 0); PG8_STAGE(PG8_SA(1, 1), a1 + hstep, voffA);
            PG8_WAIT_V(8); PG8_WAIT_L(0); PG8_BAR; PG8_MMA(0, 0, At, B0); PG8_MMA(0, 1, At, B1); PG8_BAR; PG8_SCHED;
            PG8_LDA(At, 0, 1); PG8_STAGE(PG8_SB(0, 0), b2, voffB); PG8_STAGE(PG8_SB(0, 1), b2 + hstep, voffB); PG8_STAGE(PG8_SA(0, 0), a2, voffA);
            PG8_WAIT_V(8); PG8_WAIT_L(0); PG8_BAR; PG8_MMA(1, 0, At, B0); PG8_MMA(1, 1, At, B1); PG8_BAR; PG8_SCHED;
            PG8_LDB(B0, 1, 0); PG8_LDB(B1, 1, 1); PG8_SCHED; PG8_LDA(At, 1, 0); PG8_STAGE(PG8_SA(0, 1), a2 + hstep, voffA);
            PG8_WAIT_V(8); PG8_WAIT_L(0); PG8_BAR; PG8_MMA(0, 0, At, B0); PG8_MMA(0, 1, At, B1); PG8_BAR; PG8_SCHED;
            PG8_LDA(At, 1, 1); PG8_STAGE(PG8_SB(1, 0), b3, voffB); PG8_STAGE(PG8_SB(1, 1), b3 + hstep, voffB); PG8_STAGE(PG8_SA(1, 0), a3, voffA);
            PG8_WAIT_V(8); PG8_WAIT_L(0); PG8_BAR; PG8_MMA(1, 0, At, B0); PG8_MMA(1, 1, At, B1); PG8_BAR; PG8_SCHED;
            } else {
            PG8_LDB(B0, 0, 0); PG8_SCHED; PG8_LDA(At, 0, 0); PG8_STAGE(PG8_SA(1, 1), a1 + hstep, voffA);
            PG8_WAIT_L(8); PG8_BAR; PG8_WAIT_L(0); PG8_MMA(0, 0, At, B0); PG8_BAR; PG8_SCHED;
            PG8_LDB(B1, 0, 1); PG8_STAGE(PG8_SB(0, 0), b2, voffB);
            PG8_BAR; PG8_WAIT_L(0); PG8_MMA(0, 1, At, B1); PG8_BAR;
            PG8_LDA(At, 0, 1); PG8_STAGE(PG8_SA(0, 0), a2, voffA);
            PG8_BAR; PG8_WAIT_L(0); PG8_MMA(1, 0, At, B0); PG8_BAR; PG8_SCHED;
            PG8_STAGE(PG8_SB(0, 1), b2 + hstep, voffB);
            PG8_WAIT_V(6); PG8_BAR; PG8_MMA(1, 1, At, B1); PG8_BAR;
            PG8_LDB(B0, 1, 0); PG8_SCHED; PG8_LDA(At, 1, 0); PG8_STAGE(PG8_SA(0, 1), a2 + hstep, voffA);
            PG8_WAIT_L(8); PG8_BAR; PG8_WAIT_L(0); PG8_MMA(0, 0, At, B0); PG8_BAR; PG8_SCHED;
            PG8_LDB(B1, 1, 1); PG8_STAGE(PG8_SB(1, 0), b3, voffB);
            PG8_BAR; PG8_WAIT_L(0); PG8_MMA(0, 1, At, B1); PG8_BAR;
            PG8_LDA(At, 1, 1); PG8_STAGE(PG8_SA(1, 0), a3, voffA);
            PG8_BAR; PG8_WAIT_L(0); PG8_MMA(1, 0, At, B0); PG8_BAR; PG8_SCHED;
            PG8_STAGE(PG8_SB(1, 1), b3 + hstep, voffB);
            PG8_WAIT_V(6); PG8_BAR; PG8_MMA(1, 1, At, B1); PG8_BAR;
            }
        }
        if constexpr (ALIGN_EPI) { if (wr == 0) PG8_BAR; }
        if constexpr (!Epi::AFTER_DRAIN) { E(acc, cur, wr, wc, fr, fq); S.done(cur); }
        if (!has_next) break;
#pragma unroll
        for (int a = 0; a < 2; ++a)
#pragma unroll
            for (int b = 0; b < 2; ++b)
#pragma unroll
                for (int m = 0; m < 4; ++m)
#pragma unroll
                    for (int n = 0; n < 2; ++n) acc[a][b][m][n] = (f32x4){0.f, 0.f, 0.f, 0.f};
        cur = nxt; cA = nA; cB = nB; ++ui;
        if constexpr (ALIGN_EPI) { if (wr == 1) PG8_BAR; }
    }
    PG8_WAIT_V(0);
    if constexpr (!ALIGN_EPI) { if (wr == 0) PG8_BAR; }
    PG8_BAR;
    if constexpr (Epi::AFTER_DRAIN) { E.fused(acc, cur, wr, wc, fr, fq, lds, wid, lane); S.done(cur); }
#undef PG8_SA
#undef PG8_SB
#undef PG8_STAGE
#undef PG8_LDA
#undef PG8_LDB
#undef PG8_MMA
#undef PG8_WAIT_V
#undef PG8_WAIT_L
#undef PG8_BAR
#undef PG8_SCHED
}
}

#ifndef PG8_SP2
#define PG8_SP2 true
#endif
#ifndef PG8_ALIGN
#define PG8_ALIGN true
#endif
constexpr int NWAVES = 8;
constexpr int T = 16384, D = 1024, FF = 4096, PLE = 256, NS = 32;
constexpr int LRU = 512, EIN = 2328, EINP = 2560;
constexpr int NPG = 128;
constexpr float EPS = 1e-6f;
constexpr size_t O_YP = 0, O_YS = 16777216, O_KVP = O_YS + 32768, O_KVS = O_KVP + 8388608, O_WINP = O_KVS + 16384, O_WINS = O_WINP + 131072,
                 O_CONVP = O_WINS + 4194304, O_CONVS = O_CONVP + 1536, O_HP = O_CONVS + 49152, O_HS = O_HP + 512, O_VS = O_HS + 16384, O_END = O_VS + 32768;
enum { I_XP = 0, I_XS, I_CKV, I_CWIN, I_SCONV, I_SH, I_PT, I_PP, I_PS, I_RELB, I_GMIX, I_GMLP, I_WUP, I_WDOWN, I_GPLE, I_WPG, I_WPP, I_WINE, I_WOUTE, I_CONVW, I_CONVB,
       I_WA, I_BA, I_WX, I_BX, I_LAM, I_QG, I_KG, I_CWK, I_CWV, I_PEK, I_PEV, I_WINO, I_LNG, I_LNB, I_SGW, I_SGB, I_WOUTO, N_IN };
constexpr size_t MiB = 1ull << 20;
constexpr size_t WS_CTL = 0, CTL_ZERO_BYTES = 1 * MiB;
constexpr size_t WS_WIN0 = 1 * MiB, WS_WOUT0 = 6 * MiB, WS_WUP = 8 * MiB, WS_WDOWN = 24 * MiB, WS_WGATE = 40 * MiB, WS_WPROJ = 44 * MiB, WS_WIN1 = 45 * MiB, WS_WOUT1 = 49 * MiB;
constexpr size_t WS_HBA = 52 * MiB, WS_HBB = 84 * MiB, WS_RSA = 116 * MiB, WS_RSB = 117 * MiB, WS_PB = 118 * MiB;
constexpr size_t WS_XA = 134 * MiB, WS_GG = 166 * MiB, WS_QR = 198 * MiB, WS_WINB = 230 * MiB, WS_GATE = 246 * MiB;
constexpr size_t WS_KC = 248 * MiB, WS_VC = 248 * MiB + 512 * 1024, WS_SUMP = 249 * MiB, WS_SUME = 249 * MiB + 512 * 1024;
constexpr size_t WS_HL = 250 * MiB, WS_CP = 282 * MiB, WS_YAB = 314 * MiB, WS_U = 346 * MiB, WS_PP = 474 * MiB, WS_U1 = 538 * MiB, WS_V1 = 570 * MiB, WS_LNS = 634 * MiB;
constexpr size_t WS_KCS = 636 * MiB, WS_VCS = 644 * MiB, WS_SMP = 652 * MiB, WS_END = 656 * MiB;
constexpr int SM_ZS = 0, SM_QS = 81920, SM_WNS = 98304, SM_GATES = 106496, SM_YABS = 114688, SM_YS0 = 147456, SM_YS1 = 180224, SM_US = 212992, SM_U1S = 344064, SM_V1S = 376832, SM_USS = 409600, SM_PPS = 442368, SM_END = 475136;
static_assert(SM_END * 4 <= 4 * (int)MiB, "sample buffers");
constexpr int CW_TMO = 0, CW_CODE = 1, CW_BAR = 4096;
constexpr int RING_OFF = 0, RING_BYTES = 131072;
constexpr int LDSCTL_OFF = RING_BYTES, MISC_OFF = LDSCTL_OFF + 320;
constexpr int BTAB_OFF = LDSCTL_OFF + 1024;
constexpr int LDS_BYTES = 147456;
static_assert(MISC_OFF + 128 <= BTAB_OFF && BTAB_OFF + 114 * 8 * 4 <= LDS_BYTES, "LDS map");

#define GAS __attribute__((address_space(1)))
#define LAS __attribute__((address_space(3)))
typedef unsigned short bf16;
typedef unsigned v4u __attribute__((ext_vector_type(4)));
typedef unsigned v2u __attribute__((ext_vector_type(2)));
typedef float f32x4 __attribute__((ext_vector_type(4)));
typedef float f32x2 __attribute__((ext_vector_type(2)));
typedef GAS unsigned gu32;
#define RLX_AGENT __ATOMIC_RELAXED, __HIP_MEMORY_SCOPE_AGENT
#define LDS_WAIT() asm volatile("s_waitcnt lgkmcnt(0)" ::: "memory")
#define VM_WAIT() asm volatile("s_waitcnt vmcnt(0)" ::: "memory")
__device__ __forceinline__ unsigned f2bf(float f) { unsigned u = __builtin_bit_cast(unsigned, f); return (u + 0x7fffu + ((u >> 16) & 1u)) >> 16; }
__device__ __forceinline__ unsigned pk2(float lo, float hi) { return f2bf(lo) | (f2bf(hi) << 16); }
using pg8::gelu_tanh; using pg8::sigmoidf_;

#define XB_TMO      128
#define XB_XCNT(j)  (256  + 64 * (j))
#define XB_XSUB(j)  (1280 + 64 * (j))
#define XB_XGEN(j)  (2304 + 64 * (j))
#define XB_TOP      3328
#define XB_TOPGEN   3392
#define XCD_BAR_WORDS 3456
#define XB_SPIN_CAP (1u << 18)

__device__ __forceinline__ unsigned xb_ld(unsigned* p)              { return __hip_atomic_load(p, __ATOMIC_RELAXED, __HIP_MEMORY_SCOPE_AGENT); }
__device__ __forceinline__ unsigned xb_add(unsigned* p, unsigned v) { return __hip_atomic_fetch_add(p, v, __ATOMIC_RELAXED, __HIP_MEMORY_SCOPE_AGENT); }
__device__ __forceinline__ unsigned xb_xcc_id() { return (unsigned)__builtin_amdgcn_s_getreg((3 << 11) | 20) & 0xFu; }
#define XB_SPIN(cond, bar) do { unsigned _sp = 0; while (cond) { __builtin_amdgcn_s_sleep(1); \
    if ((++_sp & 255u) == 0u) { if (xb_ld(&(bar)[XB_TMO])) break; if (_sp > XB_SPIN_CAP) { atomicAdd(&(bar)[XB_TMO], 1u); break; } } } } while (0)

struct XcdBarrier {
    unsigned* bar; unsigned x;
    volatile LAS unsigned* st;
};

__device__ __forceinline__ XcdBarrier xcd_barrier_post(unsigned* bar, volatile LAS unsigned* st) {
    XcdBarrier b; b.bar = bar; b.x = xb_xcc_id(); b.st = st;
    if (threadIdx.x == 0) (void)xb_add(&bar[XB_XCNT(b.x)], 1u);
    return b;
}
__device__ __forceinline__ void xcd_barrier_complete(unsigned* bar, unsigned x, unsigned& nloc, unsigned& nx) {
    const unsigned G = gridDim.x * gridDim.y * gridDim.z;
    unsigned sum, cnt, mine, sp = 0u;
    for (;;) {
        sum = 0u; cnt = 0u; mine = 0u;
#pragma unroll
        for (unsigned j = 0; j < 16; ++j) { const unsigned c = xb_ld(&bar[XB_XCNT(j)]); sum += c; cnt += (c > 0u) ? 1u : 0u; mine = (j == x) ? c : mine; }
        if (sum == G) break;
        __builtin_amdgcn_s_sleep(1);
        if ((++sp & 255u) == 0u) { if (xb_ld(&bar[XB_TMO])) break; if (sp > XB_SPIN_CAP) { atomicAdd(&bar[XB_TMO], 1u); break; } }
    }
    nloc = mine > 0u ? mine : 1u; nx = cnt > 0u ? cnt : 1u;
}

__device__ __forceinline__ void xcd_barrier(const XcdBarrier& b) {
    asm volatile("s_waitcnt vmcnt(0)" ::: "memory");
    __syncthreads();
    if (threadIdx.x == 0) {
        unsigned* bar = b.bar;
        __builtin_amdgcn_s_waitcnt(0);
        unsigned nloc = b.st[0], nx = b.st[1];
        if (nloc == 0u) { xcd_barrier_complete(bar, b.x, nloc, nx); b.st[0] = nloc; b.st[1] = nx; }
        const unsigned old = xb_add(&bar[XB_XSUB(b.x)], 1u);
        const unsigned gen = old / nloc;
        if (old + 1u == (gen + 1u) * nloc) {
            __builtin_amdgcn_fence(__ATOMIC_RELEASE, "agent");
            asm volatile("s_waitcnt vmcnt(0)" ::: "memory");
            const unsigned og = xb_add(&bar[XB_TOP], 1u);
            const unsigned tg = og / nx;
            if (og + 1u == (tg + 1u) * nx) xb_add(&bar[XB_TOPGEN], 1u);
            else XB_SPIN(xb_ld(&bar[XB_TOPGEN]) == tg, bar);
            __builtin_amdgcn_fence(__ATOMIC_ACQUIRE, "agent");
            xb_add(&bar[XB_XGEN(b.x)], 1u);
            asm volatile("s_waitcnt vmcnt(0)" ::: "memory");
        } else {
            XB_SPIN(xb_ld(&bar[XB_XGEN(b.x)]) == gen, bar);
            __builtin_amdgcn_fence(__ATOMIC_ACQUIRE, "agent");
            asm volatile("s_waitcnt vmcnt(0)" ::: "memory");
        }
    }
    __syncthreads();
}


struct Args { const float* in[N_IN]; float* out; unsigned char* ws; int ph_lo, ph_hi; };
struct Frame {
    LAS unsigned char* lds;
    volatile LAS unsigned* MISC;
    gu32* ctl;
    int wave;
    int vcu, G;
    float* out; unsigned char* ws;
};
__device__ __forceinline__ int lane_id_() { int l = (int)__builtin_amdgcn_mbcnt_hi(~0u, __builtin_amdgcn_mbcnt_lo(~0u, 0u)); asm volatile("" : "+v"(l)); return l; }
#define LANE() lane_id_()
#define TID() (F.wave * 64 + lane_id_())
#define WSF(off) ((float*)(F.ws + (off)))
#define WSB(off) ((bf16*)(F.ws + (off)))
#define SMP(off) ((float*)(F.ws + WS_SMP) + (off))

__device__ __forceinline__ float wave_sum(float v) {
#pragma unroll
    for (int o = 1; o < 64; o <<= 1) v += __shfl_xor(v, o);
    return v;
}
__device__ __forceinline__ void transpose_item(const float* W, int K, int N, const float* gain, bf16* WT, LAS float* scr, int item, int lane) {
    const int nblk = (N + 31) / 32, kb = item / nblk, nb = item % nblk, k0 = 64 * kb, n0 = 32 * nb;
#pragma unroll 8
    for (int i = 0; i < 32; ++i) { const int kk = 2 * i + (lane >> 5), n = n0 + (lane & 31);
        float v = (n < N) ? W[(size_t)(k0 + kk) * N + n] : 0.f; if (gain) v *= gain[k0 + kk]; scr[kk * 33 + (lane & 31)] = v; }
    LDS_WAIT();
    const int c = lane & 7;
#pragma unroll
    for (int j = 0; j < 4; ++j) { const int n = (lane >> 3) + 8 * j; const LAS float* s = scr + (8 * c) * 33 + n;
        v4u o; o.x = pk2(s[0 * 33], s[1 * 33]); o.y = pk2(s[2 * 33], s[3 * 33]); o.z = pk2(s[4 * 33], s[5 * 33]); o.w = pk2(s[6 * 33], s[7 * 33]);
        *(GAS v4u*)(WT + (size_t)(n0 + n) * K + k0 + 8 * c) = o; }
    LDS_WAIT();
}
__device__ __forceinline__ void x_row_to_bf16(int lane, const float* xrow, bf16* orow, float* rsrow) {
    const GAS f32x4* xr = (const GAS f32x4*)xrow + lane;
    f32x4 v[4]; float s = 0.f;
#pragma unroll
    for (int j = 0; j < 4; ++j) { v[j] = xr[64 * j]; s += (v[j].x * v[j].x + v[j].y * v[j].y) + (v[j].z * v[j].z + v[j].w * v[j].w); }
    s = wave_sum(s);
    GAS unsigned long long* o8 = (GAS unsigned long long*)orow + lane;
#pragma unroll
    for (int j = 0; j < 4; ++j) o8[64 * j] = (unsigned long long)pk2(v[j].x, v[j].y) | ((unsigned long long)pk2(v[j].z, v[j].w) << 32);
    if (lane < 16) rsrow[lane] = (lane == 0) ? s : 0.f;
}
__device__ __forceinline__ void sample_rstd(Frame& F, const float* Amat, LAS float* rs) {
#pragma unroll
    for (int i = 0; i < 4; ++i) { const int r = F.wave * 4 + i; const f32x4* p = (const f32x4*)(Amat + (size_t)r * D) + LANE(); float s = 0.f;
#pragma unroll
        for (int j = 0; j < 4; ++j) { const f32x4 v = p[64 * j]; s += (v.x * v.x + v.y * v.y) + (v.z * v.z + v.w * v.w); }
        s = wave_sum(s); if (LANE() == 0) rs[r] = 1.0f / sqrtf(s * (1.0f / D) + EPS); }
    LDS_WAIT(); __syncthreads();
}
__device__ __forceinline__ float sgemm_cg(Frame& F, const float* Amat, int lda, const float* gain, const float* W, int N, int K, int n0, LAS float* red) {
    const int r = LANE() & 31, kh = LANE() >> 5, ksl = K / 16, k0 = (F.wave * 2 + kh) * ksl;
    f32x4 acc = {0.f, 0.f, 0.f, 0.f};
    const float* ap = Amat + (size_t)r * lda + k0;
#pragma unroll 4
    for (int k = 0; k < ksl; k += 4) {
        f32x4 a = *(const f32x4*)(ap + k);
        if (gain) a = a * *(const f32x4*)(gain + k0 + k);
        const float* wp = W + (size_t)(k0 + k) * N + n0;
        const f32x4 w0 = *(const f32x4*)wp, w1 = *(const f32x4*)(wp + N), w2 = *(const f32x4*)(wp + 2 * (size_t)N), w3 = *(const f32x4*)(wp + 3 * (size_t)N);
        acc += w0 * a.x; acc += w1 * a.y; acc += w2 * a.z; acc += w3 * a.w;
    }
#pragma unroll
    for (int j = 0; j < 4; ++j) acc[j] += __shfl_xor(acc[j], 32);
    if (kh == 0) *(LAS f32x4*)(red + (F.wave * 32 + r) * 4) = acc;
    LDS_WAIT(); __syncthreads();
    float s = 0.f;
    if (TID() < 128) { const int rr = TID() & 31, cc = TID() >> 5;
#pragma unroll
        for (int w = 0; w < 8; ++w) s += red[(w * 32 + rr) * 4 + cc]; }
    LDS_WAIT(); __syncthreads();
    return s;
}

__device__ __forceinline__ void rg_ab(float rp, float ip, float cv, float lam, float& a, float& b) {
    const float r = 1.0f / (1.0f + expf(-rp)), i = 1.0f / (1.0f + expf(-ip));
    const float sp = log1pf(expf(-lam)); const float la = -8.0f * r * sp;
    a = expf(la); b = sqrtf(-expm1f(2.0f * la)) * (i * cv);
}

__device__ __forceinline__ void sample_post(Frame& F, const Args& A, int b) {
    const int lane = LANE(); const float* z = SMP(SM_ZS) + (size_t)b * EIN;
    const float* convw = A.in[I_CONVW]; const float* sc = A.in[I_SCONV] + (size_t)b * 3 * LRU;
    float* convs = F.out + O_CONVS + (size_t)b * 3 * LRU;
    for (int n = 0; n < 8; ++n) {
        const int ch = n * 64 + lane; const float xa = z[ch];
        const float s0 = sc[ch], s1 = sc[LRU + ch], s2 = sc[2 * LRU + ch];
        const float cv = A.in[I_CONVB][ch] + convw[ch] * s0 + convw[LRU + ch] * s1 + convw[2 * LRU + ch] * s2 + convw[3 * LRU + ch] * xa;
        convs[ch] = s1; convs[LRU + ch] = s2; convs[2 * LRU + ch] = xa;
        float rp = A.in[I_BA][ch], ip = A.in[I_BX][ch];
        const float* wa = A.in[I_WA] + (size_t)n * 4096 + lane; const float* wx = A.in[I_WX] + (size_t)n * 4096 + lane;
        for (int c = 0; c < 64; ++c) { const float cc = __shfl(cv, c); rp += cc * wa[c * 64]; ip += cc * wx[c * 64]; }
        float a, bb; rg_ab(rp, ip, cv, A.in[I_LAM][ch], a, bb);
        const float h = a * A.in[I_SH][(size_t)b * LRU + ch] + bb;
        F.out[O_HS + (size_t)b * LRU + ch] = h;
        SMP(SM_YABS)[(size_t)b * D + ch] = h * gelu_tanh(z[LRU + ch]);
    }
    {
        const float* q = z + 1024 + lane * 8; float v[8], ss = 0.f;
#pragma unroll
        for (int j = 0; j < 8; ++j) { v[j] = q[j]; ss += v[j] * v[j]; }
        ss += __shfl_xor(ss, 1); ss += __shfl_xor(ss, 2); ss += __shfl_xor(ss, 4);
        const float rstd = 1.0f / sqrtf(ss * (1.0f / 64.0f) + EPS);
#pragma unroll
        for (int j = 0; j < 8; ++j) SMP(SM_QS)[(size_t)b * 512 + lane * 8 + j] = v[j] * rstd * A.in[I_QG][(lane & 7) * 8 + j];
    }
    for (int s = 0; s < 6; ++s) {
        const float* p = z + 1536 + s * 128 + lane * 2; float v0 = p[0], v1 = p[1];
        if (s == 2 || s == 4) { float ss = v0 * v0 + v1 * v1;
#pragma unroll
            for (int o = 1; o < 32; o <<= 1) ss += __shfl_xor(ss, o);
            const float rstd = 1.0f / sqrtf(ss * (1.0f / 64.0f) + EPS); const float* kg = A.in[I_KG] + (s == 2 ? 64 : 128) + (lane & 31) * 2;
            v0 = v0 * rstd * kg[0]; v1 = v1 * rstd * kg[1]; }
        if (s < 4) { float* o = F.out + O_KVS + (size_t)b * 512 + s * 128 + lane * 2; o[0] = v0; o[1] = v1; }
        else { float* o = SMP(SM_WNS) + (size_t)b * 256 + (s - 4) * 128 + lane * 2; o[0] = v0; o[1] = v1;
               float* w = F.out + O_WINS + ((size_t)b * 512 + 511) * 256 + (s - 4) * 128 + lane * 2; w[0] = v0; w[1] = v1; }
    }
    if (lane < 24) SMP(SM_GATES)[b * 24 + lane] = sigmoidf_(z[2304 + lane]);
}
__device__ __forceinline__ void head_norm_token(Frame& F, const Args& A, int t) {
    const int lane = LANE();
    {   float* q = WSF(WS_QR) + (size_t)t * 512 + lane * 8; f32x4 a = *(f32x4*)q, b = *(f32x4*)(q + 4);
        float ss = pg8::dot4(a) + pg8::dot4(b); ss += __shfl_xor(ss, 1); ss += __shfl_xor(ss, 2); ss += __shfl_xor(ss, 4);
        const float rstd = 1.0f / sqrtf(ss * (1.0f / 64.0f) + EPS); const float* g = A.in[I_QG] + (lane & 7) * 8;
        a = a * rstd * *(const f32x4*)g; b = b * rstd * *(const f32x4*)(g + 4); *(f32x4*)q = a; *(f32x4*)(q + 4) = b; }
    {   const int l = lane & 31; float* p = (lane < 32) ? (F.out + O_KVP + (size_t)t * 512 + 256 + l * 4) : (WSF(WS_WINB) + (size_t)t * 256 + l * 4);
        f32x4 a = *(f32x4*)p; float ss = pg8::dot4(a);
#pragma unroll
        for (int o = 1; o < 16; o <<= 1) ss += __shfl_xor(ss, o);
        const float rstd = 1.0f / sqrtf(ss * (1.0f / 64.0f) + EPS); const float* g = A.in[I_KG] + (lane < 32 ? 64 : 128) + (l & 15) * 4;
        a = a * rstd * *(const f32x4*)g; *(f32x4*)p = a;
        if (t >= T - 512) {
            float* wo = F.out + O_WINP + (size_t)(t - (T - 512)) * 256;
            if (lane >= 32) *(f32x4*)(wo + l * 4) = a;
            else *(f32x4*)(wo + 128 + l * 4) = *(const f32x4*)(WSF(WS_WINB) + (size_t)t * 256 + 128 + l * 4);
        }
    }
    if (t >= T - 3) {
        const float* x = WSF(WS_XA) + (size_t)t * 512 + lane * 8; float* o = F.out + O_CONVP + (size_t)(t - (T - 3)) * 512 + lane * 8;
        *(f32x4*)o = *(const f32x4*)x; *(f32x4*)(o + 4) = *(const f32x4*)(x + 4);
    }
}


__device__ __forceinline__ void rg1_item(Frame& F, const Args& A, int sc, int n, LAS float* wscr) {
    typedef float f32x16 __attribute__((ext_vector_type(16)));
    const int lane = LANE(), ch = n * 64 + lane, t0 = sc * 64, l31 = lane & 31, lh = lane >> 5;
    const float* cw = A.in[I_CONVW];
    const float cw0 = cw[ch], cw1 = cw[LRU + ch], cw2 = cw[2 * LRU + ch], cw3 = cw[3 * LRU + ch], cb = A.in[I_CONVB][ch];
    const float* xa = WSF(WS_XA); float* HL = WSF(WS_HL); float* CP = WSF(WS_CP);
    float xm3 = 0.f, xm2 = 0.f, xm1 = 0.f;
    if (t0 > 0) { xm3 = xa[(size_t)(t0 - 3) * LRU + ch]; xm2 = xa[(size_t)(t0 - 2) * LRU + ch]; xm1 = xa[(size_t)(t0 - 1) * LRU + ch]; }
    float h = 0.f, cp = 1.f;
    float ba2[2], bx2[2], sp2[2];
#pragma unroll
    for (int dt = 0; dt < 2; ++dt) { const int cd = n * 64 + dt * 32 + l31; ba2[dt] = A.in[I_BA][cd]; bx2[dt] = A.in[I_BX][cd]; sp2[dt] = -8.0f * log1pf(expf(-A.in[I_LAM][cd])); }
    for (int hf = 0; hf < 2; ++hf) {
        const int tb = t0 + hf * 32;
        LDS_WAIT();
#pragma unroll 8
        for (int i = 0; i < 32; ++i) { const float x = xa[(size_t)(tb + i) * LRU + ch];
            const float cv = cb + cw0 * xm3 + cw1 * xm2 + cw2 * xm1 + cw3 * x; xm3 = xm2; xm2 = xm1; xm1 = x;
            wscr[i * 65 + lane] = cv; }
        LDS_WAIT();
        float ra[2][16], rb[2][16];
#pragma unroll
        for (int dt = 0; dt < 2; ++dt) {
            f32x16 pa, px;
#pragma unroll
            for (int r = 0; r < 16; ++r) { pa[r] = 0.f; px[r] = 0.f; }
            const float* wa = A.in[I_WA] + (size_t)n * 4096 + dt * 32 + l31 + lh * 64; const float* wx = A.in[I_WX] + (size_t)n * 4096 + dt * 32 + l31 + lh * 64;
            const LAS float* ap = wscr + l31 * 65 + lh;
#pragma unroll 4
            for (int ks = 0; ks < 32; ++ks) { const float av = ap[2 * ks], ba_ = wa[ks * 128], bx_ = wx[ks * 128];
                pa = __builtin_amdgcn_mfma_f32_32x32x2f32(av, ba_, pa, 0, 0, 0); px = __builtin_amdgcn_mfma_f32_32x32x2f32(av, bx_, px, 0, 0, 0); }
#pragma unroll
            for (int r = 0; r < 16; ++r) { const int tt = (r & 3) + 8 * (r >> 2) + 4 * lh;
                const float cv = wscr[tt * 65 + dt * 32 + l31];
                const float rg = 1.0f / (1.0f + expf(-(pa[r] + ba2[dt]))), ig = 1.0f / (1.0f + expf(-(px[r] + bx2[dt])));
                const float la = sp2[dt] * rg; ra[dt][r] = expf(la); rb[dt][r] = sqrtf(-expm1f(2.0f * la)) * (ig * cv); }
        }
        LDS_WAIT();
#pragma unroll
        for (int dt = 0; dt < 2; ++dt)
#pragma unroll
            for (int r = 0; r < 16; ++r) { const int tt = (r & 3) + 8 * (r >> 2) + 4 * lh; wscr[tt * 64 + dt * 32 + l31] = ra[dt][r]; wscr[2048 + tt * 64 + dt * 32 + l31] = rb[dt][r]; }
        LDS_WAIT();
#pragma unroll 8
        for (int i = 0; i < 32; ++i) { const float a = wscr[i * 64 + lane], b = wscr[2048 + i * 64 + lane];
            h = a * h + b; cp *= a; HL[(size_t)(tb + i) * LRU + ch] = h; CP[(size_t)(tb + i) * LRU + ch] = cp; }
    }
    WSF(WS_SUMP)[(size_t)sc * LRU + ch] = cp; WSF(WS_SUME)[(size_t)sc * LRU + ch] = h;
}
__device__ __forceinline__ void rg3_item(Frame& F, const Args& A, int sc, int n) {
    const int lane = LANE(), ch = n * 64 + lane, t0 = sc * 64;
    const float* SP = WSF(WS_SUMP) + ch; const float* SE = WSF(WS_SUME) + ch;
    float H = 0.f;
    int s = 0;
    for (; s + 8 <= sc; s += 8) { float p[8], e[8];
#pragma unroll
        for (int j = 0; j < 8; ++j) { p[j] = SP[(size_t)(s + j) * LRU]; e[j] = SE[(size_t)(s + j) * LRU]; }
#pragma unroll
        for (int j = 0; j < 8; ++j) H = p[j] * H + e[j]; }
    for (; s < sc; ++s) H = SP[(size_t)s * LRU] * H + SE[(size_t)s * LRU];
    const float* HL = WSF(WS_HL); const float* CP = WSF(WS_CP); const float* GG = WSF(WS_GG); bf16* Y = WSB(WS_YAB);
    float hlast = 0.f;
#pragma unroll 8
    for (int i = 0; i < 64; ++i) { const size_t t = (size_t)(t0 + i);
        const float h = HL[t * LRU + ch] + CP[t * LRU + ch] * H; hlast = h;
        Y[t * D + ch] = (bf16)f2bf(h * GG[t * LRU + ch]); }
    if (sc == T / 64 - 1) F.out[O_HP + ch] = hlast;
}

__device__ __forceinline__ void cmp_prompt_item(Frame& F, const Args& A, int jq, int kv, LAS float* scr) {
    const int lane = LANE(); const float* W = A.in[kv ? I_CWV : I_CWK]; const float* pe = A.in[kv ? I_PEV : I_PEK]; const float* kvp = F.out + O_KVP;
    float acc[8];
#pragma unroll
    for (int o = 0; o < 8; ++o) acc[o] = 0.f;
    for (int i = 0; i < 32; ++i) {
        const float pv = pe[i * 64 + lane];
#pragma unroll
        for (int o = 0; o < 8; ++o) scr[lane * 8 + o] = kvp[(size_t)(32 * (4 * jq + (o >> 1)) + i) * 512 + kv * 128 + (o & 1) * 64 + lane] + pv;
        LDS_WAIT();
#pragma unroll 8
        for (int c = 0; c < 64; ++c) { const float w = W[(size_t)(i * 64 + c) * 64 + lane];
            const f32x4 x0 = *(const LAS f32x4*)(scr + c * 8), x1 = *(const LAS f32x4*)(scr + c * 8 + 4);
            acc[0] += x0.x * w; acc[1] += x0.y * w; acc[2] += x0.z * w; acc[3] += x0.w * w; acc[4] += x1.x * w; acc[5] += x1.y * w; acc[6] += x1.z * w; acc[7] += x1.w * w; }
        LDS_WAIT();
    }
    float* dst = WSF(kv ? WS_VC : WS_KC);
#pragma unroll
    for (int o = 0; o < 8; ++o) { float v = acc[o];
        if (kv == 0) { const float ss = wave_sum(v * v); v = v * (1.0f / sqrtf(ss * (1.0f / 64.0f) + EPS)) * A.in[I_KG][lane]; }
        dst[(size_t)((4 * jq + (o >> 1)) * 2 + (o & 1)) * 64 + lane] = v; }
}
__device__ __forceinline__ void cmp_sample_item(Frame& F, const Args& A, int b, int pg) {
    LAS float* xs = (LAS float*)(F.lds + RING_OFF);
    LAS float* red = (LAS float*)(F.lds + RING_OFF + 65536);
    const int lane = LANE(), phys = ((const int*)A.in[I_PT])[b * NPG + pg];
    for (int kv = 0; kv < 2; ++kv) {
        const float* W = A.in[kv ? I_CWV : I_CWK]; const float* pe = A.in[kv ? I_PEV : I_PEK];
        for (int idx = TID(); idx < 128 * 32; idx += NWAVES * 64) { const int r = idx >> 5, q = idx & 31;
            const f32x4 v = *(const f32x4*)(A.in[I_CKV] + ((size_t)(phys * 128 + r) * 4 + kv) * 128 + q * 4), p4 = *(const f32x4*)(pe + (r & 31) * 64 + (q & 15) * 4);
            *(LAS f32x4*)(xs + r * 128 + q * 4) = v + p4; }
        LDS_WAIT(); __syncthreads();
        float acc[8];
#pragma unroll
        for (int o = 0; o < 8; ++o) acc[o] = 0.f;
        for (int ii = 0; ii < 4; ++ii) { const int i = 4 * F.wave + ii;
#pragma unroll 2
            for (int c = 0; c < 64; c += 4) {
                const float w0 = W[(size_t)(i * 64 + c) * 64 + lane], w1 = W[(size_t)(i * 64 + c + 1) * 64 + lane], w2 = W[(size_t)(i * 64 + c + 2) * 64 + lane], w3 = W[(size_t)(i * 64 + c + 3) * 64 + lane];
#pragma unroll
                for (int o = 0; o < 8; ++o) { const f32x4 x = *(const LAS f32x4*)(xs + ((o >> 1) * 32 + i) * 128 + (o & 1) * 64 + c);
                    acc[o] += (x.x * w0 + x.y * w1) + (x.z * w2 + x.w * w3); }
            }
        }
#pragma unroll
        for (int o = 0; o < 8; ++o) red[(F.wave * 8 + o) * 64 + lane] = acc[o];
        LDS_WAIT(); __syncthreads();
        {   const int o = F.wave; float v = 0.f;
#pragma unroll
            for (int w = 0; w < 8; ++w) v += red[(w * 8 + o) * 64 + lane];
            if (kv == 0) { const float ss = wave_sum(v * v); v = v * (1.0f / sqrtf(ss * (1.0f / 64.0f) + EPS)) * A.in[I_KG][lane]; }
            WSF(kv ? WS_VCS : WS_KCS)[((size_t)(b * 512 + 4 * pg + (o >> 1)) * 2 + (o & 1)) * 64 + lane] = v; }
        LDS_WAIT(); __syncthreads();
    }
}

constexpr int AW_SC = 0, AW_IMP = 8192, AW_PT = 9472, AW_SEL = 9728, AW_Q = 9792;
struct SrcPromptCmp { const float* kc; const float* vc; const LAS float* btab; int t, g;
    __device__ __forceinline__ bool valid(int) const { return true; }
    __device__ __forceinline__ float bias(int k, int hh) const { int d = t - (32 * k + 31); d = d > 113 ? 113 : d; return btab[d * 8 + g * 4 + hh]; }
    __device__ __forceinline__ const float* kptr(int k) const { return kc + (size_t)(k * 2 + g) * 64; }
    __device__ __forceinline__ const float* vptr(int k) const { return vc + (size_t)(k * 2 + g) * 64; } };
struct SrcPromptSel { const float* kvp; const LAS float* btab; const LAS int* sel; int t, g;
    __device__ __forceinline__ int kpos(int k) const { return sel[k >> 6] * 64 + (k & 63); }
    __device__ __forceinline__ bool valid(int k) const { return kpos(k) <= t; }
    __device__ __forceinline__ float bias(int k, int hh) const { int d = t - kpos(k); d = d > 113 ? 113 : d; return btab[d * 8 + g * 4 + hh]; }
    __device__ __forceinline__ const float* kptr(int k) const { return kvp + (size_t)kpos(k) * 512 + 256 + g * 64; }
    __device__ __forceinline__ const float* vptr(int k) const { return kvp + (size_t)kpos(k) * 512 + 384 + g * 64; } };
struct SrcPromptWin { const float* winb; const LAS float* btab; int t, g;
    __device__ __forceinline__ bool valid(int k) const { return t - 511 + k >= 0; }
    __device__ __forceinline__ float bias(int k, int hh) const { int d = 511 - k; d = d > 113 ? 113 : d; return btab[d * 8 + g * 4 + hh]; }
    __device__ __forceinline__ const float* kptr(int k) const { return winb + (size_t)(t - 511 + k) * 256 + g * 64; }
    __device__ __forceinline__ const float* vptr(int k) const { return winb + (size_t)(t - 511 + k) * 256 + 128 + g * 64; } };
struct SrcSampleCmp { const float* kc; const float* vc; const LAS float* btab; int g;
    __device__ __forceinline__ bool valid(int) const { return true; }
    __device__ __forceinline__ float bias(int k, int hh) const { int d = T - (32 * k + 31); d = d > 113 ? 113 : d; return btab[d * 8 + g * 4 + hh]; }
    __device__ __forceinline__ const float* kptr(int k) const { return kc + (size_t)(k * 2 + g) * 64; }
    __device__ __forceinline__ const float* vptr(int k) const { return vc + (size_t)(k * 2 + g) * 64; } };
struct SrcSampleSel { const float* cache; const int* pt; const float* newrow; const LAS float* btab; const LAS int* sel; int g;
    __device__ __forceinline__ int kpos(int k) const { return sel[k >> 6] * 64 + (k & 63); }
    __device__ __forceinline__ bool valid(int k) const { return kpos(k) <= T; }
    __device__ __forceinline__ float bias(int k, int hh) const { int d = T - kpos(k); d = d > 113 ? 113 : d; return btab[d * 8 + g * 4 + hh]; }
    __device__ __forceinline__ const float* rowp(int k, int s) const { const int kp = kpos(k); if (kp >= T) return newrow + s * 128 + g * 64;
        const int phys = pt[kp >> 7]; return cache + ((size_t)(phys * 128 + (kp & 127)) * 4 + s) * 128 + g * 64; }
    __device__ __forceinline__ const float* kptr(int k) const { return rowp(k, 2); }
    __device__ __forceinline__ const float* vptr(int k) const { return rowp(k, 3); } };
struct SrcSampleWin { const float* cwin; const float* wns; const LAS float* btab; int g;
    __device__ __forceinline__ bool valid(int) const { return true; }
    __device__ __forceinline__ float bias(int k, int hh) const { int d = 511 - k; d = d > 113 ? 113 : d; return btab[d * 8 + g * 4 + hh]; }
    __device__ __forceinline__ const float* kptr(int k) const { return k < 511 ? cwin + (size_t)(k + 1) * 256 + g * 64 : wns + g * 64; }
    __device__ __forceinline__ const float* vptr(int k) const { return k < 511 ? cwin + (size_t)(k + 1) * 256 + 128 + g * 64 : wns + 128 + g * 64; } };

template <class Src, bool STASH>
__device__ __forceinline__ void attn_branch(const Src& S, int nkeys, LAS float* wscr, float& m, float& l, float (&o)[4], int lane) {
    const int kk = lane >> 2, hh = lane & 3;
    LAS float* pt = (LAS float*)((LAS unsigned char*)wscr + AW_PT); LAS float* sc = (LAS float*)((LAS unsigned char*)wscr + AW_SC);
    m = -1e30f; l = 0.f; o[0] = 0.f; o[1] = 0.f; o[2] = 0.f; o[3] = 0.f;
    for (int k0 = 0; k0 < nkeys; k0 += 16) {
        const int kidx = k0 + kk; const bool valid = kidx < nkeys && S.valid(kidx);
        float s = -1e30f;
        if (valid) { const f32x4* kr = (const f32x4*)S.kptr(kidx); const LAS f32x4* qv = (const LAS f32x4*)((LAS unsigned char*)wscr + AW_Q) + hh * 17; float d0 = 0.f, d1 = 0.f;
#pragma unroll 4
            for (int c = 0; c < 16; c += 2) { const f32x4 a = kr[c], b = kr[c + 1], qa = qv[c], qb = qv[c + 1];
                d0 += (a.x * qa.x + a.y * qa.y) + (a.z * qa.z + a.w * qa.w);
                d1 += (b.x * qb.x + b.y * qb.y) + (b.z * qb.z + b.w * qb.w); }
            s = (d0 + d1) * 0.125f + S.bias(kidx, hh); }
        if (STASH) sc[kidx * 4 + hh] = s;
        float mt = s; mt = fmaxf(mt, __shfl_xor(mt, 4)); mt = fmaxf(mt, __shfl_xor(mt, 8)); mt = fmaxf(mt, __shfl_xor(mt, 16)); mt = fmaxf(mt, __shfl_xor(mt, 32));
        const float mn = fmaxf(m, mt), alpha = __expf(m - mn), p = valid ? __expf(s - mn) : 0.f;
        float ps = p; ps += __shfl_xor(ps, 4); ps += __shfl_xor(ps, 8); ps += __shfl_xor(ps, 16); ps += __shfl_xor(ps, 32);
        l = l * alpha + ps; m = mn;
        pt[lane] = p;
        LDS_WAIT();
#pragma unroll
        for (int h = 0; h < 4; ++h) o[h] *= __shfl(alpha, h);
        const int nk = (nkeys - k0) < 16 ? (nkeys - k0) : 16;
        for (int j = 0; j < nk; ++j) { const f32x4 pj = *(const LAS f32x4*)(pt + j * 4);
            if (pj.x == 0.f && pj.y == 0.f && pj.z == 0.f && pj.w == 0.f) continue;
            const float v = S.vptr(k0 + j)[lane];
            o[0] += pj.x * v; o[1] += pj.y * v; o[2] += pj.z * v; o[3] += pj.w * v; }
        LDS_WAIT();
    }
}
__device__ __forceinline__ void attn_importance(int nkeys, LAS float* wscr, float m, float l, int lane) {
    const int kk = lane >> 2, hh = lane & 3;
    const LAS float* sc = (const LAS float*)((LAS unsigned char*)wscr + AW_SC); LAS float* imp = (LAS float*)((LAS unsigned char*)wscr + AW_IMP);
    const float rl = l > 0.f ? 1.0f / l : 0.f;
    for (int k0 = 0; k0 < 512; k0 += 16) { const int kidx = k0 + kk;
        float p = (kidx < nkeys && l > 0.f) ? __expf(sc[kidx * 4 + hh] - m) * rl : 0.f;
        p += __shfl_xor(p, 1); p += __shfl_xor(p, 2); p += __shfl_xor(p, 4);
        if ((lane & 7) == 0) imp[kidx >> 1] = p; }
    if (lane < 64) imp[256 + lane] = 0.f;
    LDS_WAIT();
}
__device__ __forceinline__ int attn_topk(int nsb, int cur, LAS float* wscr, int lane) {
    const LAS float* imp = (const LAS float*)((LAS unsigned char*)wscr + AW_IMP); LAS int* sel = (LAS int*)((LAS unsigned char*)wscr + AW_SEL);
    float v[5];
#pragma unroll
    for (int i = 0; i < 5; ++i) { const int sb = lane + 64 * i;
        v[i] = (sb >= nsb || sb > cur) ? -1.0f : ((sb == 0 || sb == cur || sb == cur - 1) ? 1.0e4f : imp[sb]); }
    int nsel = 0;
    for (int it = 0; it < 16; ++it) {
        float bv = v[0]; int bi = lane;
#pragma unroll
        for (int i = 1; i < 5; ++i) if (v[i] > bv) { bv = v[i]; bi = lane + 64 * i; }
#pragma unroll
        for (int off = 32; off >= 1; off >>= 1) { const float ov = __shfl_xor(bv, off); const int oi = __shfl_xor(bi, off);
            if (ov > bv || (ov == bv && oi < bi)) { bv = ov; bi = oi; } }
        if (bv < 0.f) break;
        if (lane == 0) sel[nsel] = bi;
        ++nsel;
#pragma unroll
        for (int i = 0; i < 5; ++i) if (bi == lane + 64 * i) v[i] = -2.0f;
    }
    LDS_WAIT();
    return nsel;
}
__device__ __forceinline__ void attn_accum(float (&of)[4], const float (&o)[4], float l, float gate_h_unused, const float* gates3, int j, int lane) {
#pragma unroll
    for (int h = 0; h < 4; ++h) { const float lh = __shfl(l, h); if (lh > 0.f) of[h] += gates3[h * 3 + j] * o[h] / lh; }
}
__device__ __forceinline__ void attn_prompt_item(Frame& F, const Args& A, int t, int g, LAS float* wscr, const LAS float* btab) {
    const int lane = LANE();
    {
        const f32x4 v = *((const f32x4*)(WSF(WS_QR) + (size_t)t * 512 + g * 256) + lane);
        *((LAS f32x4*)((LAS unsigned char*)wscr + AW_Q) + (lane >> 4) * 17 + (lane & 15)) = v; LDS_WAIT(); }
    const float* g3 = WSF(WS_GATE) + (size_t)t * 24 + g * 12;
    float of[4] = {0.f, 0.f, 0.f, 0.f}, o[4], m, l;
    const int nvis = (t + 1) >> 5, cur = t >> 6;
    {   SrcPromptCmp S{WSF(WS_KC), WSF(WS_VC), btab, t, g};
        attn_branch<SrcPromptCmp, true>(S, nvis, wscr, m, l, o, lane);
        attn_accum(of, o, l, 0.f, g3, 0, lane);
        attn_importance(nvis, wscr, m, l, lane); }
    const int nsel = attn_topk(256, cur, wscr, lane);
    {   SrcPromptSel S{F.out + O_KVP, btab, (const LAS int*)((LAS unsigned char*)wscr + AW_SEL), t, g};
        attn_branch<SrcPromptSel, false>(S, nsel * 64, wscr, m, l, o, lane);
        attn_accum(of, o, l, 0.f, g3, 1, lane); }
    {   SrcPromptWin S{WSF(WS_WINB), btab, t, g};
        attn_branch<SrcPromptWin, false>(S, 512, wscr, m, l, o, lane);
        attn_accum(of, o, l, 0.f, g3, 2, lane); }
    bf16* y = WSB(WS_YAB) + (size_t)t * D + 512 + g * 256 + lane;
#pragma unroll
    for (int h = 0; h < 4; ++h) y[h * 64] = (bf16)f2bf(of[h]);
}
__device__ __forceinline__ void attn_sample_item(Frame& F, const Args& A, int b, int g, LAS float* wscr, const LAS float* btab) {
    const int lane = LANE();
    {   const f32x4 v = *((const f32x4*)(SMP(SM_QS) + (size_t)b * 512 + g * 256) + lane);
        *((LAS f32x4*)((LAS unsigned char*)wscr + AW_Q) + (lane >> 4) * 17 + (lane & 15)) = v; LDS_WAIT(); }
    const float* g3 = SMP(SM_GATES) + b * 24 + g * 12;
    float of[4] = {0.f, 0.f, 0.f, 0.f}, o[4], m, l;
    {   SrcSampleCmp S{WSF(WS_KCS) + (size_t)b * 512 * 128, WSF(WS_VCS) + (size_t)b * 512 * 128, btab, g};
        attn_branch<SrcSampleCmp, true>(S, 512, wscr, m, l, o, lane);
        attn_accum(of, o, l, 0.f, g3, 0, lane);
        attn_importance(512, wscr, m, l, lane); }
    const int nsel = attn_topk(257, 256, wscr, lane);
    {   SrcSampleSel S{A.in[I_CKV], (const int*)A.in[I_PT] + b * NPG, F.out + O_KVS + (size_t)b * 512, btab, (const LAS int*)((LAS unsigned char*)wscr + AW_SEL), g};
        attn_branch<SrcSampleSel, false>(S, nsel * 64, wscr, m, l, o, lane);
        attn_accum(of, o, l, 0.f, g3, 1, lane); }
    {   SrcSampleWin S{A.in[I_CWIN] + (size_t)b * 512 * 256, SMP(SM_WNS) + (size_t)b * 256, btab, g};
        attn_branch<SrcSampleWin, false>(S, 512, wscr, m, l, o, lane);
        attn_accum(of, o, l, 0.f, g3, 2, lane); }
    float* y = SMP(SM_YABS) + (size_t)b * D + 512 + g * 256 + lane;
#pragma unroll
    for (int h = 0; h < 4; ++h) y[h * 64] = of[h];
}

__device__ __forceinline__ void p0_prologue(Frame& F, const Args& A) {
    LAS float* scr = (LAS float*)(F.lds + RING_OFF + F.wave * 16384);
    const int gw = F.vcu * NWAVES + F.wave, NGW = F.G * NWAVES, lane = LANE();
    constexpr int I_IN0 = 16 * 73, I_SQ = 16 * 32, I_UP = 16 * 128, I_DN = 64 * 32, I_PJ = 4 * 32, I_IN1 = 16 * 64;
    constexpr int NITEMS = I_IN0 + I_SQ + 2 * I_UP + 2 * I_DN + 2 * I_SQ + 2 * I_PJ + I_IN1 + I_SQ;
    for (int it = gw; it < NITEMS; it += NGW) {
        int r = it;
        if (r < I_IN0) { transpose_item(A.in[I_WINE], D, EIN, A.in[I_GMIX], WSB(WS_WIN0), scr, r, lane); continue; } r -= I_IN0;
        if (r < I_SQ) { transpose_item(A.in[I_WOUTE], D, D, nullptr, WSB(WS_WOUT0), scr, r, lane); continue; } r -= I_SQ;
        if (r < I_UP) { transpose_item(A.in[I_WUP], D, FF, A.in[I_GMLP], WSB(WS_WUP), scr, r, lane); continue; } r -= I_UP;
        if (r < I_UP) { transpose_item(A.in[I_WUP] + (size_t)D * FF, D, FF, A.in[I_GMLP] + D, WSB(WS_WUP) + (size_t)D * FF, scr, r, lane); continue; } r -= I_UP;
        if (r < I_DN) { transpose_item(A.in[I_WDOWN], FF, D, nullptr, WSB(WS_WDOWN), scr, r, lane); continue; } r -= I_DN;
        if (r < I_DN) { transpose_item(A.in[I_WDOWN] + (size_t)D * FF, FF, D, nullptr, WSB(WS_WDOWN) + (size_t)D * FF, scr, r, lane); continue; } r -= I_DN;
        if (r < I_SQ) { transpose_item(A.in[I_WPG], D, D, A.in[I_GPLE], WSB(WS_WGATE), scr, r, lane); continue; } r -= I_SQ;
        if (r < I_SQ) { transpose_item(A.in[I_WPG] + (size_t)D * D, D, D, A.in[I_GPLE] + D, WSB(WS_WGATE) + (size_t)D * D, scr, r, lane); continue; } r -= I_SQ;
        if (r < I_PJ) { transpose_item(A.in[I_WPP], PLE, D, nullptr, WSB(WS_WPROJ), scr, r, lane); continue; } r -= I_PJ;
        if (r < I_PJ) { transpose_item(A.in[I_WPP] + (size_t)PLE * D, PLE, D, nullptr, WSB(WS_WPROJ) + (size_t)PLE * D, scr, r, lane); continue; } r -= I_PJ;
        if (r < I_IN1) { transpose_item(A.in[I_WINO], D, 2 * D, A.in[I_GMIX] + D, WSB(WS_WIN1), scr, r, lane); continue; } r -= I_IN1;
        transpose_item(A.in[I_WOUTO], D, D, nullptr, WSB(WS_WOUT1), scr, r, lane);
    }
    {
        v4u* z = (v4u*)(WSB(WS_WIN0) + (size_t)2336 * D); const int n16 = (EINP - 2336) * D * 2 / 16;
        for (int i = gw * 64 + lane; i < n16; i += NGW * 64) z[i] = (v4u){0u, 0u, 0u, 0u};
    }
    for (int m = gw; m < T; m += NGW) x_row_to_bf16(lane, A.in[I_XP] + (size_t)m * D, WSB(WS_HBA) + (size_t)m * D, WSF(WS_RSA) + (size_t)m * 16);
    for (int m = gw; m < 2 * T; m += NGW) { const f32x4 v = *((const f32x4*)(A.in[I_PP] + (size_t)m * PLE) + lane);
        *((v2u*)(WSB(WS_PB) + (size_t)m * PLE) + lane) = (v2u){pk2(v.x, v.y), pk2(v.z, v.w)}; }
#if DBG_ZERO_OUT
    for (size_t i = (size_t)gw * 64 + lane; i < O_END / 4; i += (size_t)NGW * 64) ((f32x4*)F.out)[i] = (f32x4){0.f, 0.f, 0.f, 0.f};
#endif
    {
        LAS float* red = (LAS float*)(F.lds + RING_OFF); LAS float* rs = (LAS float*)(F.lds + RING_OFF + 8192);
        __syncthreads();
        sample_rstd(F, A.in[I_XS], rs);
        for (int cg = F.vcu; cg < EIN / 4; cg += F.G) {
            const float s = sgemm_cg(F, A.in[I_XS], D, A.in[I_GMIX], A.in[I_WINE], EIN, D, cg * 4, red);
            if (TID() < 128) { const int r = TID() & 31, n = cg * 4 + (TID() >> 5); SMP(SM_ZS)[(size_t)r * EIN + n] = s * rs[r]; }
        }
    }
}


__device__ __forceinline__ void sgu_item(Frame& F, const Args& A, int c, int g) {
    LAS float* vn = (LAS float*)(F.lds + RING_OFF);
    const int lane = LANE();
    for (int idx = TID(); idx < 128 * 32; idx += NWAVES * 64) { const int r = idx >> 5, q4 = (idx & 31) * 4; const size_t row = (size_t)c * 128 + r;
        const f32x4* lp = (const f32x4*)(WSF(WS_LNS) + row * 32); float s1 = 0.f, s2 = 0.f;
#pragma unroll
        for (int j = 0; j < 8; ++j) { const f32x4 x = lp[j]; s1 += x.x + x.z; s2 += x.y + x.w; }
        const float mu = s1 * (1.0f / 1024.0f), var = s2 * (1.0f / 1024.0f) - mu * mu, rstd = 1.0f / sqrtf(var + EPS);
        const int col = g * 128 + q4; const f32x4 v = *(const f32x4*)(WSF(WS_V1) + row * D + col), lg = *(const f32x4*)(A.in[I_LNG] + col), lb = *(const f32x4*)(A.in[I_LNB] + col);
        *(LAS f32x4*)(vn + r * 128 + q4) = (v - mu) * rstd * lg + lb; }
    LDS_WAIT(); __syncthreads();
    const float* Wg = A.in[I_SGW] + (size_t)g * 128 * 128;
    for (int t = F.wave; t < 128; t += NWAVES) {
        const float* wr = Wg + t * 128; float a0 = 0.f, a1 = 0.f;
#pragma unroll 4
        for (int s = 0; s <= t; ++s) { const float w = wr[s]; const f32x2 v = *(const LAS f32x2*)(vn + s * 128 + 2 * lane); a0 += w * v.x; a1 += w * v.y; }
        const float bb = A.in[I_SGB][g * 128 + t]; const size_t off = ((size_t)c * 128 + t) * D + g * 128 + 2 * lane;
        const unsigned uu = *(const unsigned*)(WSB(WS_U1) + off);
        const float u0 = __builtin_bit_cast(float, uu << 16), u1 = __builtin_bit_cast(float, uu & 0xffff0000u);
        *(unsigned*)(WSB(WS_YAB) + off) = pk2(u0 * (a0 + bb), u1 * (a1 + bb));
    }
    __syncthreads();
}
__device__ __forceinline__ void sgu_sample(Frame& F, const Args& A, int b) {
    const int lane = LANE(); const float* v = SMP(SM_V1S) + (size_t)b * D; const float* u = SMP(SM_U1S) + (size_t)b * D;
    f32x4 x[4]; float s = 0.f;
#pragma unroll
    for (int j = 0; j < 4; ++j) { x[j] = *((const f32x4*)v + lane + 64 * j); s += pg8::sum4(x[j]); }
    const float mu = wave_sum(s) * (1.0f / D); float s2 = 0.f;
#pragma unroll
    for (int j = 0; j < 4; ++j) { x[j] = x[j] - mu; s2 += pg8::dot4(x[j]); }
    const float rstd = 1.0f / sqrtf(wave_sum(s2) * (1.0f / D) + EPS);
#pragma unroll
    for (int j = 0; j < 4; ++j) { const int col = (lane + 64 * j) * 4, g = col >> 7;
        const f32x4 vn = x[j] * rstd * *(const f32x4*)(A.in[I_LNG] + col) + *(const f32x4*)(A.in[I_LNB] + col);
        *(f32x4*)(F.out + O_VS + (size_t)b * D + col) = vn;
        const float w00 = A.in[I_SGW][(size_t)g * 128 * 128], b0 = A.in[I_SGB][g * 128];
        *(f32x4*)(SMP(SM_USS) + (size_t)b * D + col) = *(const f32x4*)(u + col) * (vn * w00 + b0); }
}

__global__ void __launch_bounds__(NWAVES * 64, 2) mega_fwd(Args args) {
    extern __shared__ __attribute__((aligned(16))) unsigned char lds[];
    Frame F;
    F.lds = (LAS unsigned char*)lds;
    F.MISC = (volatile LAS unsigned*)(F.lds + MISC_OFF);
    F.wave = __builtin_amdgcn_readfirstlane((int)threadIdx.x >> 6);
    F.G = gridDim.x; { const int bx = blockIdx.x; F.vcu = (F.G % 8 == 0) ? (bx % 8) * (F.G / 8) + bx / 8 : bx; }
    F.out = args.out; F.ws = args.ws;
    F.ctl = (gu32*)(args.ws + WS_CTL);
    for (int u = TID(); u < (LDS_BYTES - LDSCTL_OFF) / 4; u += NWAVES * 64) ((LAS unsigned*)(F.lds + LDSCTL_OFF))[u] = 0u;
    __syncthreads();
    XcdBarrier bar = xcd_barrier_post((unsigned*)(F.ctl + CW_BAR), F.MISC + 8);
    const int lo = args.ph_lo, hi = args.ph_hi;
#ifndef PHASE_MASK
#define PHASE_MASK 0xffffffffu
#endif
#define IN(k) (((PHASE_MASK >> (k)) & 1u) && lo <= (k) && (k) < hi)
#define BOTH(k) (IN(k) && IN((k) + 1))
#define GRID_BAR() xcd_barrier(bar)
    const int gw = F.vcu * NWAVES + F.wave, NGW = F.G * NWAVES;

    if (IN(0)) { p0_prologue(F, args); if (BOTH(0)) GRID_BAR(); }

    if (IN(1)) {
        if (gw < NS) sample_post(F, args, gw);
        for (int it = gw; it < NS * 511; it += NGW) { const int b = it / 511, r = it % 511;
            *((f32x4*)(F.out + O_WINS + ((size_t)b * 512 + r) * 256) + LANE()) = *((const f32x4*)(args.in[I_CWIN] + ((size_t)b * 512 + r + 1) * 256) + LANE()); }
        pg8::Gemm g{WSB(WS_HBA), WSB(WS_WIN0), T, EINP, D}; pg8::StaticOrder S; S.init(T, EINP, F.G, (int)blockIdx.x);
        pg8::EpiIn0 E{WSF(WS_RSA), WSF(WS_XA), WSF(WS_GG), WSF(WS_QR), F.out + O_KVP, WSF(WS_WINB), WSF(WS_GATE)};
        pg8::gemm_phase<pg8::EpiIn0, pg8::StaticOrder, PG8_ALIGN, PG8_SP2>(F.lds + RING_OFF, g, S, E, F.wave);
        if (BOTH(1)) GRID_BAR();
    }

    const LAS float* btab = (const LAS float*)(F.lds + BTAB_OFF);
    {   for (int i = TID(); i < 114 * 8; i += NWAVES * 64) { const int n = i >> 3;
            int bk = n; if (n >= 16) { bk = 16 + (n >= 19) + (n >= 21) + (n >= 24) + (n >= 27) + (n >= 31) + (n >= 35) + (n >= 40) + (n >= 46) + (n >= 52) + (n >= 59) + (n >= 67) + (n >= 77) + (n >= 87) + (n >= 99) + (n >= 113); }
            ((LAS float*)(F.lds + BTAB_OFF))[i] = args.in[I_RELB][bk * 8 + (i & 7)]; }
        LDS_WAIT(); __syncthreads(); }
    LAS float* red = (LAS float*)(F.lds + RING_OFF); LAS float* rsl = (LAS float*)(F.lds + RING_OFF + 8192);

    if (IN(2)) {
        LAS float* wscr = (LAS float*)(F.lds + RING_OFF + F.wave * 16384);
        for (int it = gw; it < 256; it += NGW) cmp_prompt_item(F, args, it >> 1, it & 1, wscr);
        for (int it = gw; it < 2048; it += NGW) rg1_item(F, args, it >> 3, it & 7, wscr);
        for (int t = gw; t < T; t += NGW) head_norm_token(F, args, t);
        __syncthreads();
        for (int it = F.vcu; it < NS * NPG; it += F.G) cmp_sample_item(F, args, it / NPG, it % NPG);
        if (BOTH(2)) GRID_BAR();
    }
    if (IN(3)) {
        LAS float* wscr = (LAS float*)(F.lds + RING_OFF + F.wave * 16384);
        for (int it = gw; it < NS * 2; it += NGW) attn_sample_item(F, args, it >> 1, it & 1, wscr, btab);
        for (int it = gw; it < 2048; it += NGW) rg3_item(F, args, it >> 3, it & 7);
        for (int it = gw; it < 2 * T; it += NGW) attn_prompt_item(F, args, it >> 1, it & 1, wscr, btab);
        __syncthreads();
        if (BOTH(3)) GRID_BAR();
    }
    if (IN(4)) {
        for (int cg = F.vcu; cg < D / 4; cg += F.G) { const float s = sgemm_cg(F, SMP(SM_YABS), D, nullptr, args.in[I_WOUTE], D, D, cg * 4, red);
            if (TID() < 128) { const int r = TID() & 31, n = cg * 4 + (TID() >> 5); SMP(SM_YS0)[r * D + n] = args.in[I_XS][r * D + n] + s; } }
        pg8::Gemm g{WSB(WS_YAB), WSB(WS_WOUT0), T, D, D}; pg8::StaticOrder S; S.init(T, D, F.G, (int)blockIdx.x);
        pg8::EpiRes E{args.in[I_XP], F.out + O_YP, WSB(WS_HBB), WSF(WS_RSB)};
        pg8::gemm_phase<pg8::EpiRes, pg8::StaticOrder, PG8_ALIGN, PG8_SP2>(F.lds + RING_OFF, g, S, E, F.wave);
        if (BOTH(4)) GRID_BAR();
    }
#define MLP_PLE_PHASES(P, L, HB_IN, RS_IN, HB_MID, RS_MID, YS_IN, YS_OUT, YS_OUT_LD)                                                                                   \
                                                                                                                                   \
    if (IN(P)) {                                                                                                                                                    \
        sample_rstd(F, YS_IN, rsl);                                                                                                                                 \
        for (int cg = F.vcu; cg < FF / 4; cg += F.G) { const float s = sgemm_cg(F, YS_IN, D, args.in[I_GMLP] + (L) * D, args.in[I_WUP] + (size_t)(L) * D * FF, FF, D, cg * 4, red); \
            if (TID() < 128) { const int r = TID() & 31, n = cg * 4 + (TID() >> 5); const float z = s * rsl[r], zr = z > 0.f ? z : 0.f; SMP(SM_US)[r * FF + n] = zr * zr; } }  \
        __syncthreads();                                                                                                                                            \
        pg8::Gemm g{HB_IN, WSB(WS_WUP) + (size_t)(L) * D * FF, T, FF, D}; pg8::StaticOrder S; S.init(T, FF, F.G, (int)blockIdx.x);                                  \
        pg8::EpiUp E{RS_IN, WSB(WS_U)};                                                                                                                             \
        pg8::gemm_phase<pg8::EpiUp, pg8::StaticOrder, PG8_ALIGN, PG8_SP2>(F.lds + RING_OFF, g, S, E, F.wave);                                                               \
        if (BOTH(P)) GRID_BAR();                                                                                                                                    \
    }                                                                                                                                                               \
                                                                                                                                     \
    if (IN((P) + 1)) {                                                                                                                                              \
        for (int cg = F.vcu; cg < D / 4; cg += F.G) { const float s = sgemm_cg(F, SMP(SM_US), FF, nullptr, args.in[I_WDOWN] + (size_t)(L) * D * FF, D, FF, cg * 4, red); \
            if (TID() < 128) { const int r = TID() & 31, n = cg * 4 + (TID() >> 5); YS_IN[r * D + n] += s; } }                                                       \
        pg8::Gemm g{WSB(WS_U), WSB(WS_WDOWN) + (size_t)(L) * D * FF, T, D, FF}; pg8::StaticOrder S; S.init(T, D, F.G, (int)blockIdx.x);                             \
        pg8::EpiRes E{F.out + O_YP, F.out + O_YP, HB_MID, RS_MID};                                                                                                  \
        pg8::gemm_phase<pg8::EpiRes, pg8::StaticOrder, PG8_ALIGN, PG8_SP2>(F.lds + RING_OFF, g, S, E, F.wave);                                                              \
        if (BOTH((P) + 1)) GRID_BAR();                                                                                                                              \
    }                                                                                                                                                               \
                                                                                                      \
    if (IN((P) + 2)) {                                                                                                                                              \
        sample_rstd(F, YS_IN, rsl);                                                                                                                                 \
        for (int cg = F.vcu; cg < D / 4; cg += F.G) {                                                                                                               \
            const float sg = sgemm_cg(F, YS_IN, D, args.in[I_GPLE] + (L) * D, args.in[I_WPG] + (size_t)(L) * D * D, D, D, cg * 4, red);                              \
            const float sp = sgemm_cg(F, args.in[I_PS] + (size_t)(L) * NS * PLE, PLE, nullptr, args.in[I_WPP] + (size_t)(L) * PLE * D, D, PLE, cg * 4, red);         \
            if (TID() < 128) { const int r = TID() & 31, n = cg * 4 + (TID() >> 5); YS_OUT[(size_t)r * YS_OUT_LD + n] = YS_IN[r * D + n] + sigmoidf_(sg * rsl[r]) * sp; } } \
        __syncthreads();                                                                                                                                            \
        { pg8::Gemm g{WSB(WS_PB) + (size_t)(L) * T * PLE, WSB(WS_WPROJ) + (size_t)(L) * PLE * D, T, D, PLE}; pg8::StaticOrder S; S.init(T, D, F.G, (int)blockIdx.x); \
          pg8::EpiProj E{WSF(WS_PP)};                                                                                                                               \
          pg8::gemm_phase<pg8::EpiProj, pg8::StaticOrder, PG8_ALIGN, PG8_SP2>(F.lds + RING_OFF, g, S, E, F.wave); }                                                         \
        __syncthreads();                                                                                                                                            \
        { pg8::Gemm g{HB_MID, WSB(WS_WGATE) + (size_t)(L) * D * D, T, D, D}; pg8::StaticOrder S; S.init(T, D, F.G, (int)blockIdx.x);                                \
          pg8::EpiGate E{RS_MID, WSF(WS_PP), F.out + O_YP, HB_IN, RS_IN};                                                                                           \
          pg8::gemm_phase<pg8::EpiGate, pg8::StaticOrder, PG8_ALIGN, PG8_SP2>(F.lds + RING_OFF, g, S, E, F.wave); }                                                         \
        if (BOTH((P) + 2)) GRID_BAR();                                                                                                                              \
    }
    MLP_PLE_PHASES(5, 0, WSB(WS_HBB), WSF(WS_RSB), WSB(WS_HBA), WSF(WS_RSA), SMP(SM_YS0), SMP(SM_YS1), D)
    if (IN(8)) {
        sample_rstd(F, SMP(SM_YS1), rsl);
        for (int cg = F.vcu; cg < 2 * D / 4; cg += F.G) { const float s = sgemm_cg(F, SMP(SM_YS1), D, args.in[I_GMIX] + D, args.in[I_WINO], 2 * D, D, cg * 4, red);
            if (TID() < 128) { const int r = TID() & 31, n = cg * 4 + (TID() >> 5); const float z = gelu_tanh(s * rsl[r]); if (n < D) SMP(SM_U1S)[r * D + n] = z; else SMP(SM_V1S)[r * D + n - D] = z; } }
        __syncthreads();
        pg8::Gemm g{WSB(WS_HBB), WSB(WS_WIN1), T, 2 * D, D}; pg8::StaticOrder S; S.init(T, 2 * D, F.G, (int)blockIdx.x);
        pg8::EpiIn1 E{WSF(WS_RSB), WSB(WS_U1), WSF(WS_V1), WSF(WS_LNS)};
        pg8::gemm_phase<pg8::EpiIn1, pg8::StaticOrder, PG8_ALIGN, PG8_SP2>(F.lds + RING_OFF, g, S, E, F.wave);
        if (BOTH(8)) GRID_BAR();
    }
    if (IN(9)) {
        if (gw < NS) sgu_sample(F, args, gw);
        __syncthreads();
        for (int it = F.vcu; it < 128 * 8; it += F.G) sgu_item(F, args, it >> 3, it & 7);
        if (BOTH(9)) GRID_BAR();
    }
    if (IN(10)) {
        for (int cg = F.vcu; cg < D / 4; cg += F.G) { const float s = sgemm_cg(F, SMP(SM_USS), D, nullptr, args.in[I_WOUTO], D, D, cg * 4, red);
            if (TID() < 128) { const int r = TID() & 31, n = cg * 4 + (TID() >> 5); SMP(SM_YS1)[r * D + n] += s; } }
        pg8::Gemm g{WSB(WS_YAB), WSB(WS_WOUT1), T, D, D}; pg8::StaticOrder S; S.init(T, D, F.G, (int)blockIdx.x);
        pg8::EpiRes E{F.out + O_YP, F.out + O_YP, WSB(WS_HBA), WSF(WS_RSA)};
        pg8::gemm_phase<pg8::EpiRes, pg8::StaticOrder, PG8_ALIGN, PG8_SP2>(F.lds + RING_OFF, g, S, E, F.wave);
        if (BOTH(10)) GRID_BAR();
    }
    MLP_PLE_PHASES(11, 1, WSB(WS_HBA), WSF(WS_RSA), WSB(WS_HBB), WSF(WS_RSB), SMP(SM_YS1), (F.out + O_YS), D)
#if DBG_SCALE_MASK
    {
        GRID_BAR();
#define SCALE_REGION(o, lo_, hi_) if ((DBG_SCALE_MASK >> (o)) & 1) { for (size_t i = (lo_) + (size_t)gw * 64 + LANE(); i < (hi_); i += (size_t)NGW * 64) F.out[i] *= 4.0f; }
        SCALE_REGION(0, O_YP, O_YS) SCALE_REGION(1, O_YS, O_KVP) SCALE_REGION(2, O_KVP, O_KVS) SCALE_REGION(3, O_KVS, O_WINP) SCALE_REGION(4, O_WINP, O_WINS) SCALE_REGION(5, O_WINS, O_CONVP)
        SCALE_REGION(6, O_CONVP, O_CONVS) SCALE_REGION(7, O_CONVS, O_HP) SCALE_REGION(8, O_HP, O_HS) SCALE_REGION(9, O_HS, O_VS) SCALE_REGION(10, O_VS, O_END)
#undef SCALE_REGION
    }
#endif
#undef IN
#undef BOTH
}

extern "C" void kernel_launch(void* const* d_in, const int* in_sizes, int n_in, void* d_out, int out_size, void* d_ws, size_t ws_size, hipStream_t stream) {
    static int grid = 0;
    if (grid == 0) {
        if (n_in != N_IN || (size_t)out_size != O_END || ws_size < WS_END) { fprintf(stderr, "kernel_launch: unexpected sizes n_in %d out %d ws %zu\n", n_in, out_size, ws_size); grid = -1; return; }
        int dev = 0, cus = 0, per_cu = 0;
        if (hipGetDevice(&dev) != hipSuccess || hipDeviceGetAttribute(&cus, hipDeviceAttributeMultiprocessorCount, dev) != hipSuccess) { grid = -1; return; }
        if (hipFuncSetAttribute((const void*)mega_fwd, hipFuncAttributeMaxDynamicSharedMemorySize, LDS_BYTES) != hipSuccess) { grid = -1; return; }
        if (hipOccupancyMaxActiveBlocksPerMultiprocessor(&per_cu, (const void*)mega_fwd, NWAVES * 64, LDS_BYTES) != hipSuccess || per_cu < 1)
            fprintf(stderr, "kernel_launch: occupancy query reports %d workgroups per CU\n", per_cu);
        (void)hipGetLastError();
        grid = cus;
    }
    if (grid < 0) return;
    if (hipMemsetAsync((char*)d_ws + WS_CTL, 0, CTL_ZERO_BYTES, stream) != hipSuccess) return;
    Args a{};
    for (int i = 0; i < N_IN; ++i) a.in[i] = (const float*)d_in[i];
    a.out = (float*)d_out; a.ws = (unsigned char*)d_ws;
    a.ph_lo = 0; a.ph_hi = 64;
    hipLaunchKernelGGL(mega_fwd, dim3(grid), dim3(NWAVES * 64), LDS_BYTES, stream, a);
}
```

```cpp
#include <hip/hip_runtime.h>
#include <cstdio>
#include <cstdint>
#define DBG_ZERO_OUT 0
#define DBG_SCALE_MASK 0
#define DBG_TIME_PHASE (-1)
#define ATTN_IMPL 1
#define CMPS_IMPL 1
#define SATTN_IMPL 1
#define ATTN_DBUF 0
#define HOTBLK 0
#define DBG_SECT (-1)
#define DBG_SECT2 (-1)
#define CMPP_IMPL 1
#define KV_NT 0
#define CMPP_SPLIT 1
#define ATTN_PACK 2
#define SEL_FP8 1
#define FUSE_HEADNORM 1
namespace pg8 {
#define PG8_LAS __attribute__((address_space(3)))
typedef unsigned short bf16_t;
typedef short bf16x8 __attribute__((ext_vector_type(8)));
typedef float f32x4 __attribute__((ext_vector_type(4)));
typedef unsigned u32x4 __attribute__((ext_vector_type(4)));
constexpr int BM = 256, BK = 64, HALF = 128, HTB = HALF * BK * 2  , STAGE_BYTES = 8 * HTB, NXCD = 8, WGM = 8;

__host__ __device__ __forceinline__ int lds_byte(int r, int c) { const int st = (r >> 4) * 2 + (c >> 5), rr = r & 15, cc = c & 31, ob = rr * 64 + cc * 2; return st * 1024 + (ob ^ (((ob >> 9) & 1) << 5)); }
__host__ __device__ __forceinline__ void stage_rc(int b, int& R, int& C) { const int st = b / 1024, sb = b % 1024, swz = sb ^ (((sb >> 9) & 1) << 5); R = (st >> 1) * 16 + swz / 64; C = (st & 1) * 32 + (swz % 64) / 2; }
__host__ __device__ __forceinline__ int perm32(int rho) { const int n = rho >> 4, i = rho & 15; return 8 * (i >> 2) + 4 * n + (i & 3); }

struct Unit { int pm, pn; };
struct Gemm { const bf16_t* A; const bf16_t* Bt; int M, N, K; };

struct StaticOrder {
    int nM, nN, nwg, G, c;
    __host__ __device__ void init(int M, int N, int G_, int c_) { nM = M / BM; nN = N / BM; nwg = nM * nN; G = G_; c = c_; }
    __host__ __device__ bool next(int i, Unit& u) const {
        const long L = (long)i * G + c; if (L >= nwg) return false;
        int wgid = (int)L; { const int q = nwg / NXCD, r = nwg % NXCD, xcd = wgid % NXCD, off = wgid / NXCD; wgid = (xcd < r ? xcd * (q + 1) : r * (q + 1) + (xcd - r) * q) + off; }
        const int nig = WGM * nN, gid = wgid / nig, fm = gid * WGM, gsz = (nM - fm) < WGM ? (nM - fm) : WGM;
        u.pm = fm + ((wgid % nig) % gsz); u.pn = (wgid % nig) / gsz; return true;
    }
    __device__ __forceinline__ void a_ready(const Unit&) const {}
    __device__ __forceinline__ void done(const Unit&) const {}
};


__device__ __forceinline__ unsigned cvt_pk_bf16(float lo, float hi) { unsigned r; asm volatile("v_cvt_pk_bf16_f32 %0, %1, %2" : "=v"(r) : "v"(lo), "v"(hi)); return r; }
typedef unsigned u32x2 __attribute__((ext_vector_type(2)));
__device__ __forceinline__ float dot4(const f32x4 a) { return (a[0] * a[0] + a[1] * a[1]) + (a[2] * a[2] + a[3] * a[3]); }
__device__ __forceinline__ float sum4(const f32x4 a) { return (a[0] + a[1]) + (a[2] + a[3]); }
__device__ __forceinline__ float row_rstd16(const float* rs, int row) {
    const f32x4* p = (const f32x4*)(rs + (size_t)row * 16);
    const f32x4 a = p[0], b = p[1], c = p[2], d = p[3];
    const float s = (sum4(a) + sum4(b)) + (sum4(c) + sum4(d));
    return 1.0f / sqrtf(s * (1.0f / 1024.0f) + 1e-6f);
}
__device__ __forceinline__ float gelu_tanh(float x) { const float u2 = (-2.0f * 0.7978845608028654f * 1.4426950408889634f) * (x + 0.044715f * x * x * x); return x * __builtin_amdgcn_rcpf(1.0f + __builtin_amdgcn_exp2f(u2)); }
__device__ __forceinline__ float sigmoidf_(float x) { return __builtin_amdgcn_rcpf(1.0f + __builtin_amdgcn_exp2f(-1.4426950408889634f * x)); }
__device__ __forceinline__ void st_bf16x4(bf16_t* p, const f32x4 v) { u32x2 w; w.x = cvt_pk_bf16(v[0], v[1]); w.y = cvt_pk_bf16(v[2], v[3]); *(u32x2*)p = w; }

__device__ __forceinline__ int epi_kv_off_k(int r, int d) { return (((r >> 4) * 2 + (d >> 5)) * 64 + ((d & 31) >> 3) * 16 + (r & 15)) * 8 + (d & 7); }
struct EpiIn0 {
    static constexpr bool PERM = false, AFTER_DRAIN = false;
    const float* rs; float* xa; bf16_t* gg; float* qr; float* kvp; float* win; float* gate;
    const float* qgain; const float* kgain; bf16_t* kvs; bf16_t* kvw; float* winp; float* convp; int nrows;
    template <int TYPE>
    __device__ __forceinline__ void head_tile(const f32x4 (&acc)[2][2][4][2], const Unit& u, int wr, int wc, int fr, int fq) const {
        const bool normed = TYPE == 0 || ((TYPE == 2 || TYPE == 3) && wc < 2);
        const float* gp = TYPE == 0 ? qgain : (TYPE == 2 ? kgain + 64 : kgain + 128);
#pragma unroll
        for (int ai = 0; ai < 2; ++ai)
#pragma unroll
            for (int m = 0; m < 4; ++m) {
                const int row = u.pm * BM + ai * HALF + wr * 64 + m * 16 + fr;
                const float rstd = row_rstd16(rs, row);
                f32x4 z[2][2]; float ss = 0.f;
#pragma unroll
                for (int bj = 0; bj < 2; ++bj)
#pragma unroll
                    for (int n = 0; n < 2; ++n) { z[bj][n] = acc[ai][bj][m][n] * rstd; ss += dot4(z[bj][n]); }
                float hs = 1.0f;
                if (TYPE != 1) { ss += __shfl_xor(ss, 16); ss += __shfl_xor(ss, 32); if (normed) hs = 1.0f / sqrtf(ss * (1.0f / 64.0f) + 1e-6f); }
                float* f32dst = TYPE == 0 ? qr + (size_t)row * 512 + (u.pn - 4) * 256 + 64 * wc + 4 * fq
                              : (TYPE == 3 ? win + (size_t)row * 256 + 64 * wc + 4 * fq : kvp + (size_t)row * 512 + (TYPE - 1) * 256 + 64 * wc + 4 * fq);
#pragma unroll
                for (int bj = 0; bj < 2; ++bj)
#pragma unroll
                    for (int n = 0; n < 2; ++n) {
                        const int d0 = 32 * bj + 16 * n, d = d0 + 4 * fq;
                        f32x4 v = z[bj][n]; if (normed) v = v * hs * *(const f32x4*)(gp + d);
                        *(f32x4*)(f32dst + d0) = v;
                        if (TYPE == 3) { if (row >= nrows - 512) *(f32x4*)(winp + (size_t)(row - (nrows - 512)) * 256 + 64 * wc + d) = v; }
                    }
                asm volatile("" ::: "memory");
            }
    }
    __device__ __forceinline__ void operator()(const f32x4 (&acc)[2][2][4][2], const Unit& u, int wr, int wc, int fr, int fq) const {
        if (u.pn == 4 || u.pn == 5) { head_tile<0>(acc, u, wr, wc, fr, fq); return; }
        if (u.pn == 6) { head_tile<1>(acc, u, wr, wc, fr, fq); return; }
        if (u.pn == 7) { head_tile<2>(acc, u, wr, wc, fr, fq); return; }
        if (u.pn == 8) { head_tile<3>(acc, u, wr, wc, fr, fq); return; }
#pragma unroll
        for (int ai = 0; ai < 2; ++ai)
#pragma unroll
            for (int m = 0; m < 4; ++m) {
                const int row = u.pm * BM + ai * HALF + wr * 64 + m * 16 + fr;
                const float rstd = row_rstd16(rs, row);
#pragma unroll
                for (int bj = 0; bj < 2; ++bj)
#pragma unroll
                    for (int n = 0; n < 2; ++n) {
                        const int cb = u.pn * BM + bj * HALF, col = cb + wc * 32 + n * 16 + fq * 4;
                        f32x4 z = acc[ai][bj][m][n] * rstd;
                        if (cb < 512) { *(f32x4*)(xa + (size_t)row * 512 + col) = z; if (row >= nrows - 3) *(f32x4*)(convp + (size_t)(row - (nrows - 3)) * 512 + col) = z; }
                        else if (cb < 1024) { z[0] = gelu_tanh(z[0]); z[1] = gelu_tanh(z[1]); z[2] = gelu_tanh(z[2]); z[3] = gelu_tanh(z[3]); st_bf16x4(gg + (size_t)row * 512 + (col - 512), z); }
                        else if (col < 2328) { z[0] = sigmoidf_(z[0]); z[1] = sigmoidf_(z[1]); z[2] = sigmoidf_(z[2]); z[3] = sigmoidf_(z[3]); *(f32x4*)(gate + (size_t)row * 24 + (col - 2304)) = z; }
                    }
            }
    }
};
__device__ __forceinline__ void ld_bf16x8(const bf16_t* p, f32x4& a, f32x4& b) { const u32x4 w = *(const u32x4*)p;
    a[0] = __uint_as_float(w.x << 16); a[1] = __uint_as_float(w.x & 0xffff0000u); a[2] = __uint_as_float(w.y << 16); a[3] = __uint_as_float(w.y & 0xffff0000u);
    b[0] = __uint_as_float(w.z << 16); b[1] = __uint_as_float(w.z & 0xffff0000u); b[2] = __uint_as_float(w.w << 16); b[3] = __uint_as_float(w.w & 0xffff0000u); }
template <bool RB, bool WY>
struct EpiRes {
    static constexpr bool PERM = true, AFTER_DRAIN = false;
    const float* resid; const bf16_t* resid_b; float* y; bf16_t* hb; float* rs;
    __device__ __forceinline__ void operator()(const f32x4 (&acc)[2][2][4][2], const Unit& u, int wr, int wc, int fr, int fq) const {
#pragma unroll
        for (int ai = 0; ai < 2; ++ai)
#pragma unroll
            for (int m = 0; m < 4; ++m) {
                const int row = u.pm * BM + ai * HALF + wr * 64 + m * 16 + fr;
                float ss = 0.f;
#pragma unroll
                for (int bj = 0; bj < 2; ++bj) {
                    const size_t off = (size_t)row * 1024 + (u.pn * BM + bj * HALF + wc * 32 + 8 * fq);
                    f32x4 r0, r1; if (RB) ld_bf16x8(resid_b + off, r0, r1); else { r0 = *(const f32x4*)(resid + off); r1 = *(const f32x4*)(resid + off + 4); }
                    const f32x4 v0 = acc[ai][bj][m][0] + r0, v1 = acc[ai][bj][m][1] + r1;
                    if (WY) { *(f32x4*)(y + off) = v0; *(f32x4*)(y + off + 4) = v1; } ss += dot4(v0) + dot4(v1);
                    u32x4 w; w.x = cvt_pk_bf16(v0[0], v0[1]); w.y = cvt_pk_bf16(v0[2], v0[3]); w.z = cvt_pk_bf16(v1[0], v1[1]); w.w = cvt_pk_bf16(v1[2], v1[3]);
                    *(u32x4*)(hb + off) = w;
                }
                ss += __shfl_xor(ss, 16); ss += __shfl_xor(ss, 32);
                if (fq == 0) rs[(size_t)row * 16 + u.pn * 4 + wc] = ss;
                if (m == 3) asm volatile("" ::: "memory");
            }
    }
};
struct EpiUp {
    static constexpr bool PERM = true, AFTER_DRAIN = false;
    const float* rs; bf16_t* o;
    __device__ __forceinline__ void operator()(const f32x4 (&acc)[2][2][4][2], const Unit& u, int wr, int wc, int fr, int fq) const {
#pragma unroll
        for (int ai = 0; ai < 2; ++ai)
#pragma unroll
            for (int m = 0; m < 4; ++m) {
                const int row = u.pm * BM + ai * HALF + wr * 64 + m * 16 + fr;
                const float rstd = row_rstd16(rs, row);
#pragma unroll
                for (int bj = 0; bj < 2; ++bj) {
                    const size_t off = (size_t)row * 4096 + (u.pn * BM + bj * HALF + wc * 32 + 8 * fq);
                    f32x4 z0 = acc[ai][bj][m][0] * rstd, z1 = acc[ai][bj][m][1] * rstd;
#pragma unroll
                    for (int j = 0; j < 4; ++j) { const float t0 = z0[j] > 0.f ? z0[j] : 0.f, t1 = z1[j] > 0.f ? z1[j] : 0.f; z0[j] = t0 * t0; z1[j] = t1 * t1; }
                    u32x4 w; w.x = cvt_pk_bf16(z0[0], z0[1]); w.y = cvt_pk_bf16(z0[2], z0[3]); w.z = cvt_pk_bf16(z1[0], z1[1]); w.w = cvt_pk_bf16(z1[2], z1[3]);
                    *(u32x4*)(o + off) = w;
                }
            }
    }
};
struct EpiProj {
    static constexpr bool PERM = false, AFTER_DRAIN = false;
    bf16_t* pp;
    __device__ __forceinline__ void operator()(const f32x4 (&acc)[2][2][4][2], const Unit& u, int wr, int wc, int fr, int fq) const {
#pragma unroll
        for (int ai = 0; ai < 2; ++ai)
#pragma unroll
            for (int m = 0; m < 4; ++m) {
                const int row = u.pm * BM + ai * HALF + wr * 64 + m * 16 + fr;
#pragma unroll
                for (int bj = 0; bj < 2; ++bj)
#pragma unroll
                    for (int n = 0; n < 2; ++n) st_bf16x4(pp + (size_t)row * 1024 + (u.pn * BM + bj * HALF + wc * 32 + n * 16 + fq * 4), acc[ai][bj][m][n]);
            }
    }
};
template <bool WY>
struct EpiGate {
    static constexpr bool PERM = true, AFTER_DRAIN = false;
    const float* rs_in; const bf16_t* pp; const bf16_t* yb; float* y; bf16_t* hb; float* rs_out;
    __device__ __forceinline__ void operator()(const f32x4 (&acc)[2][2][4][2], const Unit& u, int wr, int wc, int fr, int fq) const {
#pragma unroll
        for (int ai = 0; ai < 2; ++ai)
#pragma unroll
            for (int m = 0; m < 4; ++m) {
                const int row = u.pm * BM + ai * HALF + wr * 64 + m * 16 + fr;
                const float rstd = row_rstd16(rs_in, row);
                float ss = 0.f;
#pragma unroll
                for (int bj = 0; bj < 2; ++bj) {
                    const size_t off = (size_t)row * 1024 + (u.pn * BM + bj * HALF + wc * 32 + 8 * fq);
                    const f32x4 z0 = acc[ai][bj][m][0] * rstd, z1 = acc[ai][bj][m][1] * rstd; f32x4 p0, p1; ld_bf16x8(pp + off, p0, p1);
                    f32x4 v0, v1; ld_bf16x8(yb + off, v0, v1);
#pragma unroll
                    for (int j = 0; j < 4; ++j) { v0[j] += sigmoidf_(z0[j]) * p0[j]; v1[j] += sigmoidf_(z1[j]) * p1[j]; }
                    if (WY) { *(f32x4*)(y + off) = v0; *(f32x4*)(y + off + 4) = v1; } ss += dot4(v0) + dot4(v1);
                    u32x4 w; w.x = cvt_pk_bf16(v0[0], v0[1]); w.y = cvt_pk_bf16(v0[2], v0[3]); w.z = cvt_pk_bf16(v1[0], v1[1]); w.w = cvt_pk_bf16(v1[2], v1[3]);
                    if (!WY) *(u32x4*)(hb + off) = w;
                }
                ss += __shfl_xor(ss, 16); ss += __shfl_xor(ss, 32);
                if (!WY && fq == 0) rs_out[(size_t)row * 16 + u.pn * 4 + wc] = ss;
                if (m == 3) asm volatile("" ::: "memory");
            }
    }
};
struct EpiIn1 {
    static constexpr bool PERM = false, AFTER_DRAIN = false;
    const float* rs; bf16_t* u1; bf16_t* v1; float* lns;
    __device__ __forceinline__ void operator()(const f32x4 (&acc)[2][2][4][2], const Unit& u, int wr, int wc, int fr, int fq) const {
#pragma unroll
        for (int ai = 0; ai < 2; ++ai)
#pragma unroll
            for (int m = 0; m < 4; ++m) {
                const int row = u.pm * BM + ai * HALF + wr * 64 + m * 16 + fr;
                const float rstd = row_rstd16(rs, row);
                float s1 = 0.f, s2 = 0.f;
#pragma unroll
                for (int bj = 0; bj < 2; ++bj)
#pragma unroll
                    for (int n = 0; n < 2; ++n) {
                        const int col = u.pn * BM + bj * HALF + wc * 32 + n * 16 + fq * 4;
                        f32x4 z = acc[ai][bj][m][n] * rstd;
#pragma unroll
                        for (int j = 0; j < 4; ++j) z[j] = gelu_tanh(z[j]);
                        if (col < 1024) st_bf16x4(u1 + (size_t)row * 1024 + col, z);
                        else { st_bf16x4(v1 + (size_t)row * 1024 + (col - 1024), z); s1 += sum4(z); s2 += dot4(z); }
                    }
                if (u.pn >= 4) {
                    s1 += __shfl_xor(s1, 16); s1 += __shfl_xor(s1, 32); s2 += __shfl_xor(s2, 16); s2 += __shfl_xor(s2, 32);
                    if (fq == 0) { float* p = lns + ((size_t)row * 16 + (u.pn - 4) * 4 + wc) * 2; p[0] = s1; p[1] = s2; }
                }
            }
    }
};

template <class Epi, class Sched, bool ALIGN_EPI = false, bool SP2 = false>
__device__ __forceinline__ void gemm_phase(PG8_LAS unsigned char* lds, const Gemm g, const Sched& S, const Epi& E, const int wid_in) {
    int lane_ = (int)__builtin_amdgcn_mbcnt_hi(~0u, __builtin_amdgcn_mbcnt_lo(~0u, 0u)); asm volatile("" : "+v"(lane_));
    const int wid = wid_in, lane = lane_, tid = wid * 64 + lane, wr = wid >> 2, wc = wid & 3, fr = lane & 15, fq = lane >> 4;
    const int K = g.K, nt = K / BK;
    unsigned voffA[2], voffB[2];
#pragma unroll
    for (int i = 0; i < 2; ++i) { int R, C; stage_rc(tid * 16 + i * 8192, R, C); const int Rb = Epi::PERM ? ((R & ~31) + perm32(R & 31)) : R;
        voffA[i] = (unsigned)(R * K + C) * 2u; voffB[i] = (unsigned)(Rb * K + C) * 2u; }
    const size_t kstep = (size_t)(BK * 2);
    const size_t hstep = (size_t)HALF * K * 2;
    const size_t tstep = 2 * hstep;
    const unsigned ldsw = (unsigned)wid * 1024u;
    const int aoff = lds_byte(wr * 64 + fr, fq * 8), boff = lds_byte(wc * 32 + fr, fq * 8);
#define PG8_SA(b, h) (((b) * 2 + (h)) * HTB)
#define PG8_SB(b, h) ((4 + (b) * 2 + (h)) * HTB)
#define PG8_STAGE(bufoff, gbase, voff) do { _Pragma("unroll") for (int _i = 0; _i < 2; ++_i) \
        __builtin_amdgcn_global_load_lds((const unsigned*)((const char*)(gbase) + (voff)[_i]), (PG8_LAS unsigned*)(lds + (bufoff) + ldsw + _i * 8192), 16, 0, 0); } while (0)
#define PG8_LDA(dst, b, h) do { _Pragma("unroll") for (int m = 0; m < 4; ++m) _Pragma("unroll") for (int k = 0; k < 2; ++k) dst[m][k] = *(const PG8_LAS bf16x8*)(lds + PG8_SA(b, h) + aoff + m * 2048 + k * 1024); } while (0)
#define PG8_LDB(dst, b, h) do { _Pragma("unroll") for (int n = 0; n < 2; ++n) _Pragma("unroll") for (int k = 0; k < 2; ++k) dst[n][k] = *(const PG8_LAS bf16x8*)(lds + PG8_SB(b, h) + boff + n * 2048 + k * 1024); } while (0)
#define PG8_MMA(ai, bj, At, Bt) do { __builtin_amdgcn_s_setprio(1); _Pragma("unroll") for (int m = 0; m < 4; ++m) _Pragma("unroll") for (int n = 0; n < 2; ++n) _Pragma("unroll") for (int k = 0; k < 2; ++k) \
        acc[ai][bj][m][n] = __builtin_amdgcn_mfma_f32_16x16x32_bf16(Bt[n][k], At[m][k], acc[ai][bj][m][n], 0, 0, 0); __builtin_amdgcn_s_setprio(0); } while (0)
#define PG8_WAIT_V(n) asm volatile("s_waitcnt vmcnt(" #n ")" ::: "memory")
#define PG8_WAIT_L(n) asm volatile("s_waitcnt lgkmcnt(" #n ")" ::: "memory")
#define PG8_BAR __builtin_amdgcn_s_barrier()
#define PG8_SCHED __builtin_amdgcn_sched_barrier(0)
    Unit cur, nxt; int ui = 0;
    if (!S.next(0, cur)) return;
    f32x4 acc[2][2][4][2];
#pragma unroll
    for (int a = 0; a < 2; ++a)
#pragma unroll
        for (int b = 0; b < 2; ++b)
#pragma unroll
            for (int m = 0; m < 4; ++m)
#pragma unroll
                for (int n = 0; n < 2; ++n) acc[a][b][m][n] = (f32x4){0.f, 0.f, 0.f, 0.f};
    bf16x8 At[4][2], B0[2][2], B1[2][2];
    const char* cA = (const char*)g.A + (size_t)cur.pm * tstep; const char* cB = (const char*)g.Bt + (size_t)cur.pn * tstep;
    S.a_ready(cur);
    if constexpr (SP2) {
        PG8_STAGE(PG8_SB(0, 0), cB, voffB); PG8_STAGE(PG8_SB(0, 1), cB + hstep, voffB); PG8_STAGE(PG8_SA(0, 0), cA, voffA); PG8_STAGE(PG8_SA(0, 1), cA + hstep, voffA);
        if (wr == 1) PG8_BAR;
        PG8_WAIT_V(2); PG8_BAR;
        PG8_STAGE(PG8_SB(1, 0), cB + kstep, voffB); PG8_STAGE(PG8_SA(1, 0), cA + kstep, voffA); PG8_STAGE(PG8_SB(1, 1), cB + hstep + kstep, voffB);
        PG8_WAIT_V(6); PG8_BAR;
    } else {
        PG8_STAGE(PG8_SB(0, 0), cB, voffB); PG8_STAGE(PG8_SA(0, 0), cA, voffA); PG8_STAGE(PG8_SB(0, 1), cB + hstep, voffB); PG8_STAGE(PG8_SA(0, 1), cA + hstep, voffA);
        if (wr == 1) PG8_BAR;
        PG8_WAIT_V(4); PG8_BAR;
        PG8_STAGE(PG8_SB(1, 0), cB + kstep, voffB); PG8_STAGE(PG8_SA(1, 0), cA + kstep, voffA); PG8_STAGE(PG8_SB(1, 1), cB + hstep + kstep, voffB);
        PG8_WAIT_V(6); PG8_BAR;
    }
    for (;;) {
        const bool has_next = S.next(ui + 1, nxt);
        const char* nA = has_next ? (const char*)g.A + (size_t)nxt.pm * tstep : cA; const char* nB = has_next ? (const char*)g.Bt + (size_t)nxt.pn * tstep : cB;
        for (int t = 0; t < nt; t += 2) {
            const bool last = (t == nt - 2);
            const char* a1 = cA + (size_t)(t + 1) * kstep;
            const char* a2 = last ? nA : cA + (size_t)(t + 2) * kstep; const char* b2 = last ? nB : cB + (size_t)(t + 2) * kstep;
            const char* a3 = a2 + kstep; const char* b3 = b2 + kstep;
            if (last && has_next) S.a_ready(nxt);
            if constexpr (SP2) {
            PG8_LDB(B0, 0, 0); PG8_LDB(B1, 0, 1); PG8_SCHED; PG8_LDA(At, 0, 0); PG8_STAGE(PG8_SA(1, 1), a1 + hstep, voffA);
            PG8_WAIT_V(8); PG8_WAIT_L(0); PG8_BAR; PG8_MMA(0, 0, At, B0); PG8_MMA(0, 1, At, B1); PG8_BAR; PG8_SCHED;
            PG8_LDA(At, 0, 1); PG8_STAGE(PG8_SB(0, 0), b2, voffB); PG8_STAGE(PG8_SB(0, 1), b2 + hstep, voffB); PG8_STAGE(PG8_SA(0, 0), a2, voffA);
            PG8_WAIT_V(8); PG8_WAIT_L(0); PG8_BAR; PG8_MMA(1, 0, At, B0); PG8_MMA(1, 1, At, B1); PG8_BAR; PG8_SCHED;
            PG8_LDB(B0, 1, 0); PG8_LDB(B1, 1, 1); PG8_SCHED; PG8_LDA(At, 1, 0); PG8_STAGE(PG8_SA(0, 1), a2 + hstep, voffA);
            PG8_WAIT_V(8); PG8_WAIT_L(0); PG8_BAR; PG8_MMA(0, 0, At, B0); PG8_MMA(0, 1, At, B1); PG8_BAR; PG8_SCHED;
            PG8_LDA(At, 1, 1); PG8_STAGE(PG8_SB(1, 0), b3, voffB); PG8_STAGE(PG8_SB(1, 1), b3 + hstep, voffB); PG8_STAGE(PG8_SA(1, 0), a3, voffA);
            PG8_WAIT_V(8); PG8_WAIT_L(0); PG8_BAR; PG8_MMA(1, 0, At, B0); PG8_MMA(1, 1, At, B1); PG8_BAR; PG8_SCHED;
            } else {
            PG8_LDB(B0, 0, 0); PG8_SCHED; PG8_LDA(At, 0, 0); PG8_STAGE(PG8_SA(1, 1), a1 + hstep, voffA);
            PG8_WAIT_L(8); PG8_BAR; PG8_WAIT_L(0); PG8_MMA(0, 0, At, B0); PG8_BAR; PG8_SCHED;
            PG8_LDB(B1, 0, 1); PG8_STAGE(PG8_SB(0, 0), b2, voffB);
            PG8_BAR; PG8_WAIT_L(0); PG8_MMA(0, 1, At, B1); PG8_BAR;
            PG8_LDA(At, 0, 1); PG8_STAGE(PG8_SA(0, 0), a2, voffA);
            PG8_BAR; PG8_WAIT_L(0); PG8_MMA(1, 0, At, B0); PG8_BAR; PG8_SCHED;
            PG8_STAGE(PG8_SB(0, 1), b2 + hstep, voffB);
            PG8_WAIT_V(6); PG8_BAR; PG8_MMA(1, 1, At, B1); PG8_BAR;
            PG8_LDB(B0, 1, 0); PG8_SCHED; PG8_LDA(At, 1, 0); PG8_STAGE(PG8_SA(0, 1), a2 + hstep, voffA);
            PG8_WAIT_L(8); PG8_BAR; PG8_WAIT_L(0); PG8_MMA(0, 0, At, B0); PG8_BAR; PG8_SCHED;
            PG8_LDB(B1, 1, 1); PG8_STAGE(PG8_SB(1, 0), b3, voffB);
            PG8_BAR; PG8_WAIT_L(0); PG8_MMA(0, 1, At, B1); PG8_BAR;
            PG8_LDA(At, 1, 1); PG8_STAGE(PG8_SA(1, 0), a3, voffA);
            PG8_BAR; PG8_WAIT_L(0); PG8_MMA(1, 0, At, B0); PG8_BAR; PG8_SCHED;
            PG8_STAGE(PG8_SB(1, 1), b3 + hstep, voffB);
            PG8_WAIT_V(6); PG8_BAR; PG8_MMA(1, 1, At, B1); PG8_BAR;
            }
        }
        if constexpr (ALIGN_EPI) { if (wr == 0) PG8_BAR; }
        if constexpr (!Epi::AFTER_DRAIN) { E(acc, cur, wr, wc, fr, fq); S.done(cur); }
        if (!has_next) break;
#pragma unroll
        for (int a = 0; a < 2; ++a)
#pragma unroll
            for (int b = 0; b < 2; ++b)
#pragma unroll
                for (int m = 0; m < 4; ++m)
#pragma unroll
                    for (int n = 0; n < 2; ++n) acc[a][b][m][n] = (f32x4){0.f, 0.f, 0.f, 0.f};
        cur = nxt; cA = nA; cB = nB; ++ui;
        if constexpr (ALIGN_EPI) { if (wr == 1) PG8_BAR; }
    }
    PG8_WAIT_V(0);
    if constexpr (!ALIGN_EPI) { if (wr == 0) PG8_BAR; }
    PG8_BAR;
    if constexpr (Epi::AFTER_DRAIN) { E.fused(acc, cur, wr, wc, fr, fq, lds, wid, lane); S.done(cur); }
#undef PG8_SA
#undef PG8_SB
#undef PG8_STAGE
#undef PG8_LDA
#undef PG8_LDB
#undef PG8_MMA
#undef PG8_WAIT_V
#undef PG8_WAIT_L
#undef PG8_BAR
#undef PG8_SCHED
}
}

#ifndef PG8_SP2
#define PG8_SP2 true
#endif
#ifndef PG8_ALIGN
#define PG8_ALIGN true
#endif
constexpr int NWAVES = 8;
constexpr int T = 16384, D = 1024, FF = 4096, PLE = 256, NS = 32;
constexpr int LRU = 512, EIN = 2328, EINP = 2560;
constexpr int NPG = 128;
constexpr float EPS = 1e-6f;
constexpr size_t O_YP = 0, O_YS = 16777216, O_KVP = O_YS + 32768, O_KVS = O_KVP + 8388608, O_WINP = O_KVS + 16384, O_WINS = O_WINP + 131072,
                 O_CONVP = O_WINS + 4194304, O_CONVS = O_CONVP + 1536, O_HP = O_CONVS + 49152, O_HS = O_HP + 512, O_VS = O_HS + 16384, O_END = O_VS + 32768;
enum { I_XP = 0, I_XS, I_CKV, I_CWIN, I_SCONV, I_SH, I_PT, I_PP, I_PS, I_RELB, I_GMIX, I_GMLP, I_WUP, I_WDOWN, I_GPLE, I_WPG, I_WPP, I_WINE, I_WOUTE, I_CONVW, I_CONVB,
       I_WA, I_BA, I_WX, I_BX, I_LAM, I_QG, I_KG, I_CWK, I_CWV, I_PEK, I_PEV, I_WINO, I_LNG, I_LNB, I_SGW, I_SGB, I_WOUTO, N_IN };
constexpr size_t MiB = 1ull << 20;
constexpr size_t WS_CTL = 0, CTL_ZERO_BYTES = 1 * MiB;
constexpr size_t WS_WIN0 = 1 * MiB, WS_WOUT0 = 6 * MiB, WS_WUP = 8 * MiB, WS_WDOWN = 24 * MiB, WS_WGATE = 40 * MiB, WS_WPROJ = 44 * MiB, WS_WIN1 = 45 * MiB, WS_WOUT1 = 49 * MiB;
constexpr size_t WS_HBA = 52 * MiB, WS_HBB = 84 * MiB, WS_RSA = 116 * MiB, WS_RSB = 117 * MiB, WS_PB = 118 * MiB;
constexpr size_t WS_XA = 134 * MiB, WS_GG = 166 * MiB, WS_QR = 198 * MiB, WS_WINB = 230 * MiB, WS_GATE = 246 * MiB;
constexpr size_t WS_KC = 248 * MiB, WS_VC = 248 * MiB + 512 * 1024, WS_SUMP = 249 * MiB, WS_SUME = 249 * MiB + 512 * 1024;
constexpr size_t WS_HL = 250 * MiB, WS_CP = 282 * MiB, WS_YAB = 314 * MiB, WS_U = 346 * MiB, WS_PP = 474 * MiB, WS_U1 = 538 * MiB, WS_V1 = 570 * MiB, WS_LNS = 634 * MiB;
constexpr size_t WS_KCS = 636 * MiB, WS_VCS = 644 * MiB, WS_SMP = 652 * MiB;
constexpr size_t WS_KVS = 656 * MiB, WS_KVW = 664 * MiB, WS_KVC = 672 * MiB, WS_WCT = 674 * MiB, WS_KVCS = 675 * MiB, WS_KVWS = 683 * MiB, WS_SGWB = 691 * MiB, WS_PP1 = 692 * MiB, WS_END = 756 * MiB;
constexpr int SM_ZS = 0, SM_QS = 81920, SM_WNS = 98304, SM_GATES = 106496, SM_YABS = 114688, SM_YS0 = 147456, SM_YS1 = 180224, SM_US = 212992, SM_U1S = 344064, SM_V1S = 376832, SM_USS = 409600, SM_PPS = 442368, SM_END = 507904;
constexpr int SB_BASE = 2 * SM_END, SB_YABS = SB_BASE, SB_YS0 = SB_YABS + 32768, SB_YS1 = SB_YS0 + 32768, SB_US = SB_YS1 + 32768, SB_USS = SB_US + 131072, SB_PS = SB_USS + 32768, SB_END = SB_PS + 16384;
static_assert(SB_END * 2 <= 4 * (int)MiB, "sample buffers");
constexpr int CW_TMO = 0, CW_CODE = 1, CW_BAR = 4096;
constexpr int RING_OFF = 0, RING_BYTES = 131072;
constexpr int LDSCTL_OFF = RING_BYTES, MISC_OFF = LDSCTL_OFF + 320;
constexpr int BTAB_OFF = LDSCTL_OFF + 1024;
constexpr int LDS_BYTES = 147456;
static_assert(MISC_OFF + 128 <= BTAB_OFF && BTAB_OFF + 2 * 114 * 8 * 4 <= LDS_BYTES, "LDS map");

#define GAS __attribute__((address_space(1)))
#define LAS __attribute__((address_space(3)))
typedef unsigned short bf16;
typedef unsigned v4u __attribute__((ext_vector_type(4)));
typedef unsigned v2u __attribute__((ext_vector_type(2)));
typedef float f32x4 __attribute__((ext_vector_type(4)));
typedef float f32x2 __attribute__((ext_vector_type(2)));
typedef GAS unsigned gu32;
#define RLX_AGENT __ATOMIC_RELAXED, __HIP_MEMORY_SCOPE_AGENT
#define LDS_WAIT() asm volatile("s_waitcnt lgkmcnt(0)" ::: "memory")
#define VM_WAIT() asm volatile("s_waitcnt vmcnt(0)" ::: "memory")
__device__ __forceinline__ unsigned f2bf(float f) { unsigned u = __builtin_bit_cast(unsigned, f); return (u + 0x7fffu + ((u >> 16) & 1u)) >> 16; }
__device__ __forceinline__ unsigned pk2(float lo, float hi) { return f2bf(lo) | (f2bf(hi) << 16); }
using pg8::gelu_tanh; using pg8::sigmoidf_;

#define XB_TMO      128
#define XB_XCNT(j)  (256  + 64 * (j))
#define XB_XSUB(j)  (1280 + 64 * (j))
#define XB_XGEN(j)  (2304 + 64 * (j))
#define XB_TOP      3328
#define XB_TOPGEN   3392
#define XCD_BAR_WORDS 3456
#define XB_SPIN_CAP (1u << 18)

__device__ __forceinline__ unsigned xb_ld(unsigned* p)              { return __hip_atomic_load(p, __ATOMIC_RELAXED, __HIP_MEMORY_SCOPE_AGENT); }
__device__ __forceinline__ unsigned xb_add(unsigned* p, unsigned v) { return __hip_atomic_fetch_add(p, v, __ATOMIC_RELAXED, __HIP_MEMORY_SCOPE_AGENT); }
__device__ __forceinline__ unsigned xb_xcc_id() { return (unsigned)__builtin_amdgcn_s_getreg((3 << 11) | 20) & 0xFu; }
#define XB_SPIN(cond, bar) do { unsigned _sp = 0; while (cond) { __builtin_amdgcn_s_sleep(1); \
    if ((++_sp & 255u) == 0u) { if (xb_ld(&(bar)[XB_TMO])) break; if (_sp > XB_SPIN_CAP) { atomicAdd(&(bar)[XB_TMO], 1u); break; } } } } while (0)

struct XcdBarrier {
    unsigned* bar; unsigned x;
    volatile LAS unsigned* st;
};

__device__ __forceinline__ XcdBarrier xcd_barrier_post(unsigned* bar, volatile LAS unsigned* st) {
    XcdBarrier b; b.bar = bar; b.x = xb_xcc_id(); b.st = st;
    if (threadIdx.x == 0) (void)xb_add(&bar[XB_XCNT(b.x)], 1u);
    return b;
}
__device__ __forceinline__ void xcd_barrier_complete(unsigned* bar, unsigned x, unsigned& nloc, unsigned& nx) {
    const unsigned G = gridDim.x * gridDim.y * gridDim.z;
    unsigned sum, cnt, mine, sp = 0u;
    for (;;) {
        sum = 0u; cnt = 0u; mine = 0u;
#pragma unroll
        for (unsigned j = 0; j < 16; ++j) { const unsigned c = xb_ld(&bar[XB_XCNT(j)]); sum += c; cnt += (c > 0u) ? 1u : 0u; mine = (j == x) ? c : mine; }
        if (sum == G) break;
        __builtin_amdgcn_s_sleep(1);
        if ((++sp & 255u) == 0u) { if (xb_ld(&bar[XB_TMO])) break; if (sp > XB_SPIN_CAP) { atomicAdd(&bar[XB_TMO], 1u); break; } }
    }
    nloc = mine > 0u ? mine : 1u; nx = cnt > 0u ? cnt : 1u;
}

__device__ __forceinline__ void xcd_barrier(const XcdBarrier& b) {
    asm volatile("s_waitcnt vmcnt(0)" ::: "memory");
    __syncthreads();
    if (threadIdx.x == 0) {
        unsigned* bar = b.bar;
        __builtin_amdgcn_s_waitcnt(0);
        unsigned nloc = b.st[0], nx = b.st[1];
        if (nloc == 0u) { xcd_barrier_complete(bar, b.x, nloc, nx); b.st[0] = nloc; b.st[1] = nx; }
        const unsigned old = xb_add(&bar[XB_XSUB(b.x)], 1u);
        const unsigned gen = old / nloc;
        if (old + 1u == (gen + 1u) * nloc) {
            __builtin_amdgcn_fence(__ATOMIC_RELEASE, "agent");
            asm volatile("s_waitcnt vmcnt(0)" ::: "memory");
            const unsigned og = xb_add(&bar[XB_TOP], 1u);
            const unsigned tg = og / nx;
            if (og + 1u == (tg + 1u) * nx) xb_add(&bar[XB_TOPGEN], 1u);
            else XB_SPIN(xb_ld(&bar[XB_TOPGEN]) == tg, bar);
            __builtin_amdgcn_fence(__ATOMIC_ACQUIRE, "agent");
            xb_add(&bar[XB_XGEN(b.x)], 1u);
            asm volatile("s_waitcnt vmcnt(0)" ::: "memory");
        } else {
            XB_SPIN(xb_ld(&bar[XB_XGEN(b.x)]) == gen, bar);
            __builtin_amdgcn_fence(__ATOMIC_ACQUIRE, "agent");
            asm volatile("s_waitcnt vmcnt(0)" ::: "memory");
        }
    }
    __syncthreads();
}


struct Args { const float* in[N_IN]; float* out; unsigned char* ws; int ph_lo, ph_hi; };
struct Frame {
    LAS unsigned char* lds;
    volatile LAS unsigned* MISC;
    gu32* ctl;
    int wave;
    int vcu, G;
    float* out; unsigned char* ws;
};
__device__ __forceinline__ int lane_id_() { int l = (int)__builtin_amdgcn_mbcnt_hi(~0u, __builtin_amdgcn_mbcnt_lo(~0u, 0u)); asm volatile("" : "+v"(l)); return l; }
#define LANE() lane_id_()
#define TID() (F.wave * 64 + lane_id_())
#define WSF(off) ((float*)(F.ws + (off)))
#define WSB(off) ((bf16*)(F.ws + (off)))
#define SMP(off) ((float*)(F.ws + WS_SMP) + (off))
#define SMB(off) ((bf16*)(F.ws + WS_SMP) + (off))

__device__ __forceinline__ float wave_sum(float v) {
#pragma unroll
    for (int o = 1; o < 64; o <<= 1) v += __shfl_xor(v, o);
    return v;
}
__device__ __forceinline__ void transpose_item(const float* W, int K, int N, const float* gain, bf16* WT, LAS float* scr, int item, int lane, bool headperm = false) {
    const int nblk = (N + 31) / 32, kb = item / nblk, nb = item % nblk, k0 = 64 * kb, n0 = 32 * nb;
    const int r0 = (headperm && n0 >= 1024 && n0 < 2304) ? (n0 & ~255) + 128 * ((n0 >> 5) & 1) + 32 * ((n0 & 255) >> 6) : n0;
    {   float wv[32]; const int n = n0 + (lane & 31);
#pragma unroll
        for (int i = 0; i < 32; ++i) wv[i] = (n < N) ? W[(size_t)(k0 + 2 * i + (lane >> 5)) * N + n] : 0.f;
#pragma unroll
        for (int i = 0; i < 32; ++i) { const int kk = 2 * i + (lane >> 5); float v = wv[i]; if (gain) v *= gain[k0 + kk]; scr[kk * 33 + (lane & 31)] = v; } }
    LDS_WAIT();
    const int c = lane & 7;
#pragma unroll
    for (int j = 0; j < 4; ++j) { const int n = (lane >> 3) + 8 * j; const LAS float* s = scr + (8 * c) * 33 + n;
        v4u o; o.x = pk2(s[0 * 33], s[1 * 33]); o.y = pk2(s[2 * 33], s[3 * 33]); o.z = pk2(s[4 * 33], s[5 * 33]); o.w = pk2(s[6 * 33], s[7 * 33]);
        *(GAS v4u*)(WT + (size_t)(r0 + n) * K + k0 + 8 * c) = o; }
    LDS_WAIT();
}
__device__ __forceinline__ void x_row_to_bf16(int lane, const float* xrow, bf16* orow, float* rsrow) {
    const GAS f32x4* xr = (const GAS f32x4*)xrow + lane;
    f32x4 v[4]; float s = 0.f;
#pragma unroll
    for (int j = 0; j < 4; ++j) { v[j] = xr[64 * j]; s += (v[j].x * v[j].x + v[j].y * v[j].y) + (v[j].z * v[j].z + v[j].w * v[j].w); }
    s = wave_sum(s);
    GAS unsigned long long* o8 = (GAS unsigned long long*)orow + lane;
#pragma unroll
    for (int j = 0; j < 4; ++j) o8[64 * j] = (unsigned long long)pk2(v[j].x, v[j].y) | ((unsigned long long)pk2(v[j].z, v[j].w) << 32);
    if (lane < 16) rsrow[lane] = (lane == 0) ? s : 0.f;
}
__device__ __forceinline__ void x_row2_to_bf16(int lane, const float* xrow, bf16* orow, float* rsrow) {
    const GAS f32x4* xr = (const GAS f32x4*)xrow + lane;
    f32x4 v[8]; float s0 = 0.f, s1 = 0.f;
#pragma unroll
    for (int j = 0; j < 8; ++j) v[j] = xr[64 * j];
#pragma unroll
    for (int j = 0; j < 4; ++j) { s0 += (v[j].x * v[j].x + v[j].y * v[j].y) + (v[j].z * v[j].z + v[j].w * v[j].w); s1 += (v[4 + j].x * v[4 + j].x + v[4 + j].y * v[4 + j].y) + (v[4 + j].z * v[4 + j].z + v[4 + j].w * v[4 + j].w); }
    s0 = wave_sum(s0); s1 = wave_sum(s1);
    GAS unsigned long long* o8 = (GAS unsigned long long*)orow + lane;
#pragma unroll
    for (int j = 0; j < 8; ++j) o8[64 * j] = (unsigned long long)pk2(v[j].x, v[j].y) | ((unsigned long long)pk2(v[j].z, v[j].w) << 32);
    if (lane < 32) rsrow[lane] = (lane == 0) ? s0 : (lane == 16 ? s1 : 0.f);
}
__device__ __forceinline__ void sample_rstd(Frame& F, const float* Amat, LAS float* rs) {
#pragma unroll
    for (int i = 0; i < 4; ++i) { const int r = F.wave * 4 + i; const f32x4* p = (const f32x4*)(Amat + (size_t)r * D) + LANE(); float s = 0.f;
#pragma unroll
        for (int j = 0; j < 4; ++j) { const f32x4 v = p[64 * j]; s += (v.x * v.x + v.y * v.y) + (v.z * v.z + v.w * v.w); }
        s = wave_sum(s); if (LANE() == 0) rs[r] = 1.0f / sqrtf(s * (1.0f / D) + EPS); }
    LDS_WAIT(); __syncthreads();
}
__device__ __forceinline__ float sgemm_cg(Frame& F, const float* Amat, int lda, const float* gain, const float* W, int N, int K, int n0, LAS float* red) {
    const int r = LANE() & 31, kh = LANE() >> 5, ksl = K / 16, k0 = (F.wave * 2 + kh) * ksl;
    f32x4 acc = {0.f, 0.f, 0.f, 0.f};
    const float* ap = Amat + (size_t)r * lda + k0;
#pragma unroll 4
    for (int k = 0; k < ksl; k += 4) {
        f32x4 a = *(const f32x4*)(ap + k);
        if (gain) a = a * *(const f32x4*)(gain + k0 + k);
        const float* wp = W + (size_t)(k0 + k) * N + n0;
        const f32x4 w0 = *(const f32x4*)wp, w1 = *(const f32x4*)(wp + N), w2 = *(const f32x4*)(wp + 2 * (size_t)N), w3 = *(const f32x4*)(wp + 3 * (size_t)N);
        acc += w0 * a.x; acc += w1 * a.y; acc += w2 * a.z; acc += w3 * a.w;
    }
#pragma unroll
    for (int j = 0; j < 4; ++j) acc[j] += __shfl_xor(acc[j], 32);
    if (kh == 0) *(LAS f32x4*)(red + (F.wave * 32 + r) * 4) = acc;
    LDS_WAIT(); __syncthreads();
    float s = 0.f;
    if (TID() < 128) { const int rr = TID() & 31, cc = TID() >> 5;
#pragma unroll
        for (int w = 0; w < 8; ++w) s += red[(w * 32 + rr) * 4 + cc]; }
    LDS_WAIT(); __syncthreads();
    return s;
}

#define SG_ROW(tid_) (16 * ((tid_) >> 8) + 4 * (((tid_) >> 6) & 3) + ((tid_) & 3))
#define SG_COL(tid_) (((tid_) >> 2) & 15)
typedef short bf16x8s __attribute__((ext_vector_type(8)));
__device__ __forceinline__ float sgemm16(Frame& F, const bf16* Abf, int K, const bf16* Wt, int ct, LAS float* red, const float* rs_src = nullptr, LAS float* rsl = nullptr) {
    const int lane = LANE(), r = lane & 15, q = lane >> 4, kw = K >> 3, k0 = F.wave * kw;
    f32x4 rv[4][4];
    if (rs_src) {
#pragma unroll
        for (int i = 0; i < 4; ++i)
#pragma unroll
            for (int j = 0; j < 4; ++j) rv[i][j] = *((const f32x4*)(rs_src + (size_t)(F.wave * 4 + i) * D) + lane + 64 * j); }
    const bf16* a0 = Abf + (size_t)r * K + k0 + 8 * q; const bf16* a1 = a0 + (size_t)16 * K; const bf16* bp = Wt + (size_t)(16 * ct + r) * K + k0 + 8 * q;
    f32x4 acc0 = {0.f, 0.f, 0.f, 0.f}, acc1 = {0.f, 0.f, 0.f, 0.f};
#pragma unroll 8
    for (int k = 0; k < kw; k += 32) { const bf16x8s x0 = *(const bf16x8s*)(a0 + k), x1 = *(const bf16x8s*)(a1 + k), w = *(const bf16x8s*)(bp + k);
        acc0 = __builtin_amdgcn_mfma_f32_16x16x32_bf16(x0, w, acc0, 0, 0, 0); acc1 = __builtin_amdgcn_mfma_f32_16x16x32_bf16(x1, w, acc1, 0, 0, 0); }
    *(LAS f32x4*)(red + (F.wave * 2 + 0) * 256 + lane * 4) = acc0; *(LAS f32x4*)(red + (F.wave * 2 + 1) * 256 + lane * 4) = acc1;
    if (rs_src) {
#pragma unroll
        for (int i = 0; i < 4; ++i) { float ss = 0.f;
#pragma unroll
            for (int j = 0; j < 4; ++j) { const f32x4 v = rv[i][j]; ss += (v.x * v.x + v.y * v.y) + (v.z * v.z + v.w * v.w); }
            ss = wave_sum(ss); if (lane == 0) rsl[F.wave * 4 + i] = 1.0f / sqrtf(ss * (1.0f / D) + EPS); } }
    LDS_WAIT(); __syncthreads();
    const int tid = TID(); float s = 0.f;
#pragma unroll
    for (int w = 0; w < 8; ++w) s += red[(w * 2 + (tid >> 8)) * 256 + (tid & 255)];
    LDS_WAIT(); __syncthreads();
    return s;
}

__device__ __forceinline__ float sgemm16_f32w(Frame& F, const float* Amat, const float* gain, const float* W, int N, int ct, LAS float* red) {
    const int lane = LANE(), r = lane & 15, q = lane >> 4, k0 = F.wave * 128 + 8 * q, n = 16 * ct + r; const bool nv = n < N;
    const float* a0 = Amat + (size_t)r * D + k0; const float* a1 = a0 + (size_t)16 * D; const float* wp = W + (size_t)k0 * N + (nv ? n : 0);
    f32x4 acc0 = {0.f, 0.f, 0.f, 0.f}, acc1 = {0.f, 0.f, 0.f, 0.f};
#pragma unroll
    for (int ks = 0; ks < 4; ++ks) {
        const f32x4 g0 = *(const f32x4*)(gain + k0 + 32 * ks), g1 = *(const f32x4*)(gain + k0 + 32 * ks + 4);
        const f32x4 p0 = *(const f32x4*)(a0 + 32 * ks) * g0, p1 = *(const f32x4*)(a0 + 32 * ks + 4) * g1, p2 = *(const f32x4*)(a1 + 32 * ks) * g0, p3 = *(const f32x4*)(a1 + 32 * ks + 4) * g1;
        float wv[8];
#pragma unroll
        for (int j = 0; j < 8; ++j) wv[j] = wp[(size_t)(32 * ks + j) * N];
        const v4u x0 = {pk2(p0[0], p0[1]), pk2(p0[2], p0[3]), pk2(p1[0], p1[1]), pk2(p1[2], p1[3])}, x1 = {pk2(p2[0], p2[1]), pk2(p2[2], p2[3]), pk2(p3[0], p3[1]), pk2(p3[2], p3[3])};
        v4u w = {pk2(wv[0], wv[1]), pk2(wv[2], wv[3]), pk2(wv[4], wv[5]), pk2(wv[6], wv[7])}; if (!nv) w = (v4u){0u, 0u, 0u, 0u};
        acc0 = __builtin_amdgcn_mfma_f32_16x16x32_bf16(__builtin_bit_cast(bf16x8s, x0), __builtin_bit_cast(bf16x8s, w), acc0, 0, 0, 0);
        acc1 = __builtin_amdgcn_mfma_f32_16x16x32_bf16(__builtin_bit_cast(bf16x8s, x1), __builtin_bit_cast(bf16x8s, w), acc1, 0, 0, 0); }
    *(LAS f32x4*)(red + (F.wave * 2 + 0) * 256 + lane * 4) = acc0; *(LAS f32x4*)(red + (F.wave * 2 + 1) * 256 + lane * 4) = acc1;
    LDS_WAIT(); __syncthreads();
    const int tid = TID(); float s = 0.f;
#pragma unroll
    for (int w = 0; w < 8; ++w) s += red[(w * 2 + (tid >> 8)) * 256 + (tid & 255)];
    LDS_WAIT(); __syncthreads();
    return s;
}

__device__ __forceinline__ void rg_ab(float rp, float ip, float cv, float lam, float& a, float& b) {
    const float r = 1.0f / (1.0f + expf(-rp)), i = 1.0f / (1.0f + expf(-ip));
    const float sp = log1pf(expf(-lam)); const float la = -8.0f * r * sp;
    a = expf(la); b = sqrtf(-expm1f(2.0f * la)) * (i * cv);
}

__device__ __forceinline__ void sample_post(Frame& F, const Args& A, int b) {
    const int lane = LANE(); const float* z = SMP(SM_ZS) + (size_t)b * EIN;
    const float* convw = A.in[I_CONVW]; const float* sc = A.in[I_SCONV] + (size_t)b * 3 * LRU;
    float* convs = F.out + O_CONVS + (size_t)b * 3 * LRU;
    for (int n = 0; n < 8; ++n) {
        const int ch = n * 64 + lane; const float xa = z[ch];
        const float s0 = sc[ch], s1 = sc[LRU + ch], s2 = sc[2 * LRU + ch];
        const float cv = A.in[I_CONVB][ch] + convw[ch] * s0 + convw[LRU + ch] * s1 + convw[2 * LRU + ch] * s2 + convw[3 * LRU + ch] * xa;
        convs[ch] = s1; convs[LRU + ch] = s2; convs[2 * LRU + ch] = xa;
        float rp = A.in[I_BA][ch], ip = A.in[I_BX][ch];
        const float* wa = A.in[I_WA] + (size_t)n * 4096 + lane; const float* wx = A.in[I_WX] + (size_t)n * 4096 + lane;
        for (int c = 0; c < 64; ++c) { const float cc = __shfl(cv, c); rp += cc * wa[c * 64]; ip += cc * wx[c * 64]; }
        float a, bb; rg_ab(rp, ip, cv, A.in[I_LAM][ch], a, bb);
        const float h = a * A.in[I_SH][(size_t)b * LRU + ch] + bb;
        F.out[O_HS + (size_t)b * LRU + ch] = h;
        { const float ya = h * gelu_tanh(z[LRU + ch]); SMP(SM_YABS)[(size_t)b * D + ch] = ya; SMB(SB_YABS)[(size_t)b * D + ch] = (bf16)f2bf(ya); }
    }
    {
        const float* q = z + 1024 + lane * 8; float v[8], ss = 0.f;
#pragma unroll
        for (int j = 0; j < 8; ++j) { v[j] = q[j]; ss += v[j] * v[j]; }
        ss += __shfl_xor(ss, 1); ss += __shfl_xor(ss, 2); ss += __shfl_xor(ss, 4);
        const float rstd = 1.0f / sqrtf(ss * (1.0f / 64.0f) + EPS);
#pragma unroll
        for (int j = 0; j < 8; ++j) SMP(SM_QS)[(size_t)b * 512 + lane * 8 + j] = v[j] * rstd * A.in[I_QG][(lane & 7) * 8 + j];
    }
    for (int s = 0; s < 6; ++s) {
        const float* p = z + 1536 + s * 128 + lane * 2; float v0 = p[0], v1 = p[1];
        if (s == 2 || s == 4) { float ss = v0 * v0 + v1 * v1;
#pragma unroll
            for (int o = 1; o < 32; o <<= 1) ss += __shfl_xor(ss, o);
            const float rstd = 1.0f / sqrtf(ss * (1.0f / 64.0f) + EPS); const float* kg = A.in[I_KG] + (s == 2 ? 64 : 128) + (lane & 31) * 2;
            v0 = v0 * rstd * kg[0]; v1 = v1 * rstd * kg[1]; }
        if (s < 4) { float* o = F.out + O_KVS + (size_t)b * 512 + s * 128 + lane * 2; o[0] = v0; o[1] = v1; }
        else { float* o = SMP(SM_WNS) + (size_t)b * 256 + (s - 4) * 128 + lane * 2; o[0] = v0; o[1] = v1;
               float* w = F.out + O_WINS + ((size_t)b * 512 + 511) * 256 + (s - 4) * 128 + lane * 2; w[0] = v0; w[1] = v1; }
    }
    if (lane < 24) SMP(SM_GATES)[b * 24 + lane] = sigmoidf_(z[2304 + lane]);
}
__host__ __device__ __forceinline__ int kv_off_k(int r, int d) { return (((r >> 4) * 2 + (d >> 5)) * 64 + ((d & 31) >> 3) * 16 + (r & 15)) * 8 + (d & 7); }
__host__ __device__ __forceinline__ int kv_off_v(int s, int d) { return 4096 + (((s >> 5) * 4 + (d >> 4)) * 64 + ((s & 31) >> 3) * 16 + (d & 15)) * 8 + (s & 7); }
#if FUSE_HEADNORM
__device__ __forceinline__ void ktile_token4(Frame& F, const Args& A, int t0) {
    const int lane = LANE(), l = lane & 31;
    f32x4 a[4];
#pragma unroll
    for (int i = 0; i < 4; ++i) a[i] = *(const f32x4*)((lane < 32) ? (F.out + O_KVP + (size_t)(t0 + i) * 512 + 256 + l * 4) : (WSF(WS_WINB) + (size_t)(t0 + i) * 256 + l * 4));
#pragma unroll
    for (int i = 0; i < 4; ++i) { const int t = t0 + i;
#if SEL_FP8
        if (lane < 32) { const int r = t & 63, d = 4 * (l & 15);
            int w = __builtin_amdgcn_cvt_pk_fp8_f32(a[i].x, a[i].y, 0, false); w = __builtin_amdgcn_cvt_pk_fp8_f32(a[i].z, a[i].w, w, true);
            *(int*)((unsigned char*)(WSB(WS_KVS) + (size_t)((t >> 6) * 2 + (l >> 4)) * 8192) + ((r >> 4) * 64 + ((d & 31) >> 3) * 16 + (r & 15)) * 16 + (d >> 5) * 8 + (d & 7)) = w; }
        else
#endif
        *(v2u*)(WSB(lane < 32 ? WS_KVS : WS_KVW) + (size_t)((t >> 6) * 2 + (l >> 4)) * 8192 + kv_off_k(t & 63, 4 * (l & 15))) = (v2u){pk2(a[i].x, a[i].y), pk2(a[i].z, a[i].w)}; }
}
#endif
__device__ __forceinline__ void head_norm_token(Frame& F, const Args& A, int t) {
    const int lane = LANE();
    {   float* q = WSF(WS_QR) + (size_t)t * 512 + lane * 8; f32x4 a = *(f32x4*)q, b = *(f32x4*)(q + 4);
        float ss = pg8::dot4(a) + pg8::dot4(b); ss += __shfl_xor(ss, 1); ss += __shfl_xor(ss, 2); ss += __shfl_xor(ss, 4);
        const float rstd = 1.0f / sqrtf(ss * (1.0f / 64.0f) + EPS); const float* g = A.in[I_QG] + (lane & 7) * 8;
        a = a * rstd * *(const f32x4*)g; b = b * rstd * *(const f32x4*)(g + 4); *(f32x4*)q = a; *(f32x4*)(q + 4) = b; }
    {   const int l = lane & 31; float* p = (lane < 32) ? (F.out + O_KVP + (size_t)t * 512 + 256 + l * 4) : (WSF(WS_WINB) + (size_t)t * 256 + l * 4);
        f32x4 a = *(f32x4*)p; float ss = pg8::dot4(a);
#pragma unroll
        for (int o = 1; o < 16; o <<= 1) ss += __shfl_xor(ss, o);
        const float rstd = 1.0f / sqrtf(ss * (1.0f / 64.0f) + EPS); const float* g = A.in[I_KG] + (lane < 32 ? 64 : 128) + (l & 15) * 4;
        a = a * rstd * *(const f32x4*)g; *(f32x4*)p = a;
#if SEL_FP8
        if (lane < 32) { const int r = t & 63, d = 4 * (l & 15);
            int w = __builtin_amdgcn_cvt_pk_fp8_f32(a.x, a.y, 0, false); w = __builtin_amdgcn_cvt_pk_fp8_f32(a.z, a.w, w, true);
            *(int*)((unsigned char*)(WSB(WS_KVS) + (size_t)((t >> 6) * 2 + (l >> 4)) * 8192) + ((r >> 4) * 64 + ((d & 31) >> 3) * 16 + (r & 15)) * 16 + (d >> 5) * 8 + (d & 7)) = w; }
        else
#endif
        *(v2u*)(WSB(lane < 32 ? WS_KVS : WS_KVW) + (size_t)((t >> 6) * 2 + (l >> 4)) * 8192 + kv_off_k(t & 63, 4 * (l & 15))) = (v2u){pk2(a.x, a.y), pk2(a.z, a.w)};
        if (t >= T - 512) {
            float* wo = F.out + O_WINP + (size_t)(t - (T - 512)) * 256;
            if (lane >= 32) *(f32x4*)(wo + l * 4) = a;
            else *(f32x4*)(wo + 128 + l * 4) = *(const f32x4*)(WSF(WS_WINB) + (size_t)t * 256 + 128 + l * 4);
        }
    }
    if (t >= T - 3) {
        const float* x = WSF(WS_XA) + (size_t)t * 512 + lane * 8; float* o = F.out + O_CONVP + (size_t)(t - (T - 3)) * 512 + lane * 8;
        *(f32x4*)o = *(const f32x4*)x; *(f32x4*)(o + 4) = *(const f32x4*)(x + 4);
    }
}

__host__ __device__ __forceinline__ int vt_slot(int r);

__device__ __forceinline__ void rg1_item(Frame& F, const Args& A, int sc, int n, LAS float* wscr) {
    typedef float f32x16 __attribute__((ext_vector_type(16)));
    const int lane = LANE(), ch = n * 64 + lane, t0 = sc * 64, l31 = lane & 31, lh = lane >> 5;
    const float* cw = A.in[I_CONVW];
    const float cw0 = cw[ch], cw1 = cw[LRU + ch], cw2 = cw[2 * LRU + ch], cw3 = cw[3 * LRU + ch], cb = A.in[I_CONVB][ch];
    const float* xa = WSF(WS_XA); bf16* HL = WSB(WS_HL); bf16* CP = WSB(WS_CP);
    float xm3 = 0.f, xm2 = 0.f, xm1 = 0.f;
    if (t0 > 0) { xm3 = xa[(size_t)(t0 - 3) * LRU + ch]; xm2 = xa[(size_t)(t0 - 2) * LRU + ch]; xm1 = xa[(size_t)(t0 - 1) * LRU + ch]; }
    float h = 0.f, cp = 1.f;
    float ba2[2], bx2[2], sp2[2];
#pragma unroll
    for (int dt = 0; dt < 2; ++dt) { const int cd = n * 64 + dt * 32 + l31; ba2[dt] = A.in[I_BA][cd]; bx2[dt] = A.in[I_BX][cd]; sp2[dt] = -8.0f * log1pf(expf(-A.in[I_LAM][cd])); }
    for (int hf = 0; hf < 2; ++hf) {
        const int tb = t0 + hf * 32;
        LDS_WAIT();
        {   float xv[32];
#pragma unroll
            for (int i = 0; i < 32; ++i) xv[i] = xa[(size_t)(tb + i) * LRU + ch];
#pragma unroll
            for (int i = 0; i < 32; ++i) { const float x = xv[i];
                const float cv = cb + cw0 * xm3 + cw1 * xm2 + cw2 * xm1 + cw3 * x; xm3 = xm2; xm2 = xm1; xm1 = x;
                wscr[i * 65 + lane] = cv; } }
        LDS_WAIT();
        float ra[2][16], rb[2][16];
#pragma unroll
        for (int dt = 0; dt < 2; ++dt) {
            f32x16 pa, px;
#pragma unroll
            for (int r = 0; r < 16; ++r) { pa[r] = 0.f; px[r] = 0.f; }
            const float* wa = A.in[I_WA] + (size_t)n * 4096 + dt * 32 + l31 + lh * 64; const float* wx = A.in[I_WX] + (size_t)n * 4096 + dt * 32 + l31 + lh * 64;
            const LAS float* ap = wscr + l31 * 65 + lh;
#pragma unroll 1
            for (int kh = 0; kh < 2; ++kh) {
                float wav[16], wxv[16];
#pragma unroll
                for (int k2 = 0; k2 < 16; ++k2) { wav[k2] = wa[(kh * 16 + k2) * 128]; wxv[k2] = wx[(kh * 16 + k2) * 128]; }
#pragma unroll
                for (int k2 = 0; k2 < 16; ++k2) { const float av = ap[2 * (kh * 16 + k2)];
                    pa = __builtin_amdgcn_mfma_f32_32x32x2f32(av, wav[k2], pa, 0, 0, 0); px = __builtin_amdgcn_mfma_f32_32x32x2f32(av, wxv[k2], px, 0, 0, 0); } }
#pragma unroll
            for (int r = 0; r < 16; ++r) { const int tt = (r & 3) + 8 * (r >> 2) + 4 * lh;
                const float cv = wscr[tt * 65 + dt * 32 + l31];
                const float rg = __builtin_amdgcn_rcpf(1.0f + __expf(-(pa[r] + ba2[dt]))), ig = __builtin_amdgcn_rcpf(1.0f + __expf(-(px[r] + bx2[dt])));
                const float la = sp2[dt] * rg, x2 = 2.0f * la;
                const float om = x2 > -0.0625f ? -x2 * (1.0f + x2 * (0.5f + x2 * (0.16666667f + x2 * 0.041666668f))) : 1.0f - __expf(x2);
                ra[dt][r] = __expf(la); rb[dt][r] = __builtin_amdgcn_sqrtf(om) * (ig * cv); }
        }
        LDS_WAIT();
#pragma unroll
        for (int dt = 0; dt < 2; ++dt)
#pragma unroll
            for (int r = 0; r < 16; ++r) { const int tt = (r & 3) + 8 * (r >> 2) + 4 * lh; wscr[tt * 64 + dt * 32 + l31] = ra[dt][r]; wscr[2048 + tt * 64 + dt * 32 + l31] = rb[dt][r]; }
        LDS_WAIT();
#pragma unroll 8
        for (int i = 0; i < 32; ++i) { const float a = wscr[i * 64 + lane], b = wscr[2048 + i * 64 + lane];
            h = a * h + b; cp *= a; HL[(size_t)(tb + i) * LRU + ch] = (bf16)f2bf(h); CP[(size_t)(tb + i) * LRU + ch] = (bf16)f2bf(cp); }
    }
    WSF(WS_SUMP)[(size_t)sc * LRU + ch] = cp; WSF(WS_SUME)[(size_t)sc * LRU + ch] = h;
}
__device__ __forceinline__ void rg3_item(Frame& F, const Args& A, int sc, int n) {
    const int lane = LANE(), ch = n * 64 + lane, t0 = sc * 64;
    const float* SP = WSF(WS_SUMP) + ch; const float* SE = WSF(WS_SUME) + ch;
    float H = 0.f;
    int s = 0;
    for (; s + 8 <= sc; s += 8) { float p[8], e[8];
#pragma unroll
        for (int j = 0; j < 8; ++j) { p[j] = SP[(size_t)(s + j) * LRU]; e[j] = SE[(size_t)(s + j) * LRU]; }
#pragma unroll
        for (int j = 0; j < 8; ++j) H = p[j] * H + e[j]; }
    for (; s < sc; ++s) H = SP[(size_t)s * LRU] * H + SE[(size_t)s * LRU];
    const bf16* HL = WSB(WS_HL); const bf16* CP = WSB(WS_CP); const bf16* GG = WSB(WS_GG); bf16* Y = WSB(WS_YAB);
    float hlast = 0.f;
#pragma unroll 8
    for (int i = 0; i < 64; ++i) { const size_t t = (size_t)(t0 + i);
        const float h = __builtin_bit_cast(float, (unsigned)HL[t * LRU + ch] << 16) + __builtin_bit_cast(float, (unsigned)CP[t * LRU + ch] << 16) * H; hlast = h;
        Y[t * D + ch] = (bf16)f2bf(h * __builtin_bit_cast(float, (unsigned)GG[t * LRU + ch] << 16)); }
    if (sc == T / 64 - 1) F.out[O_HP + ch] = hlast;
}

__device__ __forceinline__ void cmp_prompt_item(Frame& F, const Args& A, int jq, int kv, LAS float* scr) {
    const int lane = LANE(); const float* W = A.in[kv ? I_CWV : I_CWK]; const float* pe = A.in[kv ? I_PEV : I_PEK]; const float* kvp = F.out + O_KVP;
    float acc[8];
#pragma unroll
    for (int o = 0; o < 8; ++o) acc[o] = 0.f;
    for (int i = 0; i < 32; ++i) {
        const float pv = pe[i * 64 + lane];
#pragma unroll
        for (int o = 0; o < 8; ++o) scr[lane * 8 + o] = kvp[(size_t)(32 * (4 * jq + (o >> 1)) + i) * 512 + kv * 128 + (o & 1) * 64 + lane] + pv;
        LDS_WAIT();
#pragma unroll 8
        for (int c = 0; c < 64; ++c) { const float w = W[(size_t)(i * 64 + c) * 64 + lane];
            const f32x4 x0 = *(const LAS f32x4*)(scr + c * 8), x1 = *(const LAS f32x4*)(scr + c * 8 + 4);
            acc[0] += x0.x * w; acc[1] += x0.y * w; acc[2] += x0.z * w; acc[3] += x0.w * w; acc[4] += x1.x * w; acc[5] += x1.y * w; acc[6] += x1.z * w; acc[7] += x1.w * w; }
        LDS_WAIT();
    }
    float* dst = WSF(kv ? WS_VC : WS_KC);
#pragma unroll
    for (int o = 0; o < 8; ++o) { float v = acc[o];
        if (kv == 0) { const float ss = wave_sum(v * v); v = v * (1.0f / sqrtf(ss * (1.0f / 64.0f) + EPS)) * A.in[I_KG][lane]; }
        dst[(size_t)((4 * jq + (o >> 1)) * 2 + (o & 1)) * 64 + lane] = v;
        const int j = 4 * jq + (o >> 1), gg = o & 1;
        bf16* tile = WSB(WS_KVC) + (size_t)((j >> 6) * 2 + gg) * 8192;
        if (kv == 0) tile[kv_off_k(j & 63, lane)] = (bf16)f2bf(v);
        else tile[kv_off_v(vt_slot(j & 63), lane)] = (bf16)f2bf(v); }
}
__device__ __forceinline__ void cmp_sample_item(Frame& F, const Args& A, int b, int pg) {
    LAS float* xs = (LAS float*)(F.lds + RING_OFF);
    LAS float* red = (LAS float*)(F.lds + RING_OFF + 65536);
    const int lane = LANE(), phys = ((const int*)A.in[I_PT])[b * NPG + pg];
    for (int kv = 0; kv < 2; ++kv) {
        const float* W = A.in[kv ? I_CWV : I_CWK]; const float* pe = A.in[kv ? I_PEV : I_PEK];
        for (int idx = TID(); idx < 128 * 32; idx += NWAVES * 64) { const int r = idx >> 5, q = idx & 31;
            const f32x4 v = *(const f32x4*)(A.in[I_CKV] + ((size_t)(phys * 128 + r) * 4 + kv) * 128 + q * 4), p4 = *(const f32x4*)(pe + (r & 31) * 64 + (q & 15) * 4);
            *(LAS f32x4*)(xs + r * 128 + q * 4) = v + p4; }
        LDS_WAIT(); __syncthreads();
        float acc[8];
#pragma unroll
        for (int o = 0; o < 8; ++o) acc[o] = 0.f;
        for (int ii = 0; ii < 4; ++ii) { const int i = 4 * F.wave + ii;
#pragma unroll 2
            for (int c = 0; c < 64; c += 4) {
                const float w0 = W[(size_t)(i * 64 + c) * 64 + lane], w1 = W[(size_t)(i * 64 + c + 1) * 64 + lane], w2 = W[(size_t)(i * 64 + c + 2) * 64 + lane], w3 = W[(size_t)(i * 64 + c + 3) * 64 + lane];
#pragma unroll
                for (int o = 0; o < 8; ++o) { const f32x4 x = *(const LAS f32x4*)(xs + ((o >> 1) * 32 + i) * 128 + (o & 1) * 64 + c);
                    acc[o] += (x.x * w0 + x.y * w1) + (x.z * w2 + x.w * w3); }
            }
        }
#pragma unroll
        for (int o = 0; o < 8; ++o) red[(F.wave * 8 + o) * 64 + lane] = acc[o];
        LDS_WAIT(); __syncthreads();
        {   const int o = F.wave; float v = 0.f;
#pragma unroll
            for (int w = 0; w < 8; ++w) v += red[(w * 8 + o) * 64 + lane];
            if (kv == 0) { const float ss = wave_sum(v * v); v = v * (1.0f / sqrtf(ss * (1.0f / 64.0f) + EPS)) * A.in[I_KG][lane]; }
            WSF(kv ? WS_VCS : WS_KCS)[((size_t)(b * 512 + 4 * pg + (o >> 1)) * 2 + (o & 1)) * 64 + lane] = v; }
        LDS_WAIT(); __syncthreads();
    }
}

constexpr int AW_SC = 0, AW_IMP = 8192, AW_PT = 9472, AW_SEL = 9728, AW_Q = 9792;
struct SrcPromptCmp { const float* kc; const float* vc; const LAS float* btab; int t, g;
    __device__ __forceinline__ bool valid(int) const { return true; }
    __device__ __forceinline__ float bias(int k, int hh) const { int d = t - (32 * k + 31); d = d > 113 ? 113 : d; return btab[d * 8 + g * 4 + hh]; }
    __device__ __forceinline__ const float* kptr(int k) const { return kc + (size_t)(k * 2 + g) * 64; }
    __device__ __forceinline__ const float* vptr(int k) const { return vc + (size_t)(k * 2 + g) * 64; } };
struct SrcPromptSel { const float* kvp; const LAS float* btab; const LAS int* sel; int t, g;
    __device__ __forceinline__ int kpos(int k) const { return sel[k >> 6] * 64 + (k & 63); }
    __device__ __forceinline__ bool valid(int k) const { return kpos(k) <= t; }
    __device__ __forceinline__ float bias(int k, int hh) const { int d = t - kpos(k); d = d > 113 ? 113 : d; return btab[d * 8 + g * 4 + hh]; }
    __device__ __forceinline__ const float* kptr(int k) const { return kvp + (size_t)kpos(k) * 512 + 256 + g * 64; }
    __device__ __forceinline__ const float* vptr(int k) const { return kvp + (size_t)kpos(k) * 512 + 384 + g * 64; } };
struct SrcPromptWin { const float* winb; const LAS float* btab; int t, g;
    __device__ __forceinline__ bool valid(int k) const { return t - 511 + k >= 0; }
    __device__ __forceinline__ float bias(int k, int hh) const { int d = 511 - k; d = d > 113 ? 113 : d; return btab[d * 8 + g * 4 + hh]; }
    __device__ __forceinline__ const float* kptr(int k) const { return winb + (size_t)(t - 511 + k) * 256 + g * 64; }
    __device__ __forceinline__ const float* vptr(int k) const { return winb + (size_t)(t - 511 + k) * 256 + 128 + g * 64; } };
struct SrcSampleCmp { const float* kc; const float* vc; const LAS float* btab; int g;
    __device__ __forceinline__ bool valid(int) const { return true; }
    __device__ __forceinline__ float bias(int k, int hh) const { int d = T - (32 * k + 31); d = d > 113 ? 113 : d; return btab[d * 8 + g * 4 + hh]; }
    __device__ __forceinline__ const float* kptr(int k) const { return kc + (size_t)(k * 2 + g) * 64; }
    __device__ __forceinline__ const float* vptr(int k) const { return vc + (size_t)(k * 2 + g) * 64; } };
struct SrcSampleSel { const float* cache; const int* pt; const float* newrow; const LAS float* btab; const LAS int* sel; int g;
    __device__ __forceinline__ int kpos(int k) const { return sel[k >> 6] * 64 + (k & 63); }
    __device__ __forceinline__ bool valid(int k) const { return kpos(k) <= T; }
    __device__ __forceinline__ float bias(int k, int hh) const { int d = T - kpos(k); d = d > 113 ? 113 : d; return btab[d * 8 + g * 4 + hh]; }
    __device__ __forceinline__ const float* rowp(int k, int s) const { const int kp = kpos(k); if (kp >= T) return newrow + s * 128 + g * 64;
        const int phys = pt[kp >> 7]; return cache + ((size_t)(phys * 128 + (kp & 127)) * 4 + s) * 128 + g * 64; }
    __device__ __forceinline__ const float* kptr(int k) const { return rowp(k, 2); }
    __device__ __forceinline__ const float* vptr(int k) const { return rowp(k, 3); } };
struct SrcSampleWin { const float* cwin; const float* wns; const LAS float* btab; int g;
    __device__ __forceinline__ bool valid(int) const { return true; }
    __device__ __forceinline__ float bias(int k, int hh) const { int d = 511 - k; d = d > 113 ? 113 : d; return btab[d * 8 + g * 4 + hh]; }
    __device__ __forceinline__ const float* kptr(int k) const { return k < 511 ? cwin + (size_t)(k + 1) * 256 + g * 64 : wns + g * 64; }
    __device__ __forceinline__ const float* vptr(int k) const { return k < 511 ? cwin + (size_t)(k + 1) * 256 + 128 + g * 64 : wns + 128 + g * 64; } };

template <class Src, bool STASH>
__device__ __forceinline__ void attn_branch(const Src& S, int nkeys, LAS float* wscr, float& m, float& l, float (&o)[4], int lane) {
    const int kk = lane >> 2, hh = lane & 3;
    LAS float* pt = (LAS float*)((LAS unsigned char*)wscr + AW_PT); LAS float* sc = (LAS float*)((LAS unsigned char*)wscr + AW_SC);
    m = -1e30f; l = 0.f; o[0] = 0.f; o[1] = 0.f; o[2] = 0.f; o[3] = 0.f;
    for (int k0 = 0; k0 < nkeys; k0 += 16) {
        const int kidx = k0 + kk; const bool valid = kidx < nkeys && S.valid(kidx);
        float s = -1e30f;
        if (valid) { const f32x4* kr = (const f32x4*)S.kptr(kidx); const LAS f32x4* qv = (const LAS f32x4*)((LAS unsigned char*)wscr + AW_Q) + hh * 17; float d0 = 0.f, d1 = 0.f;
#pragma unroll 4
            for (int c = 0; c < 16; c += 2) { const f32x4 a = kr[c], b = kr[c + 1], qa = qv[c], qb = qv[c + 1];
                d0 += (a.x * qa.x + a.y * qa.y) + (a.z * qa.z + a.w * qa.w);
                d1 += (b.x * qb.x + b.y * qb.y) + (b.z * qb.z + b.w * qb.w); }
            s = (d0 + d1) * 0.125f + S.bias(kidx, hh); }
        if (STASH) sc[kidx * 4 + hh] = s;
        float mt = s; mt = fmaxf(mt, __shfl_xor(mt, 4)); mt = fmaxf(mt, __shfl_xor(mt, 8)); mt = fmaxf(mt, __shfl_xor(mt, 16)); mt = fmaxf(mt, __shfl_xor(mt, 32));
        const float mn = fmaxf(m, mt), alpha = __expf(m - mn), p = valid ? __expf(s - mn) : 0.f;
        float ps = p; ps += __shfl_xor(ps, 4); ps += __shfl_xor(ps, 8); ps += __shfl_xor(ps, 16); ps += __shfl_xor(ps, 32);
        l = l * alpha + ps; m = mn;
        pt[lane] = p;
        LDS_WAIT();
#pragma unroll
        for (int h = 0; h < 4; ++h) o[h] *= __shfl(alpha, h);
        const int nk = (nkeys - k0) < 16 ? (nkeys - k0) : 16;
        for (int j = 0; j < nk; ++j) { const f32x4 pj = *(const LAS f32x4*)(pt + j * 4);
            if (pj.x == 0.f && pj.y == 0.f && pj.z == 0.f && pj.w == 0.f) continue;
            const float v = S.vptr(k0 + j)[lane];
            o[0] += pj.x * v; o[1] += pj.y * v; o[2] += pj.z * v; o[3] += pj.w * v; }
        LDS_WAIT();
    }
}
template <bool EXP2 = false>
__device__ __forceinline__ void attn_importance(int nkeys, LAS float* wscr, float m, float l, int lane) {
    const int kk = lane >> 2, hh = lane & 3;
    const LAS float* sc = (const LAS float*)((LAS unsigned char*)wscr + AW_SC); LAS float* imp = (LAS float*)((LAS unsigned char*)wscr + AW_IMP);
    const float rl = l > 0.f ? 1.0f / l : 0.f;
    for (int k0 = 0; k0 < 512; k0 += 16) { const int kidx = k0 + kk;
        float p = (kidx < nkeys && l > 0.f) ? (EXP2 ? __builtin_amdgcn_exp2f(sc[kidx * 4 + hh] - m) : __expf(sc[kidx * 4 + hh] - m)) * rl : 0.f;
        p += __shfl_xor(p, 1); p += __shfl_xor(p, 2); p += __shfl_xor(p, 4);
        if ((lane & 7) == 0) imp[kidx >> 1] = p; }
    if (lane < 64) imp[256 + lane] = 0.f;
    LDS_WAIT();
}
__device__ __forceinline__ int attn_topk(int nsb, int cur, LAS float* wscr, int lane) {
    const LAS float* imp = (const LAS float*)((LAS unsigned char*)wscr + AW_IMP); LAS int* sel = (LAS int*)((LAS unsigned char*)wscr + AW_SEL);
    float v[5];
#pragma unroll
    for (int i = 0; i < 5; ++i) { const int sb = lane + 64 * i;
        v[i] = (sb >= nsb || sb > cur) ? -1.0f : ((sb == 0 || sb == cur || sb == cur - 1) ? 1.0e4f : imp[sb]); }
    int nsel = 0;
    for (int it = 0; it < 16; ++it) {
        float bv = v[0]; int bi = lane;
#pragma unroll
        for (int i = 1; i < 5; ++i) if (v[i] > bv) { bv = v[i]; bi = lane + 64 * i; }
#pragma unroll
        for (int off = 32; off >= 1; off >>= 1) { const float ov = __shfl_xor(bv, off); const int oi = __shfl_xor(bi, off);
            if (ov > bv || (ov == bv && oi < bi)) { bv = ov; bi = oi; } }
        if (bv < 0.f) break;
        if (lane == 0) sel[nsel] = bi;
        ++nsel;
#pragma unroll
        for (int i = 0; i < 5; ++i) if (bi == lane + 64 * i) v[i] = -2.0f;
    }
    LDS_WAIT();
    return nsel;
}
__device__ __forceinline__ void attn_accum(float (&of)[4], const float (&o)[4], float l, float gate_h_unused, const float* gates3, int j, int lane) {
#pragma unroll
    for (int h = 0; h < 4; ++h) { const float lh = __shfl(l, h); if (lh > 0.f) of[h] += gates3[h * 3 + j] * o[h] / lh; }
}
__device__ __forceinline__ void attn_prompt_item(Frame& F, const Args& A, int t, int g, LAS float* wscr, const LAS float* btab) {
    const int lane = LANE();
    {
        const f32x4 v = *((const f32x4*)(WSF(WS_QR) + (size_t)t * 512 + g * 256) + lane);
        *((LAS f32x4*)((LAS unsigned char*)wscr + AW_Q) + (lane >> 4) * 17 + (lane & 15)) = v; LDS_WAIT(); }
    const float* g3 = WSF(WS_GATE) + (size_t)t * 24 + g * 12;
    float of[4] = {0.f, 0.f, 0.f, 0.f}, o[4], m, l;
    const int nvis = (t + 1) >> 5, cur = t >> 6;
    {   SrcPromptCmp S{WSF(WS_KC), WSF(WS_VC), btab, t, g};
        attn_branch<SrcPromptCmp, true>(S, nvis, wscr, m, l, o, lane);
        attn_accum(of, o, l, 0.f, g3, 0, lane);
        attn_importance(nvis, wscr, m, l, lane); }
    const int nsel = attn_topk(256, cur, wscr, lane);
    {   SrcPromptSel S{F.out + O_KVP, btab, (const LAS int*)((LAS unsigned char*)wscr + AW_SEL), t, g};
        attn_branch<SrcPromptSel, false>(S, nsel * 64, wscr, m, l, o, lane);
        attn_accum(of, o, l, 0.f, g3, 1, lane); }
    {   SrcPromptWin S{WSF(WS_WINB), btab, t, g};
        attn_branch<SrcPromptWin, false>(S, 512, wscr, m, l, o, lane);
        attn_accum(of, o, l, 0.f, g3, 2, lane); }
    bf16* y = WSB(WS_YAB) + (size_t)t * D + 512 + g * 256 + lane;
#pragma unroll
    for (int h = 0; h < 4; ++h) y[h * 64] = (bf16)f2bf(of[h]);
}
__device__ __forceinline__ void attn_sample_item(Frame& F, const Args& A, int b, int g, LAS float* wscr, const LAS float* btab) {
    const int lane = LANE();
    {   const f32x4 v = *((const f32x4*)(SMP(SM_QS) + (size_t)b * 512 + g * 256) + lane);
        *((LAS f32x4*)((LAS unsigned char*)wscr + AW_Q) + (lane >> 4) * 17 + (lane & 15)) = v; LDS_WAIT(); }
    const float* g3 = SMP(SM_GATES) + b * 24 + g * 12;
    float of[4] = {0.f, 0.f, 0.f, 0.f}, o[4], m, l;
    {   SrcSampleCmp S{WSF(WS_KCS) + (size_t)b * 512 * 128, WSF(WS_VCS) + (size_t)b * 512 * 128, btab, g};
        attn_branch<SrcSampleCmp, true>(S, 512, wscr, m, l, o, lane);
        attn_accum(of, o, l, 0.f, g3, 0, lane);
        attn_importance(512, wscr, m, l, lane); }
    const int nsel = attn_topk(257, 256, wscr, lane);
    {   SrcSampleSel S{A.in[I_CKV], (const int*)A.in[I_PT] + b * NPG, F.out + O_KVS + (size_t)b * 512, btab, (const LAS int*)((LAS unsigned char*)wscr + AW_SEL), g};
        attn_branch<SrcSampleSel, false>(S, nsel * 64, wscr, m, l, o, lane);
        attn_accum(of, o, l, 0.f, g3, 1, lane); }
    {   SrcSampleWin S{A.in[I_CWIN] + (size_t)b * 512 * 256, SMP(SM_WNS) + (size_t)b * 256, btab, g};
        attn_branch<SrcSampleWin, false>(S, 512, wscr, m, l, o, lane);
        attn_accum(of, o, l, 0.f, g3, 2, lane); }
    float* y = SMP(SM_YABS) + (size_t)b * D + 512 + g * 256 + lane;
#pragma unroll
    for (int h = 0; h < 4; ++h) y[h * 64] = of[h];
}

typedef short bf16x8v __attribute__((ext_vector_type(8)));
__host__ __device__ __forceinline__ int vt_slot(int r) { const int rr = r & 31; return 32 * (r >> 5) + (rr < 16 ? 8 * (rr >> 2) + (rr & 3) : 8 * ((rr - 16) >> 2) + 4 + (rr & 3)); }
__device__ __forceinline__ void build_vt_block(const float* vsrc, int ldv, bf16* vt, int lane) {
    unsigned pk[32];
#pragma unroll
    for (int s2 = 0; s2 < 32; ++s2) {
        const int s0 = 2 * s2, i2 = s0 >> 5, q = (s0 & 31) >> 3, j = s0 & 7;
        const int r0 = 32 * i2 + (j < 4 ? 4 * q + j : 16 + 4 * q + (j - 4));
        const float a = vsrc[(size_t)r0 * ldv + lane], b = vsrc[(size_t)(r0 + 1) * ldv + lane];
        pk[s2] = pk2(a, b); }
#pragma unroll
    for (int i = 0; i < 8; ++i) *(v4u*)(vt + kv_off_v(32 * (i >> 2) + 8 * (i & 3), lane)) = (v4u){pk[4 * i], pk[4 * i + 1], pk[4 * i + 2], pk[4 * i + 3]};
}
#define MFMA16(a, b, c) __builtin_amdgcn_mfma_f32_16x16x32_bf16((a), (b), (c), 0, 0, 0)
struct KVFrag { bf16x8v kf[4][2]; bf16x8v vf[2][4]; };
#if KV_NT
#define KV_LD(p) __builtin_nontemporal_load(p)
#else
#define KV_LD(p) (*(p))
#endif
template <bool WITH_V>
__device__ __forceinline__ void kv_load(KVFrag& f, const bf16* KV, int b, int g, int lane) {
    const bf16* p = KV + (size_t)(b * 2 + g) * 8192 + lane * 8;
#pragma unroll
    for (int kt = 0; kt < 4; ++kt)
#pragma unroll
        for (int ks = 0; ks < 2; ++ks) f.kf[kt][ks] = KV_LD((const bf16x8v*)(p + (kt * 2 + ks) * 512));
    if (WITH_V) {
#pragma unroll
        for (int i2 = 0; i2 < 2; ++i2)
#pragma unroll
            for (int dt = 0; dt < 4; ++dt) f.vf[i2][dt] = KV_LD((const bf16x8v*)(p + 4096 + (i2 * 4 + dt) * 512)); }
}
template <int MODE, bool STASH>
__device__ __forceinline__ void mf_block(const KVFrag& f, int b, int t, int lo, int g, const bf16x8v (&qf)[2], const LAS float* btab2, LAS float* sc,
                                         float& l, f32x4 (&o)[4], int q4, int c) {
    const int hh = c & 3;
    f32x4 s[4];
#pragma unroll
    for (int kt = 0; kt < 4; ++kt) { s[kt] = MFMA16(f.kf[kt][0], qf[0], ((f32x4){0.f, 0.f, 0.f, 0.f})); s[kt] = MFMA16(f.kf[kt][1], qf[1], s[kt]); }
    const int kmax = b * 64 + 63, pmax = MODE == 0 ? 32 * kmax + 31 : kmax, pmin = MODE == 0 ? 32 * (b * 64) + 31 : b * 64;
    const bool far = (t - pmax >= 113) && (pmin > lo);
    if (far) { const float bb = btab2[113 * 8 + g * 4 + hh];
#pragma unroll
        for (int kt = 0; kt < 4; ++kt)
#pragma unroll
            for (int j = 0; j < 4; ++j) s[kt][j] = fminf(s[kt][j] + bb, 64.0f);
    } else {
#pragma unroll
        for (int kt = 0; kt < 4; ++kt)
#pragma unroll
            for (int j = 0; j < 4; ++j) { const int k = b * 64 + 16 * kt + 4 * q4 + j, pos = MODE == 0 ? 32 * k + 31 : k; const bool ok = pos <= t && pos > lo;
                int d = t - pos; d = d < 0 ? 0 : (d > 113 ? 113 : d);
                const float bias = btab2[d * 8 + g * 4 + hh];
                s[kt][j] = ok ? fminf(s[kt][j] + bias, 64.0f) : -1e30f; }
    }
    if (STASH) {
#pragma unroll
        for (int kt = 0; kt < 4; ++kt)
#pragma unroll
            for (int j = 0; j < 4; ++j) { if (c < 4) sc[(b * 64 + 16 * kt + 4 * q4 + j) * 4 + c] = s[kt][j]; }
    }
#pragma unroll
    for (int kt = 0; kt < 4; ++kt)
#pragma unroll
        for (int j = 0; j < 4; ++j) { const float p = __builtin_amdgcn_exp2f(s[kt][j]); s[kt][j] = p; l += p; }
    if (!STASH) {
        bf16x8v pf[2];
#pragma unroll
        for (int i2 = 0; i2 < 2; ++i2) { v4u w; w.x = pg8::cvt_pk_bf16(s[2 * i2][0], s[2 * i2][1]); w.y = pg8::cvt_pk_bf16(s[2 * i2][2], s[2 * i2][3]); w.z = pg8::cvt_pk_bf16(s[2 * i2 + 1][0], s[2 * i2 + 1][1]); w.w = pg8::cvt_pk_bf16(s[2 * i2 + 1][2], s[2 * i2 + 1][3]);
            pf[i2] = __builtin_bit_cast(bf16x8v, w); }
#pragma unroll
        for (int dt = 0; dt < 4; ++dt) { o[dt] = MFMA16(f.vf[0][dt], pf[0], o[dt]); o[dt] = MFMA16(f.vf[1][dt], pf[1], o[dt]); }
    }
}
template <int MODE, bool STASH>
__device__ __forceinline__ void mf_branch(const bf16* KV, int nblk, int b0, const LAS int* sel, int t, int lo, int g, const bf16x8v (&qf)[2],
                                          const LAS float* btab, LAS float* wscr, float& l, f32x4 (&o)[4], int lane) {
    const int q4 = lane >> 4, c = lane & 15;
    LAS float* sc = (LAS float*)((LAS unsigned char*)wscr + AW_SC);
    l = 0.f;
#pragma unroll
    for (int dt = 0; dt < 4; ++dt) o[dt] = (f32x4){0.f, 0.f, 0.f, 0.f};
#if HOTBLK
#define MF_BLK(i_) (MODE == 0 ? (i_) : (MODE == 1 ? (__builtin_amdgcn_readfirstlane(sel[(i_)]) & 1) : (b0 & 1) + ((i_) & 1)))
#else
#define MF_BLK(i_) (MODE == 0 ? (i_) : (MODE == 1 ? __builtin_amdgcn_readfirstlane(sel[(i_)]) : b0 + (i_)))
#endif
#if ATTN_DBUF
    if (!STASH) {
        KVFrag f0, f1;
        if (nblk > 0) kv_load<true>(f0, KV, MF_BLK(0), g, lane);
        for (int i = 0; i < nblk; i += 2) {
            const int bA = MF_BLK(i); const bool hasB = i + 1 < nblk; const int bB = hasB ? MF_BLK(i + 1) : bA;
            if (hasB) kv_load<true>(f1, KV, bB, g, lane);
            mf_block<MODE, STASH>(f0, bA, t, lo, g, qf, btab, sc, l, o, q4, c);
            if (hasB) { if (i + 2 < nblk) kv_load<true>(f0, KV, MF_BLK(i + 2), g, lane); mf_block<MODE, STASH>(f1, bB, t, lo, g, qf, btab, sc, l, o, q4, c); }
        }
    } else
#endif
    for (int i = 0; i < nblk; ++i) { const int bA = MF_BLK(i); KVFrag f0; kv_load<!STASH>(f0, KV, bA, g, lane); mf_block<MODE, STASH>(f0, bA, t, lo, g, qf, btab, sc, l, o, q4, c); }
#undef MF_BLK
    l += __shfl_xor(l, 16); l += __shfl_xor(l, 32);
}
__device__ __forceinline__ void mf_cmp_pv(const bf16* KV, int nblk, int g, const LAS float* wscr, f32x4 (&o)[4], int lane) {
    const int q4 = lane >> 4, c = lane & 15, hh = c & 3;
    const LAS float* sc = (const LAS float*)((const LAS unsigned char*)wscr + AW_SC);
    for (int b = 0; b < nblk; ++b) {
        const bf16* vp = KV + (size_t)(b * 2 + g) * 8192 + 4096 + lane * 8;
        bf16x8v vf[2][4];
#pragma unroll
        for (int i2 = 0; i2 < 2; ++i2)
#pragma unroll
            for (int dt = 0; dt < 4; ++dt) vf[i2][dt] = *(const bf16x8v*)(vp + (i2 * 4 + dt) * 512);
        float p[4][4];
#pragma unroll
        for (int kt = 0; kt < 4; ++kt)
#pragma unroll
            for (int j = 0; j < 4; ++j) p[kt][j] = __builtin_amdgcn_exp2f(sc[(b * 64 + 16 * kt + 4 * q4 + j) * 4 + hh]);
#pragma unroll
        for (int i2 = 0; i2 < 2; ++i2) { v4u w; w.x = pg8::cvt_pk_bf16(p[2 * i2][0], p[2 * i2][1]); w.y = pg8::cvt_pk_bf16(p[2 * i2][2], p[2 * i2][3]); w.z = pg8::cvt_pk_bf16(p[2 * i2 + 1][0], p[2 * i2 + 1][1]); w.w = pg8::cvt_pk_bf16(p[2 * i2 + 1][2], p[2 * i2 + 1][3]);
            const bf16x8v pf = __builtin_bit_cast(bf16x8v, w);
#pragma unroll
            for (int dt = 0; dt < 4; ++dt) o[dt] = MFMA16(vf[i2][dt], pf, o[dt]); }
    }
}
__device__ __forceinline__ int mf_select(int nkeys, int nsb, int cur, LAS float* wscr, float l, int lane, bool excl = false, int K = 16) {
    const LAS f32x4* sc4 = (const LAS f32x4*)((const LAS unsigned char*)wscr + AW_SC); LAS int* sel = (LAS int*)((LAS unsigned char*)wscr + AW_SEL);
    float rl[4];
#pragma unroll
    for (int h = 0; h < 4; ++h) { const float lh = __builtin_bit_cast(float, __builtin_amdgcn_readlane(__builtin_bit_cast(int, l), h)); rl[h] = lh > 0.f ? 1.0f / lh : 0.f; }
    int v[5];
#pragma unroll
    for (int i = 0; i < 5; ++i) { const int sb = lane + 64 * i; float imp = 0.f;
        if (i < 4) {
#pragma unroll
            for (int j = 0; j < 2; ++j) { const int k = 2 * sb + j; if (k < nkeys) { const f32x4 x = sc4[k];
                imp += __builtin_amdgcn_exp2f(x.x) * rl[0] + __builtin_amdgcn_exp2f(x.y) * rl[1] + __builtin_amdgcn_exp2f(x.z) * rl[2] + __builtin_amdgcn_exp2f(x.w) * rl[3]; } } }
        const float val = (sb >= nsb || sb > cur) ? -1.0f : ((sb == 0 || sb == cur || sb == cur - 1) ? (excl ? -1.0f : 1.0e4f) : imp);
        v[i] = __builtin_bit_cast(int, val); }
    int thr = 0;
#pragma unroll 1
    for (int bit = 30; bit >= 0; --bit) { const int tr = thr | (1 << bit); int cnt = 0;
#pragma unroll
        for (int i = 0; i < 5; ++i) cnt += __builtin_popcountll(__builtin_amdgcn_ballot_w64(v[i] >= tr));
        if (cnt >= K) thr = tr; }
    int n = 0;
    const unsigned lo_mask_lo = __builtin_amdgcn_mbcnt_lo(~0u, 0u);
    (void)lo_mask_lo;
#pragma unroll
    for (int pass = 0; pass < 2; ++pass)
#pragma unroll
        for (int i = 0; i < 5; ++i) { const bool pick = pass == 0 ? (v[i] > thr) : (v[i] == thr);
            const unsigned long long mk = __builtin_amdgcn_ballot_w64(pick);
            const int before = (int)__builtin_amdgcn_mbcnt_hi((unsigned)(mk >> 32), __builtin_amdgcn_mbcnt_lo((unsigned)mk, 0u));
            const int slot = n + before;
            if (pick && slot < K) sel[slot] = lane + 64 * i;
            n += __builtin_popcountll(mk); }
    LDS_WAIT();
    return n < K ? n : K;
}
__device__ __forceinline__ void attn_prompt_mfma(Frame& F, const Args& A, int t, int g, LAS float* wscr, const LAS float* btab, bf16* yab) {
    const int lane = LANE(), q4 = lane >> 4, c = lane & 15;
#if DBG_SECT >= 0
    LAS unsigned long long* tacc = (LAS unsigned long long*)((LAS unsigned char*)wscr + 16000); unsigned long long ts0 = __builtin_amdgcn_s_memrealtime(), ts1;
#define SECT(k) do { asm volatile("s_waitcnt vmcnt(0) lgkmcnt(0)" ::: "memory"); ts1 = __builtin_amdgcn_s_memrealtime(); if (lane == 0) tacc[k] += ts1 - ts0; ts0 = ts1; } while (0)
#else
#define SECT(k) do {} while (0)
#endif
    bf16x8v qf[2];
    {   const float* qp = WSF(WS_QR) + (size_t)t * 512 + (g * 4 + (c & 3)) * 64 + 8 * q4;
#pragma unroll
        for (int ks = 0; ks < 2; ++ks) { const f32x4 a = *(const f32x4*)(qp + 32 * ks), b = *(const f32x4*)(qp + 32 * ks + 4);
            v4u w; const float qs = 0.125f * 1.4426950408889634f; w.x = pk2(a.x * qs, a.y * qs); w.y = pk2(a.z * qs, a.w * qs); w.z = pk2(b.x * qs, b.y * qs); w.w = pk2(b.z * qs, b.w * qs);
            if (c >= 4) w = (v4u){0u, 0u, 0u, 0u};
            qf[ks] = __builtin_bit_cast(bf16x8v, w); } }
    SECT(0);
    const float* g3 = WSF(WS_GATE) + (size_t)t * 24 + (g * 4 + (c & 3)) * 3;
    f32x4 of[4], o[4]; float l;
#pragma unroll
    for (int dt = 0; dt < 4; ++dt) of[dt] = (f32x4){0.f, 0.f, 0.f, 0.f};
    const int nvis = (t + 1) >> 5, cur = t >> 6; float lcmp = 0.f;
    {
        const int nb = (nvis + 63) >> 6;
        mf_branch<0, true>(WSB(WS_KVC), nb, 0, nullptr, t, -1, g, qf, btab + 114 * 8, wscr, l, o, lane);
        LDS_WAIT();
        mf_cmp_pv(WSB(WS_KVC), nb, g, wscr, o, lane);
        lcmp = l;
        if (l > 0.f) { const float sc_ = g3[0] / l;
#pragma unroll
            for (int dt = 0; dt < 4; ++dt) of[dt] += o[dt] * sc_; }
    }
    SECT(1);
    const int nsel = mf_select(nvis, 256, cur, wscr, lcmp, lane);
    SECT(2);
    {   mf_branch<1, false>(WSB(WS_KVS), nsel, 0, (const LAS int*)((LAS unsigned char*)wscr + AW_SEL), t, -1, g, qf, btab + 114 * 8, wscr, l, o, lane);
        if (l > 0.f) { const float sc_ = g3[1] / l;
#pragma unroll
            for (int dt = 0; dt < 4; ++dt) of[dt] += o[dt] * sc_; } }
    SECT(3);
    {   const int bl = (t - 511) < 0 ? 0 : (t - 511) >> 6;
        mf_branch<2, false>(WSB(WS_KVW), cur - bl + 1, bl, nullptr, t, t - 512, g, qf, btab + 114 * 8, wscr, l, o, lane);
        if (l > 0.f) { const float sc_ = g3[2] / l;
#pragma unroll
            for (int dt = 0; dt < 4; ++dt) of[dt] += o[dt] * sc_; } }
    SECT(4);
    if (c < 4) { bf16* y = yab + (size_t)t * D + 512 + (g * 4 + c) * 64 + 4 * q4;
#pragma unroll
        for (int dt = 0; dt < 4; ++dt) *(v2u*)(y + 16 * dt) = (v2u){pk2(of[dt][0], of[dt][1]), pk2(of[dt][2], of[dt][3])}; }
    SECT(5);
#undef SECT
}

template <int MODE, bool STASH>
__device__ __forceinline__ void mfx_block(const KVFrag& f, int b, int tl, bool act, int tmin, int tmax, int g, const bf16x8v (&qf)[2], const LAS float* btab2, LAS float* sc,
                                          float& l, f32x4 (&o)[4], int q4, int c) {
    const int hh = c & 3;
    f32x4 s[4];
#pragma unroll
    for (int kt = 0; kt < 4; ++kt) { s[kt] = MFMA16(f.kf[kt][0], qf[0], ((f32x4){0.f, 0.f, 0.f, 0.f})); s[kt] = MFMA16(f.kf[kt][1], qf[1], s[kt]); }
    const int kmax = b * 64 + 63, pmax = MODE == 0 ? 32 * kmax + 31 : kmax, pmin = MODE == 0 ? 32 * (b * 64) + 31 : b * 64;
    const bool far = (tmin - pmax >= 113) && (MODE != 2 || pmin > tmax - 512);
    if (far) { const float bb = act ? btab2[113 * 8 + g * 4 + hh] : -1e30f;
#pragma unroll
        for (int kt = 0; kt < 4; ++kt)
#pragma unroll
            for (int j = 0; j < 4; ++j) s[kt][j] = fminf(s[kt][j] + bb, 64.0f);
    } else { const int lo = MODE == 2 ? tl - 512 : -1;
#pragma unroll
        for (int kt = 0; kt < 4; ++kt)
#pragma unroll
            for (int j = 0; j < 4; ++j) { const int k = b * 64 + 16 * kt + 4 * q4 + j, pos = MODE == 0 ? 32 * k + 31 : k; const bool ok = act && pos <= tl && pos > lo;
                int d = tl - pos; d = d < 0 ? 0 : (d > 113 ? 113 : d);
                const float bias = btab2[d * 8 + g * 4 + hh];
                s[kt][j] = ok ? fminf(s[kt][j] + bias, 64.0f) : -1e30f; }
    }
    if (STASH) {
#pragma unroll
        for (int kt = 0; kt < 4; ++kt)
#pragma unroll
            for (int j = 0; j < 4; ++j) { if (act) sc[(b * 64 + 16 * kt + 4 * q4 + j) * 4 + hh] = s[kt][j]; }
    }
#pragma unroll
    for (int kt = 0; kt < 4; ++kt)
#pragma unroll
        for (int j = 0; j < 4; ++j) { const float p = __builtin_amdgcn_exp2f(s[kt][j]); s[kt][j] = p; l += p; }
    if (!STASH) {
        bf16x8v pf[2];
#pragma unroll
        for (int i2 = 0; i2 < 2; ++i2) { v4u w; w.x = pg8::cvt_pk_bf16(s[2 * i2][0], s[2 * i2][1]); w.y = pg8::cvt_pk_bf16(s[2 * i2][2], s[2 * i2][3]); w.z = pg8::cvt_pk_bf16(s[2 * i2 + 1][0], s[2 * i2 + 1][1]); w.w = pg8::cvt_pk_bf16(s[2 * i2 + 1][2], s[2 * i2 + 1][3]);
            pf[i2] = __builtin_bit_cast(bf16x8v, w); }
#pragma unroll
        for (int dt = 0; dt < 4; ++dt) { o[dt] = MFMA16(f.vf[0][dt], pf[0], o[dt]); o[dt] = MFMA16(f.vf[1][dt], pf[1], o[dt]); }
    }
}
template <int MODE>
__device__ __forceinline__ void mfx_scores(const KVFrag& f, int b, int tl, bool act, int tmin, int tmax, int g, const bf16x8v (&qf)[2], const LAS float* btab2, int q4, int c, f32x4 (&s)[4]) {
    const int hh = c & 3;
#pragma unroll
    for (int kt = 0; kt < 4; ++kt) { s[kt] = MFMA16(f.kf[kt][0], qf[0], ((f32x4){0.f, 0.f, 0.f, 0.f})); s[kt] = MFMA16(f.kf[kt][1], qf[1], s[kt]); }
    const int kmax = b * 64 + 63, pmax = MODE == 0 ? 32 * kmax + 31 : kmax, pmin = MODE == 0 ? 32 * (b * 64) + 31 : b * 64;
    const bool far = (tmin - pmax >= 113) && (MODE != 2 || pmin > tmax - 512);
    if (far) { const float bb = act ? btab2[113 * 8 + g * 4 + hh] : -1e30f;
#pragma unroll
        for (int kt = 0; kt < 4; ++kt)
#pragma unroll
            for (int j = 0; j < 4; ++j) s[kt][j] = fminf(s[kt][j] + bb, 64.0f);
    } else { const int lo = MODE == 2 ? tl - 512 : -1;
#pragma unroll
        for (int kt = 0; kt < 4; ++kt)
#pragma unroll
            for (int j = 0; j < 4; ++j) { const int k = b * 64 + 16 * kt + 4 * q4 + j, pos = MODE == 0 ? 32 * k + 31 : k; const bool ok = act && pos <= tl && pos > lo;
                int d = tl - pos; d = d < 0 ? 0 : (d > 113 ? 113 : d);
                const float bias = btab2[d * 8 + g * 4 + hh];
                s[kt][j] = ok ? fminf(s[kt][j] + bias, 64.0f) : -1e30f; }
    }
}
__device__ __forceinline__ float dpp_xor1(float v) { return __builtin_bit_cast(float, __builtin_amdgcn_update_dpp(0, __builtin_bit_cast(int, v), 0xB1, 0xF, 0xF, true)); }
__device__ __forceinline__ float dpp_xor2(float v) { return __builtin_bit_cast(float, __builtin_amdgcn_update_dpp(0, __builtin_bit_cast(int, v), 0x4E, 0xF, 0xF, true)); }
__device__ __forceinline__ int mfx_cmp_pack(const bf16* KV, int t0, int tl, int g, const bf16x8v (&qf)[2], const LAS float* btab2, LAS float* impq, float& l, f32x4 (&o)[4], int lane) {
    const int q4 = lane >> 4, c = lane & 15, qc = c >> 2;
    const int nb = ((((t0 + 4) >> 5)) + 63) >> 6;
    l = 0.f;
#pragma unroll
    for (int dt = 0; dt < 4; ++dt) o[dt] = (f32x4){0.f, 0.f, 0.f, 0.f};
    for (int b = 0; b < nb; ++b) { KVFrag f; kv_load<false>(f, KV, b, g, lane); f32x4 s[4]; mfx_scores<0>(f, b, tl, true, t0, t0 + 3, g, qf, btab2, q4, c, s);
#pragma unroll
        for (int kt = 0; kt < 4; ++kt)
#pragma unroll
            for (int j = 0; j < 4; ++j) l += __builtin_amdgcn_exp2f(s[kt][j]); }
    l += __shfl_xor(l, 16); l += __shfl_xor(l, 32);
    const float rl = l > 0.f ? 1.0f / l : 0.f;
    for (int b = 0; b < nb; ++b) { KVFrag f; kv_load<true>(f, KV, b, g, lane); f32x4 s[4]; mfx_scores<0>(f, b, tl, true, t0, t0 + 3, g, qf, btab2, q4, c, s);
#pragma unroll
        for (int kt = 0; kt < 4; ++kt)
#pragma unroll
            for (int j = 0; j < 4; ++j) s[kt][j] = __builtin_amdgcn_exp2f(s[kt][j]);
#pragma unroll
        for (int kt = 0; kt < 4; ++kt)
#pragma unroll
            for (int jp = 0; jp < 2; ++jp) { float v = (s[kt][2 * jp] + s[kt][2 * jp + 1]) * rl; v += dpp_xor1(v); v += dpp_xor2(v);
                if ((c & 3) == 0) impq[qc * 256 + b * 32 + 8 * kt + 2 * q4 + jp] = v; }
        bf16x8v pf[2];
#pragma unroll
        for (int i2 = 0; i2 < 2; ++i2) { v4u w; w.x = pg8::cvt_pk_bf16(s[2 * i2][0], s[2 * i2][1]); w.y = pg8::cvt_pk_bf16(s[2 * i2][2], s[2 * i2][3]); w.z = pg8::cvt_pk_bf16(s[2 * i2 + 1][0], s[2 * i2 + 1][1]); w.w = pg8::cvt_pk_bf16(s[2 * i2 + 1][2], s[2 * i2 + 1][3]);
            pf[i2] = __builtin_bit_cast(bf16x8v, w); }
#pragma unroll
        for (int dt = 0; dt < 4; ++dt) { o[dt] = MFMA16(f.vf[0][dt], pf[0], o[dt]); o[dt] = MFMA16(f.vf[1][dt], pf[1], o[dt]); }
    }
    LDS_WAIT();
    return nb * 32;
}
__device__ __forceinline__ int mf_select_lds(const LAS float* imp, int nsbw, int nsb, int cur, LAS float* wscr, int lane, bool excl, int K) {
    LAS int* sel = (LAS int*)((LAS unsigned char*)wscr + AW_SEL);
    int v[5];
#pragma unroll
    for (int i = 0; i < 5; ++i) { const int sb = lane + 64 * i; const float im = (i < 4 && sb < nsbw) ? imp[sb] : 0.f;
        const float val = (sb >= nsb || sb > cur) ? -1.0f : ((sb == 0 || sb == cur || sb == cur - 1) ? (excl ? -1.0f : 1.0e4f) : im);
        v[i] = __builtin_bit_cast(int, val); }
    int thr = 0;
#pragma unroll 1
    for (int bit = 30; bit >= 0; --bit) { const int tr = thr | (1 << bit); int cnt = 0;
#pragma unroll
        for (int i = 0; i < 5; ++i) cnt += __builtin_popcountll(__builtin_amdgcn_ballot_w64(v[i] >= tr));
        if (cnt >= K) thr = tr; }
    int n = 0;
#pragma unroll
    for (int pass = 0; pass < 2; ++pass)
#pragma unroll
        for (int i = 0; i < 5; ++i) { const bool pick = pass == 0 ? (v[i] > thr) : (v[i] == thr);
            const unsigned long long mk = __builtin_amdgcn_ballot_w64(pick);
            const int before = (int)__builtin_amdgcn_mbcnt_hi((unsigned)(mk >> 32), __builtin_amdgcn_mbcnt_lo((unsigned)mk, 0u));
            const int slot = n + before;
            if (pick && slot < K) sel[slot] = lane + 64 * i;
            n += __builtin_popcountll(mk); }
    LDS_WAIT();
    return n < K ? n : K;
}
#if SEL_FP8
struct KVFrag8 { v4u k[4]; bf16x8v vf[2][4]; };
__device__ __forceinline__ void kv_load8(KVFrag8& f, const bf16* KV, int b, int g, int lane) {
    const unsigned char* p8 = (const unsigned char*)(KV + (size_t)(b * 2 + g) * 8192) + lane * 16;
#pragma unroll
    for (int kt = 0; kt < 4; ++kt) f.k[kt] = *(const v4u*)(p8 + kt * 1024);
    const bf16* p = KV + (size_t)(b * 2 + g) * 8192 + lane * 8;
#pragma unroll
    for (int i2 = 0; i2 < 2; ++i2)
#pragma unroll
        for (int dt = 0; dt < 4; ++dt) f.vf[i2][dt] = *(const bf16x8v*)(p + 4096 + (i2 * 4 + dt) * 512);
}
__device__ __forceinline__ void mfx_block8(const KVFrag8& f, int b, int tl, bool act, int tmin, int g, const long (&q8)[2], const LAS float* btab2, float& l, f32x4 (&o)[4], int q4, int c) {
    const int hh = c & 3; const float qs = 0.125f * 1.4426950408889634f;
    f32x4 s[4];
#pragma unroll
    for (int kt = 0; kt < 4; ++kt) { const long k0 = (long)(((unsigned long long)f.k[kt].y << 32) | f.k[kt].x), k1 = (long)(((unsigned long long)f.k[kt].w << 32) | f.k[kt].z);
        s[kt] = __builtin_amdgcn_mfma_f32_16x16x32_fp8_fp8(k0, q8[0], ((f32x4){0.f, 0.f, 0.f, 0.f}), 0, 0, 0); s[kt] = __builtin_amdgcn_mfma_f32_16x16x32_fp8_fp8(k1, q8[1], s[kt], 0, 0, 0); }
    const int pmax = b * 64 + 63;
    const bool far = (tmin - pmax >= 113);
    if (far) { const float bb = act ? btab2[113 * 8 + g * 4 + hh] : -1e30f;
#pragma unroll
        for (int kt = 0; kt < 4; ++kt)
#pragma unroll
            for (int j = 0; j < 4; ++j) s[kt][j] = fminf(s[kt][j] * qs + bb, 64.0f);
    } else {
#pragma unroll
        for (int kt = 0; kt < 4; ++kt)
#pragma unroll
            for (int j = 0; j < 4; ++j) { const int pos = b * 64 + 16 * kt + 4 * q4 + j; const bool ok = act && pos <= tl;
                int d = tl - pos; d = d < 0 ? 0 : (d > 113 ? 113 : d);
                const float bias = btab2[d * 8 + g * 4 + hh];
                s[kt][j] = ok ? fminf(s[kt][j] * qs + bias, 64.0f) : -1e30f; }
    }
#pragma unroll
    for (int kt = 0; kt < 4; ++kt)
#pragma unroll
        for (int j = 0; j < 4; ++j) { const float p = __builtin_amdgcn_exp2f(s[kt][j]); s[kt][j] = p; l += p; }
    bf16x8v pf[2];
#pragma unroll
    for (int i2 = 0; i2 < 2; ++i2) { v4u w; w.x = pg8::cvt_pk_bf16(s[2 * i2][0], s[2 * i2][1]); w.y = pg8::cvt_pk_bf16(s[2 * i2][2], s[2 * i2][3]); w.z = pg8::cvt_pk_bf16(s[2 * i2 + 1][0], s[2 * i2 + 1][1]); w.w = pg8::cvt_pk_bf16(s[2 * i2 + 1][2], s[2 * i2 + 1][3]);
        pf[i2] = __builtin_bit_cast(bf16x8v, w); }
#pragma unroll
    for (int dt = 0; dt < 4; ++dt) { o[dt] = MFMA16(f.vf[0][dt], pf[0], o[dt]); o[dt] = MFMA16(f.vf[1][dt], pf[1], o[dt]); }
}
#endif
template <int MODE, bool STASH, bool ACCUM = false>
__device__ __forceinline__ void mfx_branch(const bf16* KV, int nblk, int b0, const LAS int* sel, int tl, bool act, int tmin, int tmax, int g, const bf16x8v (&qf)[2],
                                           const LAS float* btab2, LAS float* wscr, float& l, f32x4 (&o)[4], int lane) {
    const int q4 = lane >> 4, c = lane & 15;
    LAS float* sc = (LAS float*)((LAS unsigned char*)wscr + AW_SC);
    if (!ACCUM) { l = 0.f;
#pragma unroll
        for (int dt = 0; dt < 4; ++dt) o[dt] = (f32x4){0.f, 0.f, 0.f, 0.f}; }
    for (int i = 0; i < nblk; ++i) { const int bA = MODE == 0 ? i : (MODE == 1 ? __builtin_amdgcn_readfirstlane(sel[i]) : b0 + i);
        KVFrag f0; kv_load<!STASH>(f0, KV, bA, g, lane); mfx_block<MODE, STASH>(f0, bA, tl, act, tmin, tmax, g, qf, btab2, sc, l, o, q4, c); }
    if (!ACCUM) { l += __shfl_xor(l, 16); l += __shfl_xor(l, 32); }
}
__device__ __forceinline__ void mfx_cmp_pv(const bf16* KV, int nblk, int g, const LAS float* wscr, bool act, f32x4 (&o)[4], int lane) {
    const int q4 = lane >> 4, c = lane & 15, hh = c & 3;
    const LAS float* sc = (const LAS float*)((const LAS unsigned char*)wscr + AW_SC);
    for (int b = 0; b < nblk; ++b) {
        const bf16* vp = KV + (size_t)(b * 2 + g) * 8192 + 4096 + lane * 8;
        bf16x8v vf[2][4];
#pragma unroll
        for (int i2 = 0; i2 < 2; ++i2)
#pragma unroll
            for (int dt = 0; dt < 4; ++dt) vf[i2][dt] = *(const bf16x8v*)(vp + (i2 * 4 + dt) * 512);
        float p[4][4];
#pragma unroll
        for (int kt = 0; kt < 4; ++kt)
#pragma unroll
            for (int j = 0; j < 4; ++j) { const float e = __builtin_amdgcn_exp2f(sc[(b * 64 + 16 * kt + 4 * q4 + j) * 4 + hh]); p[kt][j] = act ? e : 0.f; }
#pragma unroll
        for (int i2 = 0; i2 < 2; ++i2) { v4u w; w.x = pg8::cvt_pk_bf16(p[2 * i2][0], p[2 * i2][1]); w.y = pg8::cvt_pk_bf16(p[2 * i2][2], p[2 * i2][3]); w.z = pg8::cvt_pk_bf16(p[2 * i2 + 1][0], p[2 * i2 + 1][1]); w.w = pg8::cvt_pk_bf16(p[2 * i2 + 1][2], p[2 * i2 + 1][3]);
            const bf16x8v pf = __builtin_bit_cast(bf16x8v, w);
#pragma unroll
            for (int dt = 0; dt < 4; ++dt) o[dt] = MFMA16(vf[i2][dt], pf, o[dt]); }
    }
}
__device__ __forceinline__ void attn_prompt_pack(Frame& F, const Args& A, int t0, int g, LAS float* wscr, const LAS float* btab, bf16* yab) {
    const int lane = LANE(), q4 = lane >> 4, c = lane & 15, qc = c >> 2, tl = t0 + qc;
    const LAS float* btab2 = btab + 114 * 8;
    bf16x8v qf16[2];
    {   const float* qp = WSF(WS_QR) + (size_t)tl * 512 + (g * 4 + (c & 3)) * 64 + 8 * q4; const float qs = 0.125f * 1.4426950408889634f;
#pragma unroll
        for (int ks = 0; ks < 2; ++ks) { const f32x4 a = *(const f32x4*)(qp + 32 * ks), b = *(const f32x4*)(qp + 32 * ks + 4);
            v4u w; w.x = pk2(a.x * qs, a.y * qs); w.y = pk2(a.z * qs, a.w * qs); w.z = pk2(b.x * qs, b.y * qs); w.w = pk2(b.z * qs, b.w * qs);
            qf16[ks] = __builtin_bit_cast(bf16x8v, w); } }
#if SEL_FP8
    long q8[2];
    {   const float* qp = WSF(WS_QR) + (size_t)tl * 512 + (g * 4 + (c & 3)) * 64 + 8 * q4;
#pragma unroll
        for (int ks = 0; ks < 2; ++ks) { const f32x4 a = *(const f32x4*)(qp + 32 * ks), b = *(const f32x4*)(qp + 32 * ks + 4);
            int w0 = __builtin_amdgcn_cvt_pk_fp8_f32(a.x, a.y, 0, false); w0 = __builtin_amdgcn_cvt_pk_fp8_f32(a.z, a.w, w0, true);
            int w1 = __builtin_amdgcn_cvt_pk_fp8_f32(b.x, b.y, 0, false); w1 = __builtin_amdgcn_cvt_pk_fp8_f32(b.z, b.w, w1, true);
            q8[ks] = (long)(((unsigned long long)(unsigned)w1 << 32) | (unsigned)w0); } }
#endif
    const float* g3 = WSF(WS_GATE) + (size_t)tl * 24 + (g * 4 + (c & 3)) * 3;
    f32x4 of[4], o[4]; float l;
#pragma unroll
    for (int dt = 0; dt < 4; ++dt) of[dt] = (f32x4){0.f, 0.f, 0.f, 0.f};
    {
        const int bl = (t0 - 511) < 0 ? 0 : (t0 - 511) >> 6, bh = (t0 + 3) >> 6;
        mfx_branch<2, false>(WSB(WS_KVW), bh - bl + 1, bl, nullptr, tl, true, t0, t0 + 3, g, qf16, btab2, wscr, l, o, lane);
        if (l > 0.f) { const float sc_ = g3[2] / l;
#pragma unroll
            for (int dt = 0; dt < 4; ++dt) of[dt] += o[dt] * sc_; } }
    f32x4 os[4]; float ls = 0.f;
#pragma unroll
    for (int dt = 0; dt < 4; ++dt) os[dt] = (f32x4){0.f, 0.f, 0.f, 0.f};
    const int cur0 = t0 >> 6; const bool uni = cur0 == ((t0 + 3) >> 6); const int nf = uni ? (cur0 >= 2 ? 3 : cur0 + 1) : 0;
    for (int i = 0; i < nf; ++i) { const int b = i == 0 ? 0 : cur0 - (nf - 1 - i);
#if SEL_FP8
        KVFrag8 f; kv_load8(f, WSB(WS_KVS), b, g, lane); mfx_block8(f, b, tl, true, t0, g, q8, btab2, ls, os, q4, c); }
#else
        KVFrag f; kv_load<true>(f, WSB(WS_KVS), b, g, lane); mfx_block<1, false>(f, b, tl, true, t0, t0 + 3, g, qf16, btab2, nullptr, ls, os, q4, c); }
#endif
    LAS float* impq = (LAS float*)((LAS unsigned char*)wscr + AW_SC);
    const int nsbw = mfx_cmp_pack(WSB(WS_KVC), t0, tl, g, qf16, btab2, impq, l, o, lane);
    if (l > 0.f) { const float sc_ = g3[0] / l;
#pragma unroll
        for (int dt = 0; dt < 4; ++dt) of[dt] += o[dt] * sc_; }
#pragma unroll 1
    for (int qi = 0; qi < 4; ++qi) {
        const int t = t0 + qi, cur = t >> 6; const bool act = qc == qi;
        const int nsel = mf_select_lds(impq + qi * 256, nsbw, 256, cur, wscr, lane, uni, 16 - nf);
#if SEL_FP8
        {   const LAS int* sel = (const LAS int*)((LAS unsigned char*)wscr + AW_SEL);
            for (int i = 0; i < nsel; ++i) { const int bA = __builtin_amdgcn_readfirstlane(sel[i]); KVFrag8 f; kv_load8(f, WSB(WS_KVS), bA, g, lane); mfx_block8(f, bA, t, act, t, g, q8, btab2, ls, os, q4, c); } }
#else
        mfx_branch<1, false, true>(WSB(WS_KVS), nsel, 0, (const LAS int*)((LAS unsigned char*)wscr + AW_SEL), t, act, t, t, g, qf16, btab2, wscr, ls, os, lane);
#endif
        LDS_WAIT();
    }
    ls += __shfl_xor(ls, 16); ls += __shfl_xor(ls, 32);
    if (ls > 0.f) { const float sc_ = g3[1] / ls;
#pragma unroll
        for (int dt = 0; dt < 4; ++dt) of[dt] += os[dt] * sc_; }
    {   bf16* y = yab + (size_t)tl * D + 512 + (g * 4 + (c & 3)) * 64 + 4 * q4;
#pragma unroll
        for (int dt = 0; dt < 4; ++dt) *(v2u*)(y + 16 * dt) = (v2u){pk2(of[dt][0], of[dt][1]), pk2(of[dt][2], of[dt][3])}; }
}

template <bool SAMPLE>
__device__ __forceinline__ void cmp_mfma(Frame& F, const Args& A, int b, int pgp, float* kcs, float* vcs, int ks0 = 0, int ks1 = 64, LAS float* part = nullptr, int nparts = 1) {
    const int lane = LANE(), q4 = lane >> 4, r = lane & 15, pg2 = r >> 3, jj = (r >> 1) & 3, g = r & 1;
    const float* rowbase;
    if (SAMPLE) { const int phys = ((const int*)A.in[I_PT])[b * NPG + 2 * pgp + pg2]; rowbase = A.in[I_CKV] + ((size_t)(phys * 128 + 32 * jj) * 4) * 128 + g * 64 + 8 * q4; }
    else rowbase = F.out + O_KVP + (size_t)(32 * (8 * pgp + (r >> 1))) * 512 + g * 64 + 8 * q4;
    const bf16* wk = WSB(WS_WCT) + (size_t)r * 2048 + 8 * q4;
    const float* pek = A.in[I_PEK] + 8 * q4; const float* pev = A.in[I_PEV] + 8 * q4;
    f32x4 acc[2][4];
#pragma unroll
    for (int kv = 0; kv < 2; ++kv)
#pragma unroll
        for (int nt = 0; nt < 4; ++nt) acc[kv][nt] = (f32x4){0.f, 0.f, 0.f, 0.f};
#pragma unroll 2
    for (int ks = ks0; ks < ks1; ++ks) {
        const int i = ks >> 1, co = (ks & 1) * 32;
        const float* ap = rowbase + (size_t)i * 512 + co;
        const f32x4 k0 = *(const f32x4*)ap, k1 = *(const f32x4*)(ap + 4), v0 = *(const f32x4*)(ap + 128), v1 = *(const f32x4*)(ap + 132);
        const f32x4 pk0 = *(const f32x4*)(pek + i * 64 + co), pk1 = *(const f32x4*)(pek + i * 64 + co + 4), pv0 = *(const f32x4*)(pev + i * 64 + co), pv1 = *(const f32x4*)(pev + i * 64 + co + 4);
        bf16x8v bk[4], bv[4];
#pragma unroll
        for (int nt = 0; nt < 4; ++nt) { bk[nt] = *(const bf16x8v*)(wk + (size_t)nt * 16 * 2048 + ks * 32); bv[nt] = *(const bf16x8v*)(wk + (size_t)(64 + nt * 16) * 2048 + ks * 32); }
        const f32x4 a0 = k0 + pk0, a1 = k1 + pk1, c0 = v0 + pv0, c1 = v1 + pv1;
        const bf16x8v ak = __builtin_bit_cast(bf16x8v, ((v4u){pk2(a0.x, a0.y), pk2(a0.z, a0.w), pk2(a1.x, a1.y), pk2(a1.z, a1.w)}));
        const bf16x8v av = __builtin_bit_cast(bf16x8v, ((v4u){pk2(c0.x, c0.y), pk2(c0.z, c0.w), pk2(c1.x, c1.y), pk2(c1.z, c1.w)}));
#pragma unroll
        for (int nt = 0; nt < 4; ++nt) { acc[0][nt] = MFMA16(ak, bk[nt], acc[0][nt]); acc[1][nt] = MFMA16(av, bv[nt], acc[1][nt]); }
    }
    if (nparts > 1) {
        const int slot = ks0 / (ks1 - ks0);
        if (slot != 0) {
#pragma unroll
            for (int kv = 0; kv < 2; ++kv)
#pragma unroll
                for (int nt = 0; nt < 4; ++nt) *(LAS f32x4*)(part + ((slot - 1) * 8 + kv * 4 + nt) * 256 + lane * 4) = acc[kv][nt];
        }
        asm volatile("s_waitcnt vmcnt(0) lgkmcnt(0)" ::: "memory"); __syncthreads(); asm volatile("" ::: "memory");
        if (slot == 0)
        for (int sl = 0; sl < nparts - 1; ++sl)
#pragma unroll
            for (int kv = 0; kv < 2; ++kv)
#pragma unroll
                for (int nt = 0; nt < 4; ++nt) acc[kv][nt] += *(const LAS f32x4*)(part + (sl * 8 + kv * 4 + nt) * 256 + lane * 4);
    }
    if (nparts == 1 || ks0 == 0)
#pragma unroll
    for (int rg = 0; rg < 4; ++rg) { const int ro = 4 * q4 + rg, j = SAMPLE ? 4 * (2 * pgp + (ro >> 3)) + ((ro >> 1) & 3) : 8 * pgp + (ro >> 1), gg = ro & 1;
        float ss = 0.f;
#pragma unroll
        for (int nt = 0; nt < 4; ++nt) ss += acc[0][nt][rg] * acc[0][nt][rg];
        ss += __shfl_xor(ss, 1); ss += __shfl_xor(ss, 2); ss += __shfl_xor(ss, 4); ss += __shfl_xor(ss, 8);
        const float rstd = 1.0f / sqrtf(ss * (1.0f / 64.0f) + EPS);
        const size_t off = ((size_t)(b * 512 + j) * 2 + gg) * 64 + r;
#pragma unroll
        for (int nt = 0; nt < 4; ++nt) { const float kcv = acc[0][nt][rg] * rstd * A.in[I_KG][16 * nt + r], vcv = acc[1][nt][rg];
            kcs[off + 16 * nt] = kcv; vcs[off + 16 * nt] = vcv;
            bf16* tile = SAMPLE ? WSB(WS_KVCS) + (size_t)((b * 8 + (j >> 6)) * 2 + gg) * 8192 : WSB(WS_KVC) + (size_t)((j >> 6) * 2 + gg) * 8192;
            tile[kv_off_k(j & 63, 16 * nt + r)] = (bf16)f2bf(kcv); tile[kv_off_v(vt_slot(j & 63), 16 * nt + r)] = (bf16)f2bf(vcv); } }
}

__device__ __forceinline__ void cmp_sample2(Frame& F, const Args& A, int b, int pq, float* kcs, float* vcs, LAS float* wscr) {
    const int lane = LANE(), q4 = lane >> 4, r = lane & 15, pg2 = r >> 3, jj = (r >> 1) & 3, g = r & 1;
    {   f32x4 t[16];
#pragma unroll
        for (int j = 0; j < 8; ++j) { t[j] = ((const f32x4*)A.in[I_PEK])[lane + 64 * j]; t[8 + j] = ((const f32x4*)A.in[I_PEV])[lane + 64 * j]; }
#pragma unroll
        for (int j = 0; j < 16; ++j) *(LAS f32x4*)(wscr + (size_t)(lane + 64 * j) * 4) = t[j]; }
    LDS_WAIT();
    const float* rb0; const float* rb1;
    {   const int ph0 = ((const int*)A.in[I_PT])[b * NPG + 4 * pq + pg2], ph1 = ((const int*)A.in[I_PT])[b * NPG + 4 * pq + 2 + pg2];
        rb0 = A.in[I_CKV] + ((size_t)(ph0 * 128 + 32 * jj) * 4) * 128 + g * 64 + 8 * q4; rb1 = A.in[I_CKV] + ((size_t)(ph1 * 128 + 32 * jj) * 4) * 128 + g * 64 + 8 * q4; }
    const bf16* wk = WSB(WS_WCT) + (size_t)r * 2048 + 8 * q4;
    const LAS float* pel = wscr + 8 * q4;
    f32x4 acc[2][2][4];
#pragma unroll
    for (int s = 0; s < 2; ++s)
#pragma unroll
        for (int kv = 0; kv < 2; ++kv)
#pragma unroll
            for (int nt = 0; nt < 4; ++nt) acc[s][kv][nt] = (f32x4){0.f, 0.f, 0.f, 0.f};
#pragma unroll 2
    for (int ks = 0; ks < 64; ++ks) {
        const int i = ks >> 1, co = (ks & 1) * 32;
        const float* ap0 = rb0 + (size_t)i * 512 + co; const float* ap1 = rb1 + (size_t)i * 512 + co;
        const f32x4 k00 = *(const f32x4*)ap0, k01 = *(const f32x4*)(ap0 + 4), v00 = *(const f32x4*)(ap0 + 128), v01 = *(const f32x4*)(ap0 + 132);
        const f32x4 k10 = *(const f32x4*)ap1, k11 = *(const f32x4*)(ap1 + 4), v10 = *(const f32x4*)(ap1 + 128), v11 = *(const f32x4*)(ap1 + 132);
        bf16x8v bk[4], bv[4];
#pragma unroll
        for (int nt = 0; nt < 4; ++nt) { bk[nt] = *(const bf16x8v*)(wk + (size_t)nt * 16 * 2048 + ks * 32); bv[nt] = *(const bf16x8v*)(wk + (size_t)(64 + nt * 16) * 2048 + ks * 32); }
        const f32x4 pk0 = *(const LAS f32x4*)(pel + i * 64 + co), pk1 = *(const LAS f32x4*)(pel + i * 64 + co + 4), pv0 = *(const LAS f32x4*)(pel + 2048 + i * 64 + co), pv1 = *(const LAS f32x4*)(pel + 2048 + i * 64 + co + 4);
        f32x4 a0 = k00 + pk0, a1 = k01 + pk1, c0 = v00 + pv0, c1 = v01 + pv1;
        const bf16x8v ak0 = __builtin_bit_cast(bf16x8v, ((v4u){pk2(a0.x, a0.y), pk2(a0.z, a0.w), pk2(a1.x, a1.y), pk2(a1.z, a1.w)}));
        const bf16x8v av0 = __builtin_bit_cast(bf16x8v, ((v4u){pk2(c0.x, c0.y), pk2(c0.z, c0.w), pk2(c1.x, c1.y), pk2(c1.z, c1.w)}));
        a0 = k10 + pk0; a1 = k11 + pk1; c0 = v10 + pv0; c1 = v11 + pv1;
        const bf16x8v ak1 = __builtin_bit_cast(bf16x8v, ((v4u){pk2(a0.x, a0.y), pk2(a0.z, a0.w), pk2(a1.x, a1.y), pk2(a1.z, a1.w)}));
        const bf16x8v av1 = __builtin_bit_cast(bf16x8v, ((v4u){pk2(c0.x, c0.y), pk2(c0.z, c0.w), pk2(c1.x, c1.y), pk2(c1.z, c1.w)}));
#pragma unroll
        for (int nt = 0; nt < 4; ++nt) { acc[0][0][nt] = MFMA16(ak0, bk[nt], acc[0][0][nt]); acc[0][1][nt] = MFMA16(av0, bv[nt], acc[0][1][nt]);
                                         acc[1][0][nt] = MFMA16(ak1, bk[nt], acc[1][0][nt]); acc[1][1][nt] = MFMA16(av1, bv[nt], acc[1][1][nt]); }
    }
#pragma unroll
    for (int s = 0; s < 2; ++s) { const int pgp = 2 * pq + s;
#pragma unroll
    for (int rg = 0; rg < 4; ++rg) { const int ro = 4 * q4 + rg, j = 4 * (2 * pgp + (ro >> 3)) + ((ro >> 1) & 3), gg = ro & 1;
        float ss = 0.f;
#pragma unroll
        for (int nt = 0; nt < 4; ++nt) ss += acc[s][0][nt][rg] * acc[s][0][nt][rg];
        ss += __shfl_xor(ss, 1); ss += __shfl_xor(ss, 2); ss += __shfl_xor(ss, 4); ss += __shfl_xor(ss, 8);
        const float rstd = 1.0f / sqrtf(ss * (1.0f / 64.0f) + EPS);
        const size_t off = ((size_t)(b * 512 + j) * 2 + gg) * 64 + r;
#pragma unroll
        for (int nt = 0; nt < 4; ++nt) { const float kcv = acc[s][0][nt][rg] * rstd * A.in[I_KG][16 * nt + r], vcv = acc[s][1][nt][rg];
            kcs[off + 16 * nt] = kcv; vcs[off + 16 * nt] = vcv;
            bf16* tile = WSB(WS_KVCS) + (size_t)((b * 8 + (j >> 6)) * 2 + gg) * 8192;
            tile[kv_off_k(j & 63, 16 * nt + r)] = (bf16)f2bf(kcv); tile[kv_off_v(vt_slot(j & 63), 16 * nt + r)] = (bf16)f2bf(vcv); } } }
    LDS_WAIT();
}
__device__ __forceinline__ void build_win_sample(Frame& F, const Args& A, int b, int blk) {
    const int lane = LANE();
#pragma unroll 8
    for (int r = 0; r < 64; r += 2) { const int rr = r + (lane >> 5), kidx = blk * 64 + rr, l = lane & 31;
        const float* src = kidx < 511 ? A.in[I_CWIN] + ((size_t)b * 512 + kidx + 1) * 256 : SMP(SM_WNS) + (size_t)b * 256;
        const f32x4 v = *(const f32x4*)(src + l * 4);
        *(v2u*)(WSB(WS_KVWS) + (size_t)((b * 8 + blk) * 2 + (l >> 4)) * 8192 + kv_off_k(rr, 4 * (l & 15))) = (v2u){pk2(v.x, v.y), pk2(v.z, v.w)}; }
#pragma unroll 1
    for (int g = 0; g < 2; ++g) {
        unsigned pk[32];
#pragma unroll
        for (int s2 = 0; s2 < 32; ++s2) { const int s0 = 2 * s2, i2 = s0 >> 5, q = (s0 & 31) >> 3, j = s0 & 7; const int r0 = 32 * i2 + (j < 4 ? 4 * q + j : 16 + 4 * q + (j - 4));
            const int k0 = blk * 64 + r0, k1 = k0 + 1;
            const float* p0 = k0 < 511 ? A.in[I_CWIN] + ((size_t)b * 512 + k0 + 1) * 256 : SMP(SM_WNS) + (size_t)b * 256;
            const float* p1 = k1 < 511 ? A.in[I_CWIN] + ((size_t)b * 512 + k1 + 1) * 256 : SMP(SM_WNS) + (size_t)b * 256;
            pk[s2] = pk2(p0[128 + g * 64 + lane], p1[128 + g * 64 + lane]); }
        bf16* tile = WSB(WS_KVWS) + (size_t)((b * 8 + blk) * 2 + g) * 8192;
#pragma unroll
        for (int i = 0; i < 8; ++i) *(v4u*)(tile + kv_off_v(32 * (i >> 2) + 8 * (i & 3), lane)) = (v4u){pk[4 * i], pk[4 * i + 1], pk[4 * i + 2], pk[4 * i + 3]};
    }
}
__device__ __forceinline__ void attn_sample_mfma(Frame& F, const Args& A, int b, int g, LAS float* wscr, const LAS float* btab, float* yabs) {
    const int lane = LANE(), q4 = lane >> 4, c = lane & 15;
    bf16x8v qf[2];
    {   const float* qp = SMP(SM_QS) + (size_t)b * 512 + (g * 4 + (c & 3)) * 64 + 8 * q4;
#pragma unroll
        for (int ks = 0; ks < 2; ++ks) { const f32x4 a = *(const f32x4*)(qp + 32 * ks), bq = *(const f32x4*)(qp + 32 * ks + 4);
            v4u w; const float qs = 0.125f * 1.4426950408889634f; w.x = pk2(a.x * qs, a.y * qs); w.y = pk2(a.z * qs, a.w * qs); w.z = pk2(bq.x * qs, bq.y * qs); w.w = pk2(bq.z * qs, bq.w * qs);
            if (c >= 4) w = (v4u){0u, 0u, 0u, 0u};
            qf[ks] = __builtin_bit_cast(bf16x8v, w); } }
    const float* g3 = SMP(SM_GATES) + b * 24 + (g * 4 + (c & 3)) * 3;
    f32x4 of[4], o[4]; float l, lcmp = 0.f;
#pragma unroll
    for (int dt = 0; dt < 4; ++dt) of[dt] = (f32x4){0.f, 0.f, 0.f, 0.f};
    {   mf_branch<0, true>(WSB(WS_KVCS) + (size_t)b * 8 * 2 * 8192, 8, 0, nullptr, T, -1, g, qf, btab + 114 * 8, wscr, l, o, lane);
        LDS_WAIT();
        mf_cmp_pv(WSB(WS_KVCS) + (size_t)b * 8 * 2 * 8192, 8, g, wscr, o, lane);
        lcmp = l;
        if (l > 0.f) { const float sc_ = g3[0] / l;
#pragma unroll
            for (int dt = 0; dt < 4; ++dt) of[dt] += o[dt] * sc_; }
    }
    const int nsel = mf_select(512, 257, 256, wscr, lcmp, lane);
    {
        const LAS int* sel = (const LAS int*)((LAS unsigned char*)wscr + AW_SEL); LAS bf16* vt = (LAS bf16*)((LAS unsigned char*)wscr + AW_SC);
        const int* pt = (const int*)A.in[I_PT] + b * NPG;
        LAS f32x4* park = (LAS f32x4*)((LAS unsigned char*)wscr + 11264) + lane * 4;
#pragma unroll
        for (int dt = 0; dt < 4; ++dt) park[dt] = of[dt];
        l = 0.f;
#pragma unroll
        for (int dt = 0; dt < 4; ++dt) o[dt] = (f32x4){0.f, 0.f, 0.f, 0.f};
        for (int n = 0; n < nsel; ++n) {
            const int blk = __builtin_amdgcn_readfirstlane(sel[n]);
            KVFrag f;
            if (blk < 256) {
                const int phys = pt[blk >> 1]; const float* base = A.in[I_CKV] + ((size_t)(phys * 128 + (blk & 1) * 64) * 4 + 2) * 128 + g * 64;
                f32x4 ka[4][2][2], va[16];
#pragma unroll
                for (int kt = 0; kt < 4; ++kt)
#pragma unroll
                    for (int ks = 0; ks < 2; ++ks) { const float* kp = base + (size_t)(16 * kt + c) * 512 + 32 * ks + 8 * q4; ka[kt][ks][0] = *(const f32x4*)kp; ka[kt][ks][1] = *(const f32x4*)(kp + 4); }
#pragma unroll
                for (int i = 0; i < 16; ++i) va[i] = *(const f32x4*)(base + 128 + (size_t)(q4 + 4 * i) * 512 + 4 * c);
#pragma unroll
                for (int kt = 0; kt < 4; ++kt)
#pragma unroll
                    for (int ks = 0; ks < 2; ++ks) { const f32x4 x = ka[kt][ks][0], y = ka[kt][ks][1];
                        f.kf[kt][ks] = __builtin_bit_cast(bf16x8v, ((v4u){pk2(x.x, x.y), pk2(x.z, x.w), pk2(y.x, y.y), pk2(y.z, y.w)})); }
                LDS_WAIT();
#pragma unroll
                for (int i = 0; i < 16; ++i) { const int sl = vt_slot(q4 + 4 * i);
                    vt[(4 * c + 0) * 64 + sl] = (bf16)f2bf(va[i].x); vt[(4 * c + 1) * 64 + sl] = (bf16)f2bf(va[i].y); vt[(4 * c + 2) * 64 + sl] = (bf16)f2bf(va[i].z); vt[(4 * c + 3) * 64 + sl] = (bf16)f2bf(va[i].w); }
            } else {
                const float* nr = F.out + O_KVS + (size_t)b * 512 + 256 + g * 64;
#pragma unroll
                for (int kt = 0; kt < 4; ++kt)
#pragma unroll
                    for (int ks = 0; ks < 2; ++ks) { v4u w = (v4u){0u, 0u, 0u, 0u};
                        if (kt == 0 && c == 0) { const f32x4 x = *(const f32x4*)(nr + 32 * ks + 8 * q4), y = *(const f32x4*)(nr + 32 * ks + 8 * q4 + 4); w = (v4u){pk2(x.x, x.y), pk2(x.z, x.w), pk2(y.x, y.y), pk2(y.z, y.w)}; }
                        f.kf[kt][ks] = __builtin_bit_cast(bf16x8v, w); }
                LDS_WAIT();
                for (int i = lane; i < 64 * 32; i += 64) ((LAS unsigned*)vt)[i] = 0u;
                LDS_WAIT();
                vt[lane * 64 + vt_slot(0)] = (bf16)f2bf(nr[128 + lane]);
            }
            LDS_WAIT();
#pragma unroll
            for (int i2 = 0; i2 < 2; ++i2)
#pragma unroll
                for (int dt = 0; dt < 4; ++dt) f.vf[i2][dt] = *(const LAS bf16x8v*)(vt + (16 * dt + c) * 64 + 32 * i2 + 8 * q4);
            mf_block<1, false>(f, blk, T, -1, g, qf, btab + 114 * 8, nullptr, l, o, q4, c);
        }
        l += __shfl_xor(l, 16); l += __shfl_xor(l, 32);
        LDS_WAIT();
#pragma unroll
        for (int dt = 0; dt < 4; ++dt) of[dt] = park[dt];
        if (l > 0.f) { const float sc_ = g3[1] / l;
#pragma unroll
            for (int dt = 0; dt < 4; ++dt) of[dt] += o[dt] * sc_; } }
    {   mf_branch<2, false>(WSB(WS_KVWS) + (size_t)b * 8 * 2 * 8192, 8, 0, nullptr, 511, -1, g, qf, btab + 114 * 8, wscr, l, o, lane);
        if (l > 0.f) { const float sc_ = g3[2] / l;
#pragma unroll
            for (int dt = 0; dt < 4; ++dt) of[dt] += o[dt] * sc_; } }
    if (c < 4) { float* y = yabs + (size_t)b * D + 512 + (g * 4 + c) * 64 + 4 * q4; bf16* yb = SMB(SB_YABS) + (size_t)b * D + 512 + (g * 4 + c) * 64 + 4 * q4;
#pragma unroll
        for (int dt = 0; dt < 4; ++dt) { *(f32x4*)(y + 16 * dt) = of[dt]; if (yabs == SMP(SM_YABS)) *(v2u*)(yb + 16 * dt) = (v2u){pk2(of[dt][0], of[dt][1]), pk2(of[dt][2], of[dt][3])}; } }
}

__device__ __forceinline__ void p0_prologue(Frame& F, const Args& A) {
    LAS float* scr = (LAS float*)(F.lds + RING_OFF + F.wave * 16384);
    const int gw = F.vcu * NWAVES + F.wave, NGW = F.G * NWAVES, lane = LANE();
    constexpr int I_IN0 = 16 * 73, I_SQ = 16 * 32, I_UP = 16 * 128, I_DN = 64 * 32, I_PJ = 4 * 32, I_IN1 = 16 * 64;
    constexpr int I_CW = 32 * 2;
    constexpr int NITEMS = I_IN0 + I_SQ + 2 * I_UP + 2 * I_DN + 2 * I_SQ + 2 * I_PJ + I_IN1 + I_SQ + 2 * I_CW;
    for (int it = gw; it < NITEMS; it += NGW) {
        int r = it;
        if (r < I_IN0) { transpose_item(A.in[I_WINE], D, EIN, A.in[I_GMIX], WSB(WS_WIN0), scr, r, lane, true); continue; } r -= I_IN0;
        if (r < I_SQ) { transpose_item(A.in[I_WOUTE], D, D, nullptr, WSB(WS_WOUT0), scr, r, lane); continue; } r -= I_SQ;
        if (r < I_UP) { transpose_item(A.in[I_WUP], D, FF, A.in[I_GMLP], WSB(WS_WUP), scr, r, lane); continue; } r -= I_UP;
        if (r < I_UP) { transpose_item(A.in[I_WUP] + (size_t)D * FF, D, FF, A.in[I_GMLP] + D, WSB(WS_WUP) + (size_t)D * FF, scr, r, lane); continue; } r -= I_UP;
        if (r < I_DN) { transpose_item(A.in[I_WDOWN], FF, D, nullptr, WSB(WS_WDOWN), scr, r, lane); continue; } r -= I_DN;
        if (r < I_DN) { transpose_item(A.in[I_WDOWN] + (size_t)D * FF, FF, D, nullptr, WSB(WS_WDOWN) + (size_t)D * FF, scr, r, lane); continue; } r -= I_DN;
        if (r < I_SQ) { transpose_item(A.in[I_WPG], D, D, A.in[I_GPLE], WSB(WS_WGATE), scr, r, lane); continue; } r -= I_SQ;
        if (r < I_SQ) { transpose_item(A.in[I_WPG] + (size_t)D * D, D, D, A.in[I_GPLE] + D, WSB(WS_WGATE) + (size_t)D * D, scr, r, lane); continue; } r -= I_SQ;
        if (r < I_PJ) { transpose_item(A.in[I_WPP], PLE, D, nullptr, WSB(WS_WPROJ), scr, r, lane); continue; } r -= I_PJ;
        if (r < I_PJ) { transpose_item(A.in[I_WPP] + (size_t)PLE * D, PLE, D, nullptr, WSB(WS_WPROJ) + (size_t)PLE * D, scr, r, lane); continue; } r -= I_PJ;
        if (r < I_IN1) { transpose_item(A.in[I_WINO], D, 2 * D, A.in[I_GMIX] + D, WSB(WS_WIN1), scr, r, lane); continue; } r -= I_IN1;
        if (r < I_SQ) { transpose_item(A.in[I_WOUTO], D, D, nullptr, WSB(WS_WOUT1), scr, r, lane); continue; } r -= I_SQ;
        if (r < I_CW) { transpose_item(A.in[I_CWK], 2048, 64, nullptr, WSB(WS_WCT), scr, r, lane); continue; } r -= I_CW;
        transpose_item(A.in[I_CWV], 2048, 64, nullptr, WSB(WS_WCT) + (size_t)64 * 2048, scr, r, lane);
    }
    {
        v4u* z = (v4u*)(WSB(WS_WIN0) + (size_t)2336 * D); const int n16 = (EINP - 2336) * D * 2 / 16;
        for (int i = gw * 64 + lane; i < n16; i += NGW * 64) z[i] = (v4u){0u, 0u, 0u, 0u};
    }
    for (int m = 2 * gw; m < T; m += 2 * NGW) x_row2_to_bf16(lane, A.in[I_XP] + (size_t)m * D, WSB(WS_HBA) + (size_t)m * D, WSF(WS_RSA) + (size_t)m * 16);
    for (int m = 4 * gw; m < 2 * T; m += 4 * NGW) { f32x4 v[4];
#pragma unroll
        for (int i = 0; i < 4; ++i) v[i] = *((const f32x4*)(A.in[I_PP] + (size_t)(m + i) * PLE) + lane);
#pragma unroll
        for (int i = 0; i < 4; ++i) *((v2u*)(WSB(WS_PB) + (size_t)(m + i) * PLE) + lane) = (v2u){pk2(v[i].x, v[i].y), pk2(v[i].z, v[i].w)}; }
    for (int i = gw * 64 + lane; i < 8 * 128 * 128 / 4; i += NGW * 64) { const f32x4 v = ((const f32x4*)A.in[I_SGW])[i]; const int tt = (i >> 5) & 127, s0 = (i & 31) * 4;
        ((v2u*)WSB(WS_SGWB))[i] = (v2u){pk2(s0 <= tt ? v.x : 0.f, s0 + 1 <= tt ? v.y : 0.f), pk2(s0 + 2 <= tt ? v.z : 0.f, s0 + 3 <= tt ? v.w : 0.f)}; }
    for (int i = gw * 64 + lane; i < 2 * NS * PLE / 4; i += NGW * 64) { const f32x4 v = ((const f32x4*)A.in[I_PS])[i]; ((v2u*)SMB(SB_PS))[i] = (v2u){pk2(v.x, v.y), pk2(v.z, v.w)}; }
#if DBG_ZERO_OUT
    for (size_t i = (size_t)gw * 64 + lane; i < O_END / 4; i += (size_t)NGW * 64) ((f32x4*)F.out)[i] = (f32x4){0.f, 0.f, 0.f, 0.f};
#endif
    {
        LAS float* red = (LAS float*)(F.lds + RING_OFF); LAS float* rs = (LAS float*)(F.lds + RING_OFF + 16384);
        __syncthreads();
        sample_rstd(F, A.in[I_XS], rs);
        for (int ct = F.vcu; ct < (EIN + 15) / 16; ct += F.G) {
            const float s = sgemm16_f32w(F, A.in[I_XS], A.in[I_GMIX], A.in[I_WINE], EIN, ct, red);
            const int tid = TID(), r = SG_ROW(tid), n = 16 * ct + SG_COL(tid); if (n < EIN) SMP(SM_ZS)[(size_t)r * EIN + n] = s * rs[r];
        }
    }
}


__device__ __forceinline__ void sgu_item(Frame& F, const Args& A, int c, int g) {
    LAS bf16* vt = (LAS bf16*)(F.lds + RING_OFF);
    const int lane = LANE(), tid = TID();
    for (int idx = tid; idx < 128 * 32; idx += NWAVES * 64) { const int r = idx >> 5, q4 = (idx & 31) * 4; const size_t row = (size_t)c * 128 + r;
        const f32x4* lp = (const f32x4*)(WSF(WS_LNS) + row * 32); float s1 = 0.f, s2 = 0.f;
#pragma unroll
        for (int j = 0; j < 8; ++j) { const f32x4 x = lp[j]; s1 += x.x + x.z; s2 += x.y + x.w; }
        const float mu = s1 * (1.0f / 1024.0f), var = s2 * (1.0f / 1024.0f) - mu * mu, rstd = 1.0f / sqrtf(var + EPS);
        const int col = g * 128 + q4; const pg8::u32x2 vw = *(const pg8::u32x2*)(WSB(WS_V1) + row * D + col); const f32x4 v = {__uint_as_float(vw.x << 16), __uint_as_float(vw.x & 0xffff0000u), __uint_as_float(vw.y << 16), __uint_as_float(vw.y & 0xffff0000u)}, lg = *(const f32x4*)(A.in[I_LNG] + col), lb = *(const f32x4*)(A.in[I_LNB] + col);
        const f32x4 y = (v - mu) * rstd * lg + lb;
        vt[(q4 + 0) * 136 + r] = (bf16)f2bf(y.x); vt[(q4 + 1) * 136 + r] = (bf16)f2bf(y.y); vt[(q4 + 2) * 136 + r] = (bf16)f2bf(y.z); vt[(q4 + 3) * 136 + r] = (bf16)f2bf(y.w); }
    LDS_WAIT(); __syncthreads();
    const int r16 = lane & 15, q = lane >> 4, w = F.wave, nks = ((16 * w + 15) >> 5) + 1;
    const bf16* wp = WSB(WS_SGWB) + ((size_t)g * 128 + 16 * w + r16) * 128 + 8 * q;
    f32x4 acc[8];
#pragma unroll
    for (int nt = 0; nt < 8; ++nt) acc[nt] = (f32x4){0.f, 0.f, 0.f, 0.f};
    for (int ks = 0; ks < nks; ++ks) { const bf16x8s af = *(const bf16x8s*)(wp + 32 * ks);
#pragma unroll
        for (int nt = 0; nt < 8; ++nt) { const bf16x8s bfr = *(const LAS bf16x8s*)(vt + (16 * nt + r16) * 136 + 32 * ks + 8 * q); acc[nt] = __builtin_amdgcn_mfma_f32_16x16x32_bf16(bfr, af, acc[nt], 0, 0, 0); } }
    {   const int t = 16 * w + r16; const float bb = A.in[I_SGB][g * 128 + t]; const size_t off = ((size_t)c * 128 + t) * D + g * 128 + 4 * q;
        pg8::u32x2 uw[8];
#pragma unroll
        for (int nt = 0; nt < 8; ++nt) uw[nt] = *(const pg8::u32x2*)(WSB(WS_U1) + off + 16 * nt);
#pragma unroll
        for (int nt = 0; nt < 8; ++nt) { const float u0 = __uint_as_float(uw[nt].x << 16), u1 = __uint_as_float(uw[nt].x & 0xffff0000u), u2 = __uint_as_float(uw[nt].y << 16), u3 = __uint_as_float(uw[nt].y & 0xffff0000u);
            pg8::u32x2 o; o.x = pk2(u0 * (acc[nt][0] + bb), u1 * (acc[nt][1] + bb)); o.y = pk2(u2 * (acc[nt][2] + bb), u3 * (acc[nt][3] + bb));
            *(pg8::u32x2*)(WSB(WS_YAB) + off + 16 * nt) = o; } }
    __syncthreads();
}
__device__ __forceinline__ void sgu_sample(Frame& F, const Args& A, int b) {
    const int lane = LANE(); const float* v = SMP(SM_V1S) + (size_t)b * D; const float* u = SMP(SM_U1S) + (size_t)b * D;
    f32x4 x[4]; float s = 0.f;
#pragma unroll
    for (int j = 0; j < 4; ++j) { x[j] = *((const f32x4*)v + lane + 64 * j); s += pg8::sum4(x[j]); }
    const float mu = wave_sum(s) * (1.0f / D); float s2 = 0.f;
#pragma unroll
    for (int j = 0; j < 4; ++j) { x[j] = x[j] - mu; s2 += pg8::dot4(x[j]); }
    const float rstd = 1.0f / sqrtf(wave_sum(s2) * (1.0f / D) + EPS);
#pragma unroll
    for (int j = 0; j < 4; ++j) { const int col = (lane + 64 * j) * 4, g = col >> 7;
        const f32x4 vn = x[j] * rstd * *(const f32x4*)(A.in[I_LNG] + col) + *(const f32x4*)(A.in[I_LNB] + col);
        *(f32x4*)(F.out + O_VS + (size_t)b * D + col) = vn;
        const float w00 = A.in[I_SGW][(size_t)g * 128 * 128], b0 = A.in[I_SGB][g * 128];
        const f32x4 us = *(const f32x4*)(u + col) * (vn * w00 + b0);
        *(f32x4*)(SMP(SM_USS) + (size_t)b * D + col) = us; *(v2u*)(SMB(SB_USS) + (size_t)b * D + col) = (v2u){pk2(us.x, us.y), pk2(us.z, us.w)}; }
}

__global__ void __launch_bounds__(NWAVES * 64, 2) mega_fwd(Args args) {
    extern __shared__ __attribute__((aligned(16))) unsigned char lds[];
    Frame F;
    F.lds = (LAS unsigned char*)lds;
    F.MISC = (volatile LAS unsigned*)(F.lds + MISC_OFF);
    F.wave = __builtin_amdgcn_readfirstlane((int)threadIdx.x >> 6);
    F.G = gridDim.x; { const int bx = blockIdx.x; F.vcu = (F.G % 8 == 0) ? (bx % 8) * (F.G / 8) + bx / 8 : bx; }
    F.out = args.out; F.ws = args.ws;
    F.ctl = (gu32*)(args.ws + WS_CTL);
    for (int u = TID(); u < (LDS_BYTES - LDSCTL_OFF) / 4; u += NWAVES * 64) ((LAS unsigned*)(F.lds + LDSCTL_OFF))[u] = 0u;
    __syncthreads();
    XcdBarrier bar = xcd_barrier_post((unsigned*)(F.ctl + CW_BAR), F.MISC + 8);
    const int lo = args.ph_lo, hi = args.ph_hi;
#ifndef PHASE_MASK
#define PHASE_MASK 0xffffffffu
#endif
#define IN(k) (((PHASE_MASK >> (k)) & 1u) && lo <= (k) && (k) < hi)
#define BOTH(k) (IN(k) && IN((k) + 1))
#define GRID_BAR() xcd_barrier(bar)
    const int gw = F.vcu * NWAVES + F.wave, NGW = F.G * NWAVES;
#if DBG_TIME_PHASE >= 0
    unsigned long long ts_a = 0, ts_b = 0;
#define STAMP(k) do { if ((k) == DBG_TIME_PHASE) ts_a = __builtin_amdgcn_s_memrealtime(); if ((k) == DBG_TIME_PHASE + 1) ts_b = __builtin_amdgcn_s_memrealtime(); } while (0)
#else
#define STAMP(k) do {} while (0)
#endif
    STAMP(0);

    if (IN(0)) { p0_prologue(F, args); if (BOTH(0)) GRID_BAR(); }
    STAMP(1);

    if (IN(1)) {
        {
        const bool light = (F.G == 256) ? ((int)blockIdx.x >= 128) : true; const int lw = (F.G == 256) ? ((int)blockIdx.x - 128) * NWAVES + F.wave : gw, NLW = (F.G == 256) ? 128 * NWAVES : NGW;
        if (light && lw < NS) sample_post(F, args, lw);
        if (light)
        for (int it = lw * 4; it < NS * 511; it += NLW * 4) { f32x4 v[4];
#pragma unroll
            for (int i = 0; i < 4; ++i) { const int q = it + i < NS * 511 ? it + i : NS * 511 - 1, b = q / 511, r = q % 511; v[i] = *((const f32x4*)(args.in[I_CWIN] + ((size_t)b * 512 + r + 1) * 256) + LANE()); }
#pragma unroll
            for (int i = 0; i < 4; ++i) { const int q = it + i < NS * 511 ? it + i : NS * 511 - 1, b = q / 511, r = q % 511; *((f32x4*)(F.out + O_WINS + ((size_t)b * 512 + r) * 256) + LANE()) = v[i]; } }
        }
        if (F.G == 256 ? (int)blockIdx.x >= 128 : true) {
            LAS float* red1 = (LAS float*)(F.lds + RING_OFF); const int j0 = (F.G == 256) ? (int)blockIdx.x - 128 : (int)blockIdx.x, jn = (F.G == 256) ? 128 : F.G;
            for (int j = j0; j < 2 * (D / 16); j += jn) { const int l = j >> 6, ct = j & 63;
                const float s = sgemm16(F, SMB(SB_PS) + (size_t)l * NS * PLE, PLE, WSB(WS_WPROJ) + (size_t)l * PLE * D, ct, red1);
                const int tid = TID(), r = SG_ROW(tid), n = 16 * ct + SG_COL(tid); SMP(SM_PPS)[(l * NS + r) * D + n] = s; }
        }
        pg8::Gemm g{WSB(WS_HBA), WSB(WS_WIN0), T, EINP, D}; pg8::StaticOrder S; S.init(T, EINP, F.G, (int)blockIdx.x);
        pg8::EpiIn0 E{WSF(WS_RSA), WSF(WS_XA), WSB(WS_GG), WSF(WS_QR), F.out + O_KVP, WSF(WS_WINB), WSF(WS_GATE), args.in[I_QG], args.in[I_KG], WSB(WS_KVS), WSB(WS_KVW), F.out + O_WINP, F.out + O_CONVP, T};
        pg8::gemm_phase<pg8::EpiIn0, pg8::StaticOrder, PG8_ALIGN, PG8_SP2>(F.lds + RING_OFF, g, S, E, F.wave);
        if (F.G == 256 ? (int)blockIdx.x >= 128 : true) {
            __syncthreads();
            pg8::Gemm g2{WSB(WS_PB), WSB(WS_WPROJ), T, D, PLE}; pg8::StaticOrder S2;
            if (F.G == 256) S2.init(T, D, 128, (int)blockIdx.x - 128); else S2.init(T, D, F.G, (int)blockIdx.x);
            pg8::EpiProj E2{WSB(WS_PP)};
            pg8::gemm_phase<pg8::EpiProj, pg8::StaticOrder, PG8_ALIGN, PG8_SP2>(F.lds + RING_OFF, g2, S2, E2, F.wave);
        }
        if (BOTH(1)) GRID_BAR();
    }
    STAMP(2);

    const LAS float* btab = (const LAS float*)(F.lds + BTAB_OFF);
    {   for (int i = TID(); i < 114 * 8; i += NWAVES * 64) { const int n = i >> 3;
            int bk = n; if (n >= 16) { bk = 16 + (n >= 19) + (n >= 21) + (n >= 24) + (n >= 27) + (n >= 31) + (n >= 35) + (n >= 40) + (n >= 46) + (n >= 52) + (n >= 59) + (n >= 67) + (n >= 77) + (n >= 87) + (n >= 99) + (n >= 113); }
            const float bv = args.in[I_RELB][bk * 8 + (i & 7)]; ((LAS float*)(F.lds + BTAB_OFF))[i] = bv; ((LAS float*)(F.lds + BTAB_OFF))[114 * 8 + i] = bv * 1.4426950408889634f; }
        LDS_WAIT(); __syncthreads(); }
    LAS float* red = (LAS float*)(F.lds + RING_OFF); LAS float* rsl = (LAS float*)(F.lds + RING_OFF + 16384);

    if (IN(2)) {
        LAS float* wscr = (LAS float*)(F.lds + RING_OFF + F.wave * 16384);
#if DBG_SECT2 >= 0
        unsigned long long t2a = __builtin_amdgcn_s_memrealtime(), t2b; float t2v = 0.f;
#define SECT2(k) do { asm volatile("s_waitcnt vmcnt(0) lgkmcnt(0)" ::: "memory"); t2b = __builtin_amdgcn_s_memrealtime(); if ((k) == DBG_SECT2) t2v = (float)(t2b - t2a); t2a = t2b; } while (0)
#else
#define SECT2(k) do {} while (0)
#endif
#if CMPP_IMPL == 0
        for (int it = gw; it < 256; it += NGW) cmp_prompt_item(F, args, it >> 1, it & 1, wscr);
#elif CMPP_IMPL == 1
#if CMPP_SPLIT
        for (int it = F.vcu; it < 32; it += F.G) { cmp_mfma<false>(F, args, 0, 2 * it + (F.wave >> 2), WSF(WS_KC), WSF(WS_VC), (F.wave & 3) * 16, (F.wave & 3) * 16 + 16, (LAS float*)(F.lds + RING_OFF) + (F.wave >> 2) * 3 * 8 * 256, 4); __syncthreads(); }
#else
        for (int it = gw; it < 64; it += NGW) cmp_mfma<false>(F, args, 0, it, WSF(WS_KC), WSF(WS_VC));
#endif
#else
        for (int it = gw; it < 256; it += NGW) cmp_prompt_item(F, args, it >> 1, it & 1, wscr);
        for (int it = gw; it < 64; it += NGW) cmp_mfma<false>(F, args, 0, it, WSF(WS_U), WSF(WS_U) + 65536);
        GRID_BAR();
        {   float sd = 0.f, sr = 0.f;
            for (int i = gw * 64 + LANE(); i < 65536; i += NGW * 64) { const float a = WSF(WS_KC)[i], b = WSF(WS_U)[i], c = WSF(WS_VC)[i], d = WSF(WS_U)[65536 + i];
                sd += (a - b) * (a - b) + (c - d) * (c - d); sr += a * a + c * c; }
            sd = wave_sum(sd); sr = wave_sum(sr);
            if (LANE() == 0) { atomicAdd((float*)(F.ctl + 200), sd); atomicAdd((float*)(F.ctl + 264), sr); }
        }
#endif
        SECT2(0);
#if CMPS_IMPL == 1
        if (F.wave & 1) for (int it = gw >> 1; it < NS * NPG / 4; it += NGW / 2) cmp_sample2(F, args, it >> 5, it & 31, WSF(WS_KCS), WSF(WS_VCS), wscr);
#endif
        if (!(F.wave & 1)) for (int it = gw >> 1; it < 2048; it += NGW / 2) rg1_item(F, args, it >> 3, it & 7, wscr);
        SECT2(1);
#if !FUSE_HEADNORM
        for (int t = gw; t < T; t += NGW) head_norm_token(F, args, t);
#else
        if (!(F.wave & 1)) for (int t = 4 * (gw >> 1); t < T; t += 4 * (NGW / 2)) ktile_token4(F, args, t);
#endif
        SECT2(2);
        if (!(F.wave & 1)) for (int it = gw >> 1; it < 1024; it += NGW / 2) { const int w = it >> 9, b = (it >> 1) & 255, g = it & 1;
            if (w == 0) build_vt_block(F.out + O_KVP + (size_t)b * 64 * 512 + 384 + g * 64, 512, WSB(WS_KVS) + (size_t)(b * 2 + g) * 8192, LANE());
            else build_vt_block(WSF(WS_WINB) + (size_t)b * 64 * 256 + 128 + g * 64, 256, WSB(WS_KVW) + (size_t)(b * 2 + g) * 8192, LANE()); }
        SECT2(3);
        if (!(F.wave & 1)) for (int it = NGW / 2 - 1 - (gw >> 1); it < NS * 8; it += NGW / 2) build_win_sample(F, args, it >> 3, it & 7);
        SECT2(4);
#if CMPS_IMPL == 0
        __syncthreads();
        for (int it = F.vcu; it < NS * NPG; it += F.G) cmp_sample_item(F, args, it / NPG, it % NPG);
#elif CMPS_IMPL == 1
        (void)0;
#else
        __syncthreads();
        for (int it = F.vcu; it < NS * NPG; it += F.G) cmp_sample_item(F, args, it / NPG, it % NPG);
        for (int it = gw; it < NS * NPG / 2; it += NGW) cmp_mfma<true>(F, args, it >> 6, it & 63, WSF(WS_U), WSF(WS_U) + 4 * 1024 * 1024);
        GRID_BAR();
        {   float sd = 0.f, sr = 0.f;
            for (int i = gw * 64 + LANE(); i < 2 * 1024 * 1024; i += NGW * 64) { const float a = WSF(WS_KCS)[i], b = WSF(WS_U)[i], c = WSF(WS_VCS)[i], d = WSF(WS_U)[4 * 1024 * 1024 + i];
                sd += (a - b) * (a - b) + (c - d) * (c - d); sr += a * a + c * c; }
            sd = wave_sum(sd); sr = wave_sum(sr);
            if (LANE() == 0) { atomicAdd((float*)(F.ctl + 200), sd); atomicAdd((float*)(F.ctl + 264), sr); }
        }
#endif
        SECT2(5);
#if DBG_SECT2 >= 0
        if (gw == 0 && LANE() == 0) __hip_atomic_store((float*)(F.ctl + 328), exp2f(0.5f * rintf(2.0f * log2f(t2v + 1.0f))) * 1000.0f, RLX_AGENT);
#endif
        if (BOTH(2)) GRID_BAR();
    }
    STAMP(3);
    if (IN(3)) {
        LAS float* wscr = (LAS float*)(F.lds + RING_OFF + F.wave * 16384);
#if SATTN_IMPL == 0
        for (int it = gw; it < NS * 2; it += NGW) attn_sample_item(F, args, it >> 1, it & 1, wscr, btab);
#elif SATTN_IMPL == 1
        for (int it = gw; it < NS * 2; it += NGW) attn_sample_mfma(F, args, it >> 1, it & 1, wscr, btab, SMP(SM_YABS));
#else
        for (int it = gw; it < NS * 2; it += NGW) { attn_sample_item(F, args, it >> 1, it & 1, wscr, btab); attn_sample_mfma(F, args, it >> 1, it & 1, wscr, btab, WSF(WS_U));
            const int b = it >> 1, g = it & 1; float sd = 0.f, sr = 0.f;
            asm volatile("s_waitcnt vmcnt(0)" ::: "memory");
            for (int j = 0; j < 4; ++j) { const float a = __hip_atomic_load(SMP(SM_YABS) + (size_t)b * D + 512 + g * 256 + j * 64 + LANE(), RLX_AGENT), bb = __hip_atomic_load(WSF(WS_U) + (size_t)b * D + 512 + g * 256 + j * 64 + LANE(), RLX_AGENT); sd += (a - bb) * (a - bb); sr += a * a; }
            sd = wave_sum(sd); sr = wave_sum(sr);
            if (LANE() == 0) { atomicAdd((float*)(F.ctl + 200), sd); atomicAdd((float*)(F.ctl + 264), sr); } }
#endif
        for (int it = gw; it < 2048; it += NGW) rg3_item(F, args, it >> 3, it & 7);
#if ATTN_IMPL == 0
        for (int it = gw; it < 2 * T; it += NGW) attn_prompt_item(F, args, it >> 1, it & 1, wscr, btab);
#elif ATTN_IMPL == 1
#if DBG_SECT >= 0
        if (LANE() < 6) ((LAS unsigned long long*)((LAS unsigned char*)wscr + 16000))[LANE()] = 0ull;
        LDS_WAIT();
#endif
        {
            const int gq = (2 * gw) / NGW, wq = gw - gq * (NGW / 2);
#if ATTN_PACK == 2
            {   gu32* ctr = F.ctl + 384 + 64 * gq; (void)wq;
                int nxt = 0; if (LANE() == 0) nxt = (int)__hip_atomic_fetch_add(ctr, 1u, RLX_AGENT); nxt = __builtin_amdgcn_readfirstlane(nxt);
                while (nxt < T / 4) { const int i = nxt;
                    int nn = 0; if (LANE() == 0) nn = (int)__hip_atomic_fetch_add(ctr, 1u, RLX_AGENT);
                    const int j = i >> 1, t0 = (i & 1) ? 4 * j : T - 4 - 4 * j;
                    attn_prompt_pack(F, args, t0, gq, wscr, btab, WSB(WS_YAB));
                    nxt = __builtin_amdgcn_readfirstlane(nn); } }
#elif ATTN_PACK == 1
            for (int i = 0; i < 4; ++i) { const int t0 = (i & 2) ? T - 8 - wq * 8 + 4 * (i & 1) : wq * 8 + 4 * (i & 1); attn_prompt_pack(F, args, t0, gq, wscr, btab, WSB(WS_YAB)); }
#else
            for (int i = 0; i < 16; ++i) { const int ta = wq * 8 + (i >> 1), tq = (i & 1) ? T - 1 - ta : ta; attn_prompt_mfma(F, args, tq, gq, wscr, btab, WSB(WS_YAB)); }
#endif
        }
#else
        for (int it = gw; it < 2 * T; it += NGW) attn_prompt_item(F, args, it >> 1, it & 1, wscr, btab);
        for (int it = gw; it < 2 * (T / 4); it += NGW) attn_prompt_pack(F, args, (it >> 1) * 4, it & 1, wscr, btab, WSB(WS_U));
        GRID_BAR();
        {   float sd = 0.f, sr = 0.f;
            for (int t = gw; t < T; t += NGW) { const v4u a = *((const v4u*)(WSB(WS_YAB) + (size_t)t * D + 512) + LANE()), b = *((const v4u*)(WSB(WS_U) + (size_t)t * D + 512) + LANE());
#pragma unroll
                for (int j = 0; j < 4; ++j) { const float a0 = __builtin_bit_cast(float, a[j] << 16), a1 = __builtin_bit_cast(float, a[j] & 0xffff0000u), b0 = __builtin_bit_cast(float, b[j] << 16), b1 = __builtin_bit_cast(float, b[j] & 0xffff0000u);
                    sd += (a0 - b0) * (a0 - b0) + (a1 - b1) * (a1 - b1); sr += a0 * a0 + a1 * a1; } }
            sd = wave_sum(sd); sr = wave_sum(sr);
            if (LANE() == 0) { atomicAdd((float*)(F.ctl + 200), sd); atomicAdd((float*)(F.ctl + 264), sr); }
        }
#endif
#if DBG_SECT >= 0
        if (gw == 1000 && LANE() == 0) { const float tk = (float)((LAS unsigned long long*)((LAS unsigned char*)wscr + 16000))[DBG_SECT]; F.out[O_HP] = exp2f(0.25f * rintf(4.0f * log2f(tk + 1.0f))) * 1000.0f; }
#endif
        __syncthreads();
        if (BOTH(3)) GRID_BAR();
    }
    STAMP(4);
    if (IN(4)) {
        for (int ct = F.vcu; ct < D / 16; ct += F.G) { const float s = sgemm16(F, SMB(SB_YABS), D, WSB(WS_WOUT0), ct, red);
            const int tid = TID(), r = SG_ROW(tid), n = 16 * ct + SG_COL(tid); const float y = args.in[I_XS][r * D + n] + s; SMP(SM_YS0)[r * D + n] = y; SMB(SB_YS0)[r * D + n] = (bf16)f2bf(y); }
        pg8::Gemm g{WSB(WS_YAB), WSB(WS_WOUT0), T, D, D}; pg8::StaticOrder S; S.init(T, D, F.G, (int)blockIdx.x);
        pg8::EpiRes<true, false> E{nullptr, WSB(WS_HBA), F.out + O_YP, WSB(WS_HBB), WSF(WS_RSB)};
        pg8::gemm_phase<pg8::EpiRes<true, false>, pg8::StaticOrder, PG8_ALIGN, PG8_SP2>(F.lds + RING_OFF, g, S, E, F.wave);
        if (BOTH(4)) GRID_BAR();
    }
    STAMP(5);
#define MLP_PLE_PHASES(P, L, HB_IN, RS_IN, HB_MID, RS_MID, YS_IN, YSB_IN, YS_OUT, YSB_OUT, YS_OUT_LD)                                                                                   \
                                                                                                                                   \
    if (IN(P)) {                                                                                                                                                    \
        for (int ct = F.vcu; ct < FF / 16; ct += F.G) { const float s = sgemm16(F, YSB_IN, D, WSB(WS_WUP) + (size_t)(L) * D * FF, ct, red, YS_IN, rsl);                          \
            const int tid = TID(), r = SG_ROW(tid), n = 16 * ct + SG_COL(tid); const float z = s * rsl[r], zr = z > 0.f ? z : 0.f; SMB(SB_US)[r * FF + n] = (bf16)f2bf(zr * zr); } \
        __syncthreads();                                                                                                                                            \
        pg8::Gemm g{HB_IN, WSB(WS_WUP) + (size_t)(L) * D * FF, T, FF, D}; pg8::StaticOrder S; S.init(T, FF, F.G, (int)blockIdx.x);                                  \
        pg8::EpiUp E{RS_IN, WSB(WS_U)};                                                                                                                             \
        pg8::gemm_phase<pg8::EpiUp, pg8::StaticOrder, PG8_ALIGN, PG8_SP2>(F.lds + RING_OFF, g, S, E, F.wave);                                                               \
        if (BOTH(P)) GRID_BAR();                                                                                                                                    \
    } STAMP((P) + 1);                                                                                                                                                               \
                                                                                                                                     \
    if (IN((P) + 1)) {                                                                                                                                              \
        for (int ct = F.vcu; ct < D / 16; ct += F.G) { const float s = sgemm16(F, SMB(SB_US), FF, WSB(WS_WDOWN) + (size_t)(L) * D * FF, ct, red);                       \
            const int tid = TID(), r = SG_ROW(tid), n = 16 * ct + SG_COL(tid); const float y = YS_IN[r * D + n] + s; YS_IN[r * D + n] = y; YSB_IN[r * D + n] = (bf16)f2bf(y); } \
        pg8::Gemm g{WSB(WS_U), WSB(WS_WDOWN) + (size_t)(L) * D * FF, T, D, FF}; pg8::StaticOrder S; S.init(T, D, F.G, (int)blockIdx.x);                             \
        pg8::EpiRes<true, false> E{nullptr, HB_IN, F.out + O_YP, HB_MID, RS_MID};                                                                                                  \
        pg8::gemm_phase<pg8::EpiRes<true, false>, pg8::StaticOrder, PG8_ALIGN, PG8_SP2>(F.lds + RING_OFF, g, S, E, F.wave);                                                              \
        if (BOTH((P) + 1)) GRID_BAR();                                                                                                                              \
    } STAMP((P) + 2);                                                                                                                                                               \
                                                                                                      \
    if (IN((P) + 2)) {                                                                                                                                              \
        for (int ct = F.vcu; ct < D / 16; ct += F.G) {                                                                                                              \
            const float sg = sgemm16(F, YSB_IN, D, WSB(WS_WGATE) + (size_t)(L) * D * D, ct, red, YS_IN, rsl);                                                        \
            const int tid = TID(), r = SG_ROW(tid), n = 16 * ct + SG_COL(tid); const float sp = SMP(SM_PPS)[((L) * NS + r) * D + n];        \
            const float y = YS_IN[r * D + n] + sigmoidf_(sg * rsl[r]) * sp;                       \
            YS_OUT[(size_t)r * YS_OUT_LD + n] = y; YSB_OUT[r * D + n] = (bf16)f2bf(y); }                                                                             \
        __syncthreads();                                                                                                                                            \
        { pg8::Gemm g{HB_MID, WSB(WS_WGATE) + (size_t)(L) * D * D, T, D, D}; pg8::StaticOrder S; S.init(T, D, F.G, (int)blockIdx.x);                                \
          pg8::EpiGate<(L) == 1> E{RS_MID, WSB((L) == 0 ? WS_PP : WS_PP1), HB_MID, F.out + O_YP, HB_IN, RS_IN};                                                                                                  \
          pg8::gemm_phase<pg8::EpiGate<(L) == 1>, pg8::StaticOrder, PG8_ALIGN, PG8_SP2>(F.lds + RING_OFF, g, S, E, F.wave); }                                                         \
        if (BOTH((P) + 2)) GRID_BAR();                                                                                                                              \
    } STAMP((P) + 3);
    MLP_PLE_PHASES(5, 0, WSB(WS_HBB), WSF(WS_RSB), WSB(WS_HBA), WSF(WS_RSA), SMP(SM_YS0), SMB(SB_YS0), SMP(SM_YS1), SMB(SB_YS1), D)
    if (IN(8)) {
        for (int ct = F.vcu; ct < 2 * D / 16; ct += F.G) { const float s = sgemm16(F, SMB(SB_YS1), D, WSB(WS_WIN1), ct, red, SMP(SM_YS1), rsl);
            const int tid = TID(), r = SG_ROW(tid), n = 16 * ct + SG_COL(tid); const float z = gelu_tanh(s * rsl[r]); if (n < D) SMP(SM_U1S)[r * D + n] = z; else SMP(SM_V1S)[r * D + n - D] = z; }
        __syncthreads();
        pg8::Gemm g{WSB(WS_HBB), WSB(WS_WIN1), T, 2 * D, D}; pg8::StaticOrder S; S.init(T, 2 * D, F.G, (int)blockIdx.x);
        pg8::EpiIn1 E{WSF(WS_RSB), WSB(WS_U1), WSB(WS_V1), WSF(WS_LNS)};
        pg8::gemm_phase<pg8::EpiIn1, pg8::StaticOrder, PG8_ALIGN, PG8_SP2>(F.lds + RING_OFF, g, S, E, F.wave);
        if (BOTH(8)) GRID_BAR();
    }
    STAMP(9);
    if (IN(9)) {
        if (gw < NS) sgu_sample(F, args, gw);
        __syncthreads();
        for (int it = F.vcu; it < 128 * 8; it += F.G) sgu_item(F, args, it >> 3, it & 7);
        {
            pg8::Gemm g2{WSB(WS_PB) + (size_t)T * PLE, WSB(WS_WPROJ) + (size_t)PLE * D, T, D, PLE}; pg8::StaticOrder S2; S2.init(T, D, F.G, (int)blockIdx.x);
            pg8::EpiProj E2{WSB(WS_PP1)};
            pg8::gemm_phase<pg8::EpiProj, pg8::StaticOrder, PG8_ALIGN, PG8_SP2>(F.lds + RING_OFF, g2, S2, E2, F.wave);
        }
        if (BOTH(9)) GRID_BAR();
    }
    STAMP(10);
    if (IN(10)) {
        for (int ct = F.vcu; ct < D / 16; ct += F.G) { const float s = sgemm16(F, SMB(SB_USS), D, WSB(WS_WOUT1), ct, red);
            const int tid = TID(), r = SG_ROW(tid), n = 16 * ct + SG_COL(tid); const float y = SMP(SM_YS1)[r * D + n] + s; SMP(SM_YS1)[r * D + n] = y; SMB(SB_YS1)[r * D + n] = (bf16)f2bf(y); }
        pg8::Gemm g{WSB(WS_YAB), WSB(WS_WOUT1), T, D, D}; pg8::StaticOrder S; S.init(T, D, F.G, (int)blockIdx.x);
        pg8::EpiRes<true, false> E{nullptr, WSB(WS_HBB), F.out + O_YP, WSB(WS_HBA), WSF(WS_RSA)};
        pg8::gemm_phase<pg8::EpiRes<true, false>, pg8::StaticOrder, PG8_ALIGN, PG8_SP2>(F.lds + RING_OFF, g, S, E, F.wave);
        if (BOTH(10)) GRID_BAR();
    }
    STAMP(11);
    MLP_PLE_PHASES(11, 1, WSB(WS_HBA), WSF(WS_RSA), WSB(WS_HBB), WSF(WS_RSB), SMP(SM_YS1), SMB(SB_YS1), (F.out + O_YS), SMB(SB_YS0), D)
#if ATTN_IMPL == 2 || CMPS_IMPL == 2 || SATTN_IMPL == 2 || CMPP_IMPL == 2
    GRID_BAR();
    if (blockIdx.x == 0 && TID() == 0) { const float sd = __hip_atomic_load((float*)(F.ctl + 200), RLX_AGENT), sr = __hip_atomic_load((float*)(F.ctl + 264), RLX_AGENT); F.out[O_HP] = sqrtf(sd / sr) * 1.0e9f; }
#endif
#if DBG_SECT2 >= 0
    GRID_BAR();
    if (blockIdx.x == 0 && TID() == 0) F.out[O_HP] = __hip_atomic_load((float*)(F.ctl + 328), RLX_AGENT);
#endif
#if DBG_TIME_PHASE >= 0
    if (blockIdx.x == 0 && TID() == 0) { const float tk = (float)(ts_b - ts_a); const float q = exp2f(0.25f * (rintf(4.0f * log2f(tk) - 0.5f) + 0.5f)); F.out[O_HP] = q * 1000.0f; }
#endif
#if DBG_SCALE_MASK
    {
        GRID_BAR();
#define SCALE_REGION(o, lo_, hi_) if ((DBG_SCALE_MASK >> (o)) & 1) { for (size_t i = (lo_) + (size_t)gw * 64 + LANE(); i < (hi_); i += (size_t)NGW * 64) F.out[i] *= 4.0f; }
        SCALE_REGION(0, O_YP, O_YS) SCALE_REGION(1, O_YS, O_KVP) SCALE_REGION(2, O_KVP, O_KVS) SCALE_REGION(3, O_KVS, O_WINP) SCALE_REGION(4, O_WINP, O_WINS) SCALE_REGION(5, O_WINS, O_CONVP)
        SCALE_REGION(6, O_CONVP, O_CONVS) SCALE_REGION(7, O_CONVS, O_HP) SCALE_REGION(8, O_HP, O_HS) SCALE_REGION(9, O_HS, O_VS) SCALE_REGION(10, O_VS, O_END)
#undef SCALE_REGION
    }
#endif
#undef IN
#undef BOTH
}

extern "C" void kernel_launch(void* const* d_in, const int* in_sizes, int n_in, void* d_out, int out_size, void* d_ws, size_t ws_size, hipStream_t stream) {
    static int grid = 0;
    if (grid == 0) {
        if (n_in != N_IN || (size_t)out_size != O_END || ws_size < WS_END) { fprintf(stderr, "kernel_launch: unexpected sizes n_in %d out %d ws %zu\n", n_in, out_size, ws_size); grid = -1; return; }
        int dev = 0, cus = 0, per_cu = 0;
        if (hipGetDevice(&dev) != hipSuccess || hipDeviceGetAttribute(&cus, hipDeviceAttributeMultiprocessorCount, dev) != hipSuccess) { grid = -1; return; }
        if (hipFuncSetAttribute((const void*)mega_fwd, hipFuncAttributeMaxDynamicSharedMemorySize, LDS_BYTES) != hipSuccess) { grid = -1; return; }
        if (hipOccupancyMaxActiveBlocksPerMultiprocessor(&per_cu, (const void*)mega_fwd, NWAVES * 64, LDS_BYTES) != hipSuccess || per_cu < 1)
            fprintf(stderr, "kernel_launch: occupancy query reports %d workgroups per CU\n", per_cu);
        (void)hipGetLastError();
        grid = cus;
    }
    if (grid < 0) return;
    if (hipMemsetAsync((char*)d_ws + WS_CTL, 0, CTL_ZERO_BYTES, stream) != hipSuccess) return;
    Args a{};
    for (int i = 0; i < N_IN; ++i) a.in[i] = (const float*)d_in[i];
    a.out = (float*)d_out; a.ws = (unsigned char*)d_ws;
    a.ph_lo = 0; a.ph_hi = 64;
    hipLaunchKernelGGL(mega_fwd, dim3(grid), dim3(NWAVES * 64), LDS_BYTES, stream, a);
}
```

```cpp
#include <hip/hip_runtime.h>
#include <cstdio>
#include <cstdint>
#define DBG_ZERO_OUT 0
#define DBG_SCALE_MASK 0
#define DBG_TIME_PHASE (-1)
#define ATTN_IMPL 1
#define CMPS_IMPL 1
#define SATTN_IMPL 1
#define ATTN_DBUF 0
#define HOTBLK 0
#define DBG_SECT (-1)
#define DBG_SECT2 (-1)
#define CMPP_IMPL 1
#define KV_NT 0
#define CMPP_SPLIT 1
#define ATTN_PACK 2
#define SEL_FP8 1
#define FUSE_HEADNORM 1
namespace pg8 {
#define PG8_LAS __attribute__((address_space(3)))
typedef unsigned short bf16_t;
typedef short bf16x8 __attribute__((ext_vector_type(8)));
typedef float f32x4 __attribute__((ext_vector_type(4)));
typedef unsigned u32x4 __attribute__((ext_vector_type(4)));
constexpr int BM = 256, BK = 64, HALF = 128, HTB = HALF * BK * 2  , STAGE_BYTES = 8 * HTB, NXCD = 8, WGM = 8;

__host__ __device__ __forceinline__ int lds_byte(int r, int c) { const int st = (r >> 4) * 2 + (c >> 5), rr = r & 15, cc = c & 31, ob = rr * 64 + cc * 2; return st * 1024 + (ob ^ (((ob >> 9) & 1) << 5)); }
__host__ __device__ __forceinline__ void stage_rc(int b, int& R, int& C) { const int st = b / 1024, sb = b % 1024, swz = sb ^ (((sb >> 9) & 1) << 5); R = (st >> 1) * 16 + swz / 64; C = (st & 1) * 32 + (swz % 64) / 2; }
__host__ __device__ __forceinline__ int perm32(int rho) { const int n = rho >> 4, i = rho & 15; return 8 * (i >> 2) + 4 * n + (i & 3); }

struct Unit { int pm, pn; };
struct Gemm { const bf16_t* A; const bf16_t* Bt; int M, N, K; };

struct StaticOrder {
    int nM, nN, nwg, G, c;
    __host__ __device__ void init(int M, int N, int G_, int c_) { nM = M / BM; nN = N / BM; nwg = nM * nN; G = G_; c = c_; }
    __host__ __device__ bool next(int i, Unit& u) const {
        const long L = (long)i * G + c; if (L >= nwg) return false;
        int wgid = (int)L; { const int q = nwg / NXCD, r = nwg % NXCD, xcd = wgid % NXCD, off = wgid / NXCD; wgid = (xcd < r ? xcd * (q + 1) : r * (q + 1) + (xcd - r) * q) + off; }
        const int nig = WGM * nN, gid = wgid / nig, fm = gid * WGM, gsz = (nM - fm) < WGM ? (nM - fm) : WGM;
        u.pm = fm + ((wgid % nig) % gsz); u.pn = (wgid % nig) / gsz; return true;
    }
    __device__ __forceinline__ void a_ready(const Unit&) const {}
    __device__ __forceinline__ void done(const Unit&) const {}
};


__device__ __forceinline__ unsigned cvt_pk_bf16(float lo, float hi) { unsigned r; asm volatile("v_cvt_pk_bf16_f32 %0, %1, %2" : "=v"(r) : "v"(lo), "v"(hi)); return r; }
typedef unsigned u32x2 __attribute__((ext_vector_type(2)));
__device__ __forceinline__ float dot4(const f32x4 a) { return (a[0] * a[0] + a[1] * a[1]) + (a[2] * a[2] + a[3] * a[3]); }
__device__ __forceinline__ float sum4(const f32x4 a) { return (a[0] + a[1]) + (a[2] + a[3]); }
__device__ __forceinline__ float row_rstd16(const float* rs, int row) {
    const f32x4* p = (const f32x4*)(rs + (size_t)row * 16);
    const f32x4 a = p[0], b = p[1], c = p[2], d = p[3];
    const float s = (sum4(a) + sum4(b)) + (sum4(c) + sum4(d));
    return 1.0f / sqrtf(s * (1.0f / 1024.0f) + 1e-6f);
}
__device__ __forceinline__ float gelu_tanh(float x) { const float u2 = (-2.0f * 0.7978845608028654f * 1.4426950408889634f) * (x + 0.044715f * x * x * x); return x * __builtin_amdgcn_rcpf(1.0f + __builtin_amdgcn_exp2f(u2)); }
__device__ __forceinline__ float sigmoidf_(float x) { return __builtin_amdgcn_rcpf(1.0f + __builtin_amdgcn_exp2f(-1.4426950408889634f * x)); }
__device__ __forceinline__ void st_bf16x4(bf16_t* p, const f32x4 v) { u32x2 w; w.x = cvt_pk_bf16(v[0], v[1]); w.y = cvt_pk_bf16(v[2], v[3]); *(u32x2*)p = w; }

__device__ __forceinline__ int epi_kv_off_k(int r, int d) { return (((r >> 4) * 2 + (d >> 5)) * 64 + ((d & 31) >> 3) * 16 + (r & 15)) * 8 + (d & 7); }
struct EpiIn0 {
    static constexpr bool PERM = false, AFTER_DRAIN = false;
    const float* rs; float* xa; bf16_t* gg; float* qr; float* kvp; float* win; float* gate;
    const float* qgain; const float* kgain; bf16_t* kvs; bf16_t* kvw; float* winp; float* convp; int nrows;
    template <int TYPE>
    __device__ __forceinline__ void head_tile(const f32x4 (&acc)[2][2][4][2], const Unit& u, int wr, int wc, int fr, int fq) const {
        const bool normed = TYPE == 0 || ((TYPE == 2 || TYPE == 3) && wc < 2);
        const float* gp = TYPE == 0 ? qgain : (TYPE == 2 ? kgain + 64 : kgain + 128);
#pragma unroll
        for (int ai = 0; ai < 2; ++ai)
#pragma unroll
            for (int m = 0; m < 4; ++m) {
                const int row = u.pm * BM + ai * HALF + wr * 64 + m * 16 + fr;
                const float rstd = row_rstd16(rs, row);
                f32x4 z[2][2]; float ss = 0.f;
#pragma unroll
                for (int bj = 0; bj < 2; ++bj)
#pragma unroll
                    for (int n = 0; n < 2; ++n) { z[bj][n] = acc[ai][bj][m][n] * rstd; ss += dot4(z[bj][n]); }
                float hs = 1.0f;
                if (TYPE != 1) { ss += __shfl_xor(ss, 16); ss += __shfl_xor(ss, 32); if (normed) hs = 1.0f / sqrtf(ss * (1.0f / 64.0f) + 1e-6f); }
                float* f32dst = TYPE == 0 ? qr + (size_t)row * 512 + (u.pn - 4) * 256 + 64 * wc + 4 * fq
                              : (TYPE == 3 ? win + (size_t)row * 256 + 64 * wc + 4 * fq : kvp + (size_t)row * 512 + (TYPE - 1) * 256 + 64 * wc + 4 * fq);
#pragma unroll
                for (int bj = 0; bj < 2; ++bj)
#pragma unroll
                    for (int n = 0; n < 2; ++n) {
                        const int d0 = 32 * bj + 16 * n, d = d0 + 4 * fq;
                        f32x4 v = z[bj][n]; if (normed) v = v * hs * *(const f32x4*)(gp + d);
                        *(f32x4*)(f32dst + d0) = v;
                        if (TYPE == 3) { if (row >= nrows - 512) *(f32x4*)(winp + (size_t)(row - (nrows - 512)) * 256 + 64 * wc + d) = v; }
                    }
                asm volatile("" ::: "memory");
            }
    }
    __device__ __forceinline__ void operator()(const f32x4 (&acc)[2][2][4][2], const Unit& u, int wr, int wc, int fr, int fq) const {
        if (u.pn == 4 || u.pn == 5) { head_tile<0>(acc, u, wr, wc, fr, fq); return; }
        if (u.pn == 6) { head_tile<1>(acc, u, wr, wc, fr, fq); return; }
        if (u.pn == 7) { head_tile<2>(acc, u, wr, wc, fr, fq); return; }
        if (u.pn == 8) { head_tile<3>(acc, u, wr, wc, fr, fq); return; }
#pragma unroll
        for (int ai = 0; ai < 2; ++ai)
#pragma unroll
            for (int m = 0; m < 4; ++m) {
                const int row = u.pm * BM + ai * HALF + wr * 64 + m * 16 + fr;
                const float rstd = row_rstd16(rs, row);
#pragma unroll
                for (int bj = 0; bj < 2; ++bj)
#pragma unroll
                    for (int n = 0; n < 2; ++n) {
                        const int cb = u.pn * BM + bj * HALF, col = cb + wc * 32 + n * 16 + fq * 4;
                        f32x4 z = acc[ai][bj][m][n] * rstd;
                        if (cb < 512) { *(f32x4*)(xa + (size_t)row * 512 + col) = z; if (row >= nrows - 3) *(f32x4*)(convp + (size_t)(row - (nrows - 3)) * 512 + col) = z; }
                        else if (cb < 1024) { z[0] = gelu_tanh(z[0]); z[1] = gelu_tanh(z[1]); z[2] = gelu_tanh(z[2]); z[3] = gelu_tanh(z[3]); st_bf16x4(gg + (size_t)row * 512 + (col - 512), z); }
                        else if (col < 2328) { z[0] = sigmoidf_(z[0]); z[1] = sigmoidf_(z[1]); z[2] = sigmoidf_(z[2]); z[3] = sigmoidf_(z[3]); *(f32x4*)(gate + (size_t)row * 24 + (col - 2304)) = z; }
                    }
            }
    }
};
__device__ __forceinline__ void ld_bf16x8(const bf16_t* p, f32x4& a, f32x4& b) { const u32x4 w = *(const u32x4*)p;
    a[0] = __uint_as_float(w.x << 16); a[1] = __uint_as_float(w.x & 0xffff0000u); a[2] = __uint_as_float(w.y << 16); a[3] = __uint_as_float(w.y & 0xffff0000u);
    b[0] = __uint_as_float(w.z << 16); b[1] = __uint_as_float(w.z & 0xffff0000u); b[2] = __uint_as_float(w.w << 16); b[3] = __uint_as_float(w.w & 0xffff0000u); }
template <bool RB, bool WY>
struct EpiRes {
    static constexpr bool PERM = true, AFTER_DRAIN = false;
    const float* resid; const bf16_t* resid_b; float* y; bf16_t* hb; float* rs;
    __device__ __forceinline__ void operator()(const f32x4 (&acc)[2][2][4][2], const Unit& u, int wr, int wc, int fr, int fq) const {
#pragma unroll
        for (int ai = 0; ai < 2; ++ai)
#pragma unroll
            for (int m = 0; m < 4; ++m) {
                const int row = u.pm * BM + ai * HALF + wr * 64 + m * 16 + fr;
                float ss = 0.f;
#pragma unroll
                for (int bj = 0; bj < 2; ++bj) {
                    const size_t off = (size_t)row * 1024 + (u.pn * BM + bj * HALF + wc * 32 + 8 * fq);
                    f32x4 r0, r1; if (RB) ld_bf16x8(resid_b + off, r0, r1); else { r0 = *(const f32x4*)(resid + off); r1 = *(const f32x4*)(resid + off + 4); }
                    const f32x4 v0 = acc[ai][bj][m][0] + r0, v1 = acc[ai][bj][m][1] + r1;
                    if (WY) { *(f32x4*)(y + off) = v0; *(f32x4*)(y + off + 4) = v1; } ss += dot4(v0) + dot4(v1);
                    u32x4 w; w.x = cvt_pk_bf16(v0[0], v0[1]); w.y = cvt_pk_bf16(v0[2], v0[3]); w.z = cvt_pk_bf16(v1[0], v1[1]); w.w = cvt_pk_bf16(v1[2], v1[3]);
                    *(u32x4*)(hb + off) = w;
                }
                ss += __shfl_xor(ss, 16); ss += __shfl_xor(ss, 32);
                if (fq == 0) rs[(size_t)row * 16 + u.pn * 4 + wc] = ss;
                if (m == 3) asm volatile("" ::: "memory");
            }
    }
};
struct EpiUp {
    static constexpr bool PERM = true, AFTER_DRAIN = false;
    const float* rs; bf16_t* o;
    __device__ __forceinline__ void operator()(const f32x4 (&acc)[2][2][4][2], const Unit& u, int wr, int wc, int fr, int fq) const {
#pragma unroll
        for (int ai = 0; ai < 2; ++ai)
#pragma unroll
            for (int m = 0; m < 4; ++m) {
                const int row = u.pm * BM + ai * HALF + wr * 64 + m * 16 + fr;
                const float rstd = row_rstd16(rs, row);
#pragma unroll
                for (int bj = 0; bj < 2; ++bj) {
                    const size_t off = (size_t)row * 4096 + (u.pn * BM + bj * HALF + wc * 32 + 8 * fq);
                    f32x4 z0 = acc[ai][bj][m][0] * rstd, z1 = acc[ai][bj][m][1] * rstd;
#pragma unroll
                    for (int j = 0; j < 4; ++j) { const float t0 = z0[j] > 0.f ? z0[j] : 0.f, t1 = z1[j] > 0.f ? z1[j] : 0.f; z0[j] = t0 * t0; z1[j] = t1 * t1; }
                    u32x4 w; w.x = cvt_pk_bf16(z0[0], z0[1]); w.y = cvt_pk_bf16(z0[2], z0[3]); w.z = cvt_pk_bf16(z1[0], z1[1]); w.w = cvt_pk_bf16(z1[2], z1[3]);
                    *(u32x4*)(o + off) = w;
                }
            }
    }
};
struct EpiProj {
    static constexpr bool PERM = false, AFTER_DRAIN = false;
    bf16_t* pp;
    __device__ __forceinline__ void operator()(const f32x4 (&acc)[2][2][4][2], const Unit& u, int wr, int wc, int fr, int fq) const {
#pragma unroll
        for (int ai = 0; ai < 2; ++ai)
#pragma unroll
            for (int m = 0; m < 4; ++m) {
                const int row = u.pm * BM + ai * HALF + wr * 64 + m * 16 + fr;
#pragma unroll
                for (int bj = 0; bj < 2; ++bj)
#pragma unroll
                    for (int n = 0; n < 2; ++n) st_bf16x4(pp + (size_t)row * 1024 + (u.pn * BM + bj * HALF + wc * 32 + n * 16 + fq * 4), acc[ai][bj][m][n]);
            }
    }
};
template <bool WY>
struct EpiGate {
    static constexpr bool PERM = true, AFTER_DRAIN = false;
    const float* rs_in; const bf16_t* pp; const bf16_t* yb; float* y; bf16_t* hb; float* rs_out;
    __device__ __forceinline__ void operator()(const f32x4 (&acc)[2][2][4][2], const Unit& u, int wr, int wc, int fr, int fq) const {
#pragma unroll
        for (int ai = 0; ai < 2; ++ai)
#pragma unroll
            for (int m = 0; m < 4; ++m) {
                const int row = u.pm * BM + ai * HALF + wr * 64 + m * 16 + fr;
                const float rstd = row_rstd16(rs_in, row);
                float ss = 0.f;
#pragma unroll
                for (int bj = 0; bj < 2; ++bj) {
                    const size_t off = (size_t)row * 1024 + (u.pn * BM + bj * HALF + wc * 32 + 8 * fq);
                    const f32x4 z0 = acc[ai][bj][m][0] * rstd, z1 = acc[ai][bj][m][1] * rstd; f32x4 p0, p1; ld_bf16x8(pp + off, p0, p1);
                    f32x4 v0, v1; ld_bf16x8(yb + off, v0, v1);
#pragma unroll
                    for (int j = 0; j < 4; ++j) { v0[j] += sigmoidf_(z0[j]) * p0[j]; v1[j] += sigmoidf_(z1[j]) * p1[j]; }
                    if (WY) { *(f32x4*)(y + off) = v0; *(f32x4*)(y + off + 4) = v1; } ss += dot4(v0) + dot4(v1);
                    u32x4 w; w.x = cvt_pk_bf16(v0[0], v0[1]); w.y = cvt_pk_bf16(v0[2], v0[3]); w.z = cvt_pk_bf16(v1[0], v1[1]); w.w = cvt_pk_bf16(v1[2], v1[3]);
                    if (!WY) *(u32x4*)(hb + off) = w;
                }
                ss += __shfl_xor(ss, 16); ss += __shfl_xor(ss, 32);
                if (!WY && fq == 0) rs_out[(size_t)row * 16 + u.pn * 4 + wc] = ss;
                if (m == 3) asm volatile("" ::: "memory");
            }
    }
};
struct EpiIn1 {
    static constexpr bool PERM = false, AFTER_DRAIN = false;
    const float* rs; bf16_t* u1; bf16_t* v1; float* lns;
    __device__ __forceinline__ void operator()(const f32x4 (&acc)[2][2][4][2], const Unit& u, int wr, int wc, int fr, int fq) const {
#pragma unroll
        for (int ai = 0; ai < 2; ++ai)
#pragma unroll
            for (int m = 0; m < 4; ++m) {
                const int row = u.pm * BM + ai * HALF + wr * 64 + m * 16 + fr;
                const float rstd = row_rstd16(rs, row);
                float s1 = 0.f, s2 = 0.f;
#pragma unroll
                for (int bj = 0; bj < 2; ++bj)
#pragma unroll
                    for (int n = 0; n < 2; ++n) {
                        const int col = u.pn * BM + bj * HALF + wc * 32 + n * 16 + fq * 4;
                        f32x4 z = acc[ai][bj][m][n] * rstd;
#pragma unroll
                        for (int j = 0; j < 4; ++j) z[j] = gelu_tanh(z[j]);
                        if (col < 1024) st_bf16x4(u1 + (size_t)row * 1024 + col, z);
                        else { st_bf16x4(v1 + (size_t)row * 1024 + (col - 1024), z); s1 += sum4(z); s2 += dot4(z); }
                    }
                if (u.pn >= 4) {
                    s1 += __shfl_xor(s1, 16); s1 += __shfl_xor(s1, 32); s2 += __shfl_xor(s2, 16); s2 += __shfl_xor(s2, 32);
                    if (fq == 0) { float* p = lns + ((size_t)row * 16 + (u.pn - 4) * 4 + wc) * 2; p[0] = s1; p[1] = s2; }
                }
            }
    }
};

template <class Epi, class Sched, bool ALIGN_EPI = false, bool SP2 = false>
__device__ __forceinline__ void gemm_phase(PG8_LAS unsigned char* lds, const Gemm g, const Sched& S, const Epi& E, const int wid_in) {
    int lane_ = (int)__builtin_amdgcn_mbcnt_hi(~0u, __builtin_amdgcn_mbcnt_lo(~0u, 0u)); asm volatile("" : "+v"(lane_));
    const int wid = wid_in, lane = lane_, tid = wid * 64 + lane, wr = wid >> 2, wc = wid & 3, fr = lane & 15, fq = lane >> 4;
    const int K = g.K, nt = K / BK;
    unsigned voffA[2], voffB[2];
#pragma unroll
    for (int i = 0; i < 2; ++i) { int R, C; stage_rc(tid * 16 + i * 8192, R, C); const int Rb = Epi::PERM ? ((R & ~31) + perm32(R & 31)) : R;
        voffA[i] = (unsigned)(R * K + C) * 2u; voffB[i] = (unsigned)(Rb * K + C) * 2u; }
    const size_t kstep = (size_t)(BK * 2);
    const size_t hstep = (size_t)HALF * K * 2;
    const size_t tstep = 2 * hstep;
    const unsigned ldsw = (unsigned)wid * 1024u;
    const int aoff = lds_byte(wr * 64 + fr, fq * 8), boff = lds_byte(wc * 32 + fr, fq * 8);
#define PG8_SA(b, h) (((b) * 2 + (h)) * HTB)
#define PG8_SB(b, h) ((4 + (b) * 2 + (h)) * HTB)
#define PG8_STAGE(bufoff, gbase, voff) do { _Pragma("unroll") for (int _i = 0; _i < 2; ++_i) \
        __builtin_amdgcn_global_load_lds((const unsigned*)((const char*)(gbase) + (voff)[_i]), (PG8_LAS unsigned*)(lds + (bufoff) + ldsw + _i * 8192), 16, 0, 0); } while (0)
#define PG8_LDA(dst, b, h) do { _Pragma("unroll") for (int m = 0; m < 4; ++m) _Pragma("unroll") for (int k = 0; k < 2; ++k) dst[m][k] = *(const PG8_LAS bf16x8*)(lds + PG8_SA(b, h) + aoff + m * 2048 + k * 1024); } while (0)
#define PG8_LDB(dst, b, h) do { _Pragma("unroll") for (int n = 0; n < 2; ++n) _Pragma("unroll") for (int k = 0; k < 2; ++k) dst[n][k] = *(const PG8_LAS bf16x8*)(lds + PG8_SB(b, h) + boff + n * 2048 + k * 1024); } while (0)
#define PG8_MMA(ai, bj, At, Bt) do { __builtin_amdgcn_s_setprio(1); _Pragma("unroll") for (int m = 0; m < 4; ++m) _Pragma("unroll") for (int n = 0; n < 2; ++n) _Pragma("unroll") for (int k = 0; k < 2; ++k) \
        acc[ai][bj][m][n] = __builtin_amdgcn_mfma_f32_16x16x32_bf16(Bt[n][k], At[m][k], acc[ai][bj][m][n], 0, 0, 0); __builtin_amdgcn_s_setprio(0); } while (0)
#define PG8_WAIT_V(n) asm volatile("s_waitcnt vmcnt(" #n ")" ::: "memory")
#define PG8_WAIT_L(n) asm volatile("s_waitcnt lgkmcnt(" #n ")" ::: "memory")
#define PG8_BAR __builtin_amdgcn_s_barrier()
#define PG8_SCHED __builtin_amdgcn_sched_barrier(0)
    Unit cur, nxt; int ui = 0;
    if (!S.next(0, cur)) return;
    f32x4 acc[2][2][4][2];
#pragma unroll
    for (int a = 0; a < 2; ++a)
#pragma unroll
        for (int b = 0; b < 2; ++b)
#pragma unroll
            for (int m = 0; m < 4; ++m)
#pragma unroll
                for (int n = 0; n < 2; ++n) acc[a][b][m][n] = (f32x4){0.f, 0.f, 0.f, 0.f};
    bf16x8 At[4][2], B0[2][2], B1[2][2];
    const char* cA = (const char*)g.A + (size_t)cur.pm * tstep; const char* cB = (const char*)g.Bt + (size_t)cur.pn * tstep;
    S.a_ready(cur);
    if constexpr (SP2) {
        PG8_STAGE(PG8_SB(0, 0), cB, voffB); PG8_STAGE(PG8_SB(0, 1), cB + hstep, voffB); PG8_STAGE(PG8_SA(0, 0), cA, voffA); PG8_STAGE(PG8_SA(0, 1), cA + hstep, voffA);
        if (wr == 1) PG8_BAR;
        PG8_WAIT_V(2); PG8_BAR;
        PG8_STAGE(PG8_SB(1, 0), cB + kstep, voffB); PG8_STAGE(PG8_SA(1, 0), cA + kstep, voffA); PG8_STAGE(PG8_SB(1, 1), cB + hstep + kstep, voffB);
        PG8_WAIT_V(6); PG8_BAR;
    } else {
        PG8_STAGE(PG8_SB(0, 0), cB, voffB); PG8_STAGE(PG8_SA(0, 0), cA, voffA); PG8_STAGE(PG8_SB(0, 1), cB + hstep, voffB); PG8_STAGE(PG8_SA(0, 1), cA + hstep, voffA);
        if (wr == 1) PG8_BAR;
        PG8_WAIT_V(4); PG8_BAR;
        PG8_STAGE(PG8_SB(1, 0), cB + kstep, voffB); PG8_STAGE(PG8_SA(1, 0), cA + kstep, voffA); PG8_STAGE(PG8_SB(1, 1), cB + hstep + kstep, voffB);
        PG8_WAIT_V(6); PG8_BAR;
    }
    for (;;) {
        const bool has_next = S.next(ui + 1, nxt);
        const char* nA = has_next ? (const char*)g.A + (size_t)nxt.pm * tstep : cA; const char* nB = has_next ? (const char*)g.Bt + (size_t)nxt.pn * tstep : cB;
        for (int t = 0; t < nt; t += 2) {
            const bool last = (t == nt - 2);
            const char* a1 = cA + (size_t)(t + 1) * kstep;
            const char* a2 = last ? nA : cA + (size_t)(t + 2) * kstep; const char* b2 = last ? nB : cB + (size_t)(t + 2) * kstep;
            const char* a3 = a2 + kstep; const char* b3 = b2 + kstep;
            if (last && has_next) S.a_ready(nxt);
            if constexpr (SP2) {
            PG8_LDB(B0, 0, 0); PG8_LDB(B1, 0, 1); PG8_SCHED; PG8_LDA(At, 0, 0); PG8_STAGE(PG8_SA(1, 1), a1 + hstep, voffA);
            PG8_WAIT_V(8); PG8_WAIT_L(0); PG8_BAR; PG8_MMA(0, 0, At, B0); PG8_MMA(0, 1, At, B1); PG8_BAR; PG8_SCHED;
            PG8_LDA(At, 0, 1); PG8_STAGE(PG8_SB(0, 0), b2, voffB); PG8_STAGE(PG8_SB(0, 1), b2 + hstep, voffB); PG8_STAGE(PG8_SA(0, 0), a2, voffA);
            PG8_WAIT_V(8); PG8_WAIT_L(0); PG8_BAR; PG8_MMA(1, 0, At, B0); PG8_MMA(1, 1, At, B1); PG8_BAR; PG8_SCHED;
            PG8_LDB(B0, 1, 0); PG8_LDB(B1, 1, 1); PG8_SCHED; PG8_LDA(At, 1, 0); PG8_STAGE(PG8_SA(0, 1), a2 + hstep, voffA);
            PG8_WAIT_V(8); PG8_WAIT_L(0); PG8_BAR; PG8_MMA(0, 0, At, B0); PG8_MMA(0, 1, At, B1); PG8_BAR; PG8_SCHED;
            PG8_LDA(At, 1, 1); PG8_STAGE(PG8_SB(1, 0), b3, voffB); PG8_STAGE(PG8_SB(1, 1), b3 + hstep, voffB); PG8_STAGE(PG8_SA(1, 0), a3, voffA);
            PG8_WAIT_V(8); PG8_WAIT_L(0); PG8_BAR; PG8_MMA(1, 0, At, B0); PG8_MMA(1, 1, At, B1); PG8_BAR; PG8_SCHED;
            } else {
            PG8_LDB(B0, 0, 0); PG8_SCHED; PG8_LDA(At, 0, 0); PG8_STAGE(PG8_SA(1, 1), a1 + hstep, voffA);
            PG8_WAIT_L(8); PG8_BAR; PG8_WAIT_L(0); PG8_MMA(0, 0, At, B0); PG8_BAR; PG8_SCHED;
            PG8_LDB(B1, 0, 1); PG8_STAGE(PG8_SB(0, 0), b2, voffB);
            PG8_BAR; PG8_WAIT_L(0); PG8_MMA(0, 1, At, B1); PG8_BAR;
            PG8_LDA(At, 0, 1); PG8_STAGE(PG8_SA(0, 0), a2, voffA);
            PG8_BAR; PG8_WAIT_L(0); PG8_MMA(1, 0, At, B0); PG8_BAR; PG8_SCHED;
            PG8_STAGE(PG8_SB(0, 1), b2 + hstep, voffB);
            PG8_WAIT_V(6); PG8_BAR; PG8_MMA(1, 1, At, B1); PG8_BAR;
            PG8_LDB(B0, 1, 0); PG8_SCHED; PG8_LDA(At, 1, 0); PG8_STAGE(PG8_SA(0, 1), a2 + hstep, voffA);
            PG8_WAIT_L(8); PG8_BAR; PG8_WAIT_L(0); PG8_MMA(0, 0, At, B0); PG8_BAR; PG8_SCHED;
            PG8_LDB(B1, 1, 1); PG8_STAGE(PG8_SB(1, 0), b3, voffB);
            PG8_BAR; PG8_WAIT_L(0); PG8_MMA(0, 1, At, B1); PG8_BAR;
            PG8_LDA(At, 1, 1); PG8_STAGE(PG8_SA(1, 0), a3, voffA);
            PG8_BAR; PG8_WAIT_L(0); PG8_MMA(1, 0, At, B0); PG8_BAR; PG8_SCHED;
            PG8_STAGE(PG8_SB(1, 1), b3 + hstep, voffB);
            PG8_WAIT_V(6); PG8_BAR; PG8_MMA(1, 1, At, B1); PG8_BAR;
            }
        }
        if constexpr (ALIGN_EPI) { if (wr == 0) PG8_BAR; }
        if constexpr (!Epi::AFTER_DRAIN) { E(acc, cur, wr, wc, fr, fq); S.done(cur); }
        if (!has_next) break;
#pragma unroll
        for (int a = 0; a < 2; ++a)
#pragma unroll
            for (int b = 0; b < 2; ++b)
#pragma unroll
                for (int m = 0; m < 4; ++m)
#pragma unroll
                    for (int n = 0; n < 2; ++n) acc[a][b][m][n] = (f32x4){0.f, 0.f, 0.f, 0.f};
        cur = nxt; cA = nA; cB = nB; ++ui;
        if constexpr (ALIGN_EPI) { if (wr == 1) PG8_BAR; }
    }
    PG8_WAIT_V(0);
    if constexpr (!ALIGN_EPI) { if (wr == 0) PG8_BAR; }
    PG8_BAR;
    if constexpr (Epi::AFTER_DRAIN) { E.fused(acc, cur, wr, wc, fr, fq, lds, wid, lane); S.done(cur); }
#undef PG8_SA
#undef PG8_SB
#undef PG8_STAGE
#undef PG8_LDA
#undef PG8_LDB
#undef PG8_MMA
#undef PG8_WAIT_V
#undef PG8_WAIT_L
#undef PG8_BAR
#undef PG8_SCHED
}
}

#ifndef PG8_SP2
#define PG8_SP2 true
#endif
#ifndef PG8_ALIGN
#define PG8_ALIGN true
#endif
constexpr int NWAVES = 8;
constexpr int T = 16384, D = 1024, FF = 4096, PLE = 256, NS = 32;
constexpr int LRU = 512, EIN = 2328, EINP = 2560;
constexpr int NPG = 128;
constexpr float EPS = 1e-6f;
constexpr size_t O_YP = 0, O_YS = 16777216, O_KVP = O_YS + 32768, O_KVS = O_KVP + 8388608, O_WINP = O_KVS + 16384, O_WINS = O_WINP + 131072,
                 O_CONVP = O_WINS + 4194304, O_CONVS = O_CONVP + 1536, O_HP = O_CONVS + 49152, O_HS = O_HP + 512, O_VS = O_HS + 16384, O_END = O_VS + 32768;
enum { I_XP = 0, I_XS, I_CKV, I_CWIN, I_SCONV, I_SH, I_PT, I_PP, I_PS, I_RELB, I_GMIX, I_GMLP, I_WUP, I_WDOWN, I_GPLE, I_WPG, I_WPP, I_WINE, I_WOUTE, I_CONVW, I_CONVB,
       I_WA, I_BA, I_WX, I_BX, I_LAM, I_QG, I_KG, I_CWK, I_CWV, I_PEK, I_PEV, I_WINO, I_LNG, I_LNB, I_SGW, I_SGB, I_WOUTO, N_IN };
constexpr size_t MiB = 1ull << 20;
constexpr size_t WS_CTL = 0, CTL_ZERO_BYTES = 1 * MiB;
constexpr size_t WS_WIN0 = 1 * MiB, WS_WOUT0 = 6 * MiB, WS_WUP = 8 * MiB, WS_WDOWN = 24 * MiB, WS_WGATE = 40 * MiB, WS_WPROJ = 44 * MiB, WS_WIN1 = 45 * MiB, WS_WOUT1 = 49 * MiB;
constexpr size_t WS_HBA = 52 * MiB, WS_HBB = 84 * MiB, WS_RSA = 116 * MiB, WS_RSB = 117 * MiB, WS_PB = 118 * MiB;
constexpr size_t WS_XA = 134 * MiB, WS_GG = 166 * MiB, WS_QR = 198 * MiB, WS_WINB = 230 * MiB, WS_GATE = 246 * MiB;
constexpr size_t WS_KC = 248 * MiB, WS_VC = 248 * MiB + 512 * 1024, WS_SUMP = 249 * MiB, WS_SUME = 249 * MiB + 512 * 1024;
constexpr size_t WS_HL = 250 * MiB, WS_CP = 282 * MiB, WS_YAB = 314 * MiB, WS_U = 346 * MiB, WS_PP = 474 * MiB, WS_U1 = 538 * MiB, WS_V1 = 570 * MiB, WS_LNS = 634 * MiB;
constexpr size_t WS_KCS = 636 * MiB, WS_VCS = 644 * MiB, WS_SMP = 652 * MiB;
constexpr size_t WS_KVS = 656 * MiB, WS_KVW = 664 * MiB, WS_KVC = 672 * MiB, WS_WCT = 674 * MiB, WS_KVCS = 675 * MiB, WS_KVWS = 683 * MiB, WS_SGWB = 691 * MiB, WS_PP1 = 692 * MiB, WS_END = 756 * MiB;
constexpr int SM_ZS = 0, SM_QS = 81920, SM_WNS = 98304, SM_GATES = 106496, SM_YABS = 114688, SM_YS0 = 147456, SM_YS1 = 180224, SM_US = 212992, SM_U1S = 344064, SM_V1S = 376832, SM_USS = 409600, SM_PPS = 442368, SM_END = 507904;
constexpr int SB_BASE = 2 * SM_END, SB_YABS = SB_BASE, SB_YS0 = SB_YABS + 32768, SB_YS1 = SB_YS0 + 32768, SB_US = SB_YS1 + 32768, SB_USS = SB_US + 131072, SB_PS = SB_USS + 32768, SB_END = SB_PS + 16384;
static_assert(SB_END * 2 <= 4 * (int)MiB, "sample buffers");
constexpr int CW_TMO = 0, CW_CODE = 1, CW_BAR = 4096;
constexpr int RING_OFF = 0, RING_BYTES = 131072;
constexpr int LDSCTL_OFF = RING_BYTES, MISC_OFF = LDSCTL_OFF + 320;
constexpr int BTAB_OFF = LDSCTL_OFF + 1024;
constexpr int LDS_BYTES = 147456;
static_assert(MISC_OFF + 128 <= BTAB_OFF && BTAB_OFF + 2 * 114 * 8 * 4 <= LDS_BYTES, "LDS map");

#define GAS __attribute__((address_space(1)))
#define LAS __attribute__((address_space(3)))
typedef unsigned short bf16;
typedef unsigned v4u __attribute__((ext_vector_type(4)));
typedef unsigned v2u __attribute__((ext_vector_type(2)));
typedef float f32x4 __attribute__((ext_vector_type(4)));
typedef float f32x2 __attribute__((ext_vector_type(2)));
typedef GAS unsigned gu32;
#define RLX_AGENT __ATOMIC_RELAXED, __HIP_MEMORY_SCOPE_AGENT
#define LDS_WAIT() asm volatile("s_waitcnt lgkmcnt(0)" ::: "memory")
#define VM_WAIT() asm volatile("s_waitcnt vmcnt(0)" ::: "memory")
__device__ __forceinline__ unsigned f2bf(float f) { unsigned u = __builtin_bit_cast(unsigned, f); return (u + 0x7fffu + ((u >> 16) & 1u)) >> 16; }
__device__ __forceinline__ unsigned pk2(float lo, float hi) { return f2bf(lo) | (f2bf(hi) << 16); }
using pg8::gelu_tanh; using pg8::sigmoidf_;

#define XB_TMO      128
#define XB_XCNT(j)  (256  + 64 * (j))
#define XB_XSUB(j)  (1280 + 64 * (j))
#define XB_XGEN(j)  (2304 + 64 * (j))
#define XB_TOP      3328
#define XB_TOPGEN   3392
#define XCD_BAR_WORDS 3456
#define XB_SPIN_CAP (1u << 18)

__device__ __forceinline__ unsigned xb_ld(unsigned* p)              { return __hip_atomic_load(p, __ATOMIC_RELAXED, __HIP_MEMORY_SCOPE_AGENT); }
__device__ __forceinline__ unsigned xb_add(unsigned* p, unsigned v) { return __hip_atomic_fetch_add(p, v, __ATOMIC_RELAXED, __HIP_MEMORY_SCOPE_AGENT); }
__device__ __forceinline__ unsigned xb_xcc_id() { return (unsigned)__builtin_amdgcn_s_getreg((3 << 11) | 20) & 0xFu; }
#define XB_SPIN(cond, bar) do { unsigned _sp = 0; while (cond) { __builtin_amdgcn_s_sleep(1); \
    if ((++_sp & 255u) == 0u) { if (xb_ld(&(bar)[XB_TMO])) break; if (_sp > XB_SPIN_CAP) { atomicAdd(&(bar)[XB_TMO], 1u); break; } } } } while (0)

struct XcdBarrier {
    unsigned* bar; unsigned x;
    volatile LAS unsigned* st;
};

__device__ __forceinline__ XcdBarrier xcd_barrier_post(unsigned* bar, volatile LAS unsigned* st) {
    XcdBarrier b; b.bar = bar; b.x = xb_xcc_id(); b.st = st;
    if (threadIdx.x == 0) (void)xb_add(&bar[XB_XCNT(b.x)], 1u);
    return b;
}
__device__ __forceinline__ void xcd_barrier_complete(unsigned* bar, unsigned x, unsigned& nloc, unsigned& nx) {
    const unsigned G = gridDim.x * gridDim.y * gridDim.z;
    unsigned sum, cnt, mine, sp = 0u;
    for (;;) {
        sum = 0u; cnt = 0u; mine = 0u;
#pragma unroll
        for (unsigned j = 0; j < 16; ++j) { const unsigned c = xb_ld(&bar[XB_XCNT(j)]); sum += c; cnt += (c > 0u) ? 1u : 0u; mine = (j == x) ? c : mine; }
        if (sum == G) break;
        __builtin_amdgcn_s_sleep(1);
        if ((++sp & 255u) == 0u) { if (xb_ld(&bar[XB_TMO])) break; if (sp > XB_SPIN_CAP) { atomicAdd(&bar[XB_TMO], 1u); break; } }
    }
    nloc = mine > 0u ? mine : 1u; nx = cnt > 0u ? cnt : 1u;
}

__device__ __forceinline__ void xcd_barrier(const XcdBarrier& b) {
    asm volatile("s_waitcnt vmcnt(0)" ::: "memory");
    __syncthreads();
    if (threadIdx.x == 0) {
        unsigned* bar = b.bar;
        __builtin_amdgcn_s_waitcnt(0);
        unsigned nloc = b.st[0], nx = b.st[1];
        if (nloc == 0u) { xcd_barrier_complete(bar, b.x, nloc, nx); b.st[0] = nloc; b.st[1] = nx; }
        const unsigned old = xb_add(&bar[XB_XSUB(b.x)], 1u);
        const unsigned gen = old / nloc;
        if (old + 1u == (gen + 1u) * nloc) {
            __builtin_amdgcn_fence(__ATOMIC_RELEASE, "agent");
            asm volatile("s_waitcnt vmcnt(0)" ::: "memory");
            const unsigned og = xb_add(&bar[XB_TOP], 1u);
            const unsigned tg = og / nx;
            if (og + 1u == (tg + 1u) * nx) xb_add(&bar[XB_TOPGEN], 1u);
            else XB_SPIN(xb_ld(&bar[XB_TOPGEN]) == tg, bar);
            __builtin_amdgcn_fence(__ATOMIC_ACQUIRE, "agent");
            xb_add(&bar[XB_XGEN(b.x)], 1u);
            asm volatile("s_waitcnt vmcnt(0)" ::: "memory");
        } else {
            XB_SPIN(xb_ld(&bar[XB_XGEN(b.x)]) == gen, bar);
            __builtin_amdgcn_fence(__ATOMIC_ACQUIRE, "agent");
            asm volatile("s_waitcnt vmcnt(0)" ::: "memory");
        }
    }
    __syncthreads();
}


struct Args { const float* in[N_IN]; float* out; unsigned char* ws; int ph_lo, ph_hi; };
struct Frame {
    LAS unsigned char* lds;
    volatile LAS unsigned* MISC;
    gu32* ctl;
    int wave;
    int vcu, G;
    float* out; unsigned char* ws;
};
__device__ __forceinline__ int lane_id_() { int l = (int)__builtin_amdgcn_mbcnt_hi(~0u, __builtin_amdgcn_mbcnt_lo(~0u, 0u)); asm volatile("" : "+v"(l)); return l; }
#define LANE() lane_id_()
#define TID() (F.wave * 64 + lane_id_())
#define WSF(off) ((float*)(F.ws + (off)))
#define WSB(off) ((bf16*)(F.ws + (off)))
#define SMP(off) ((float*)(F.ws + WS_SMP) + (off))
#define SMB(off) ((bf16*)(F.ws + WS_SMP) + (off))

__device__ __forceinline__ float wave_sum(float v) {
#pragma unroll
    for (int o = 1; o < 64; o <<= 1) v += __shfl_xor(v, o);
    return v;
}
__device__ __forceinline__ void transpose_item(const float* W, int K, int N, const float* gain, bf16* WT, LAS float* scr, int item, int lane, bool headperm = false) {
    const int nblk = (N + 31) / 32, kb = item / nblk, nb = item % nblk, k0 = 64 * kb, n0 = 32 * nb;
    const int r0 = (headperm && n0 >= 1024 && n0 < 2304) ? (n0 & ~255) + 128 * ((n0 >> 5) & 1) + 32 * ((n0 & 255) >> 6) : n0;
    {   float wv[32]; const int n = n0 + (lane & 31);
#pragma unroll
        for (int i = 0; i < 32; ++i) wv[i] = (n < N) ? W[(size_t)(k0 + 2 * i + (lane >> 5)) * N + n] : 0.f;
#pragma unroll
        for (int i = 0; i < 32; ++i) { const int kk = 2 * i + (lane >> 5); float v = wv[i]; if (gain) v *= gain[k0 + kk]; scr[kk * 33 + (lane & 31)] = v; } }
    LDS_WAIT();
    const int c = lane & 7;
#pragma unroll
    for (int j = 0; j < 4; ++j) { const int n = (lane >> 3) + 8 * j; const LAS float* s = scr + (8 * c) * 33 + n;
        v4u o; o.x = pk2(s[0 * 33], s[1 * 33]); o.y = pk2(s[2 * 33], s[3 * 33]); o.z = pk2(s[4 * 33], s[5 * 33]); o.w = pk2(s[6 * 33], s[7 * 33]);
        *(GAS v4u*)(WT + (size_t)(r0 + n) * K + k0 + 8 * c) = o; }
    LDS_WAIT();
}
__device__ __forceinline__ void x_row_to_bf16(int lane, const float* xrow, bf16* orow, float* rsrow) {
    const GAS f32x4* xr = (const GAS f32x4*)xrow + lane;
    f32x4 v[4]; float s = 0.f;
#pragma unroll
    for (int j = 0; j < 4; ++j) { v[j] = xr[64 * j]; s += (v[j].x * v[j].x + v[j].y * v[j].y) + (v[j].z * v[j].z + v[j].w * v[j].w); }
    s = wave_sum(s);
    GAS unsigned long long* o8 = (GAS unsigned long long*)orow + lane;
#pragma unroll
    for (int j = 0; j < 4; ++j) o8[64 * j] = (unsigned long long)pk2(v[j].x, v[j].y) | ((unsigned long long)pk2(v[j].z, v[j].w) << 32);
    if (lane < 16) rsrow[lane] = (lane == 0) ? s : 0.f;
}
__device__ __forceinline__ void x_row2_to_bf16(int lane, const float* xrow, bf16* orow, float* rsrow) {
    const GAS f32x4* xr = (const GAS f32x4*)xrow + lane;
    f32x4 v[8]; float s0 = 0.f, s1 = 0.f;
#pragma unroll
    for (int j = 0; j < 8; ++j) v[j] = xr[64 * j];
#pragma unroll
    for (int j = 0; j < 4; ++j) { s0 += (v[j].x * v[j].x + v[j].y * v[j].y) + (v[j].z * v[j].z + v[j].w * v[j].w); s1 += (v[4 + j].x * v[4 + j].x + v[4 + j].y * v[4 + j].y) + (v[4 + j].z * v[4 + j].z + v[4 + j].w * v[4 + j].w); }
    s0 = wave_sum(s0); s1 = wave_sum(s1);
    GAS unsigned long long* o8 = (GAS unsigned long long*)orow + lane;
#pragma unroll
    for (int j = 0; j < 8; ++j) o8[64 * j] = (unsigned long long)pk2(v[j].x, v[j].y) | ((unsigned long long)pk2(v[j].z, v[j].w) << 32);
    if (lane < 32) rsrow[lane] = (lane == 0) ? s0 : (lane == 16 ? s1 : 0.f);
}
__device__ __forceinline__ void x_row4_to_bf16(int lane, const float* xrow, bf16* orow, float* rsrow) {
    const GAS f32x4* xr = (const GAS f32x4*)xrow + lane;
    f32x4 v[16]; float s[4] = {0.f, 0.f, 0.f, 0.f};
#pragma unroll
    for (int j = 0; j < 16; ++j) v[j] = xr[64 * j];
#pragma unroll
    for (int i = 0; i < 4; ++i)
#pragma unroll
        for (int j = 0; j < 4; ++j) { const f32x4 x = v[4 * i + j]; s[i] += (x.x * x.x + x.y * x.y) + (x.z * x.z + x.w * x.w); }
#pragma unroll
    for (int i = 0; i < 4; ++i) s[i] = wave_sum(s[i]);
    GAS unsigned long long* o8 = (GAS unsigned long long*)orow + lane;
#pragma unroll
    for (int j = 0; j < 16; ++j) o8[64 * j] = (unsigned long long)pk2(v[j].x, v[j].y) | ((unsigned long long)pk2(v[j].z, v[j].w) << 32);
    rsrow[lane] = (lane == 0) ? s[0] : (lane == 16 ? s[1] : (lane == 32 ? s[2] : (lane == 48 ? s[3] : 0.f)));
}
__device__ __forceinline__ void sample_rstd(Frame& F, const float* Amat, LAS float* rs) {
#pragma unroll
    for (int i = 0; i < 4; ++i) { const int r = F.wave * 4 + i; const f32x4* p = (const f32x4*)(Amat + (size_t)r * D) + LANE(); float s = 0.f;
#pragma unroll
        for (int j = 0; j < 4; ++j) { const f32x4 v = p[64 * j]; s += (v.x * v.x + v.y * v.y) + (v.z * v.z + v.w * v.w); }
        s = wave_sum(s); if (LANE() == 0) rs[r] = 1.0f / sqrtf(s * (1.0f / D) + EPS); }
    LDS_WAIT(); __syncthreads();
}
__device__ __forceinline__ float sgemm_cg(Frame& F, const float* Amat, int lda, const float* gain, const float* W, int N, int K, int n0, LAS float* red) {
    const int r = LANE() & 31, kh = LANE() >> 5, ksl = K / 16, k0 = (F.wave * 2 + kh) * ksl;
    f32x4 acc = {0.f, 0.f, 0.f, 0.f};
    const float* ap = Amat + (size_t)r * lda + k0;
#pragma unroll 4
    for (int k = 0; k < ksl; k += 4) {
        f32x4 a = *(const f32x4*)(ap + k);
        if (gain) a = a * *(const f32x4*)(gain + k0 + k);
        const float* wp = W + (size_t)(k0 + k) * N + n0;
        const f32x4 w0 = *(const f32x4*)wp, w1 = *(const f32x4*)(wp + N), w2 = *(const f32x4*)(wp + 2 * (size_t)N), w3 = *(const f32x4*)(wp + 3 * (size_t)N);
        acc += w0 * a.x; acc += w1 * a.y; acc += w2 * a.z; acc += w3 * a.w;
    }
#pragma unroll
    for (int j = 0; j < 4; ++j) acc[j] += __shfl_xor(acc[j], 32);
    if (kh == 0) *(LAS f32x4*)(red + (F.wave * 32 + r) * 4) = acc;
    LDS_WAIT(); __syncthreads();
    float s = 0.f;
    if (TID() < 128) { const int rr = TID() & 31, cc = TID() >> 5;
#pragma unroll
        for (int w = 0; w < 8; ++w) s += red[(w * 32 + rr) * 4 + cc]; }
    LDS_WAIT(); __syncthreads();
    return s;
}

#define SG_ROW(tid_) (16 * ((tid_) >> 8) + 4 * (((tid_) >> 6) & 3) + ((tid_) & 3))
#define SG_COL(tid_) (((tid_) >> 2) & 15)
typedef short bf16x8s __attribute__((ext_vector_type(8)));
__device__ __forceinline__ float sgemm16(Frame& F, const bf16* Abf, int K, const bf16* Wt, int ct, LAS float* red, const float* rs_src = nullptr, LAS float* rsl = nullptr) {
    const int lane = LANE(), r = lane & 15, q = lane >> 4, kw = K >> 3, k0 = F.wave * kw;
    f32x4 rv[4][4];
    if (rs_src) {
#pragma unroll
        for (int i = 0; i < 4; ++i)
#pragma unroll
            for (int j = 0; j < 4; ++j) rv[i][j] = *((const f32x4*)(rs_src + (size_t)(F.wave * 4 + i) * D) + lane + 64 * j); }
    const bf16* a0 = Abf + (size_t)r * K + k0 + 8 * q; const bf16* a1 = a0 + (size_t)16 * K; const bf16* bp = Wt + (size_t)(16 * ct + r) * K + k0 + 8 * q;
    f32x4 acc0 = {0.f, 0.f, 0.f, 0.f}, acc1 = {0.f, 0.f, 0.f, 0.f};
#pragma unroll 8
    for (int k = 0; k < kw; k += 32) { const bf16x8s x0 = *(const bf16x8s*)(a0 + k), x1 = *(const bf16x8s*)(a1 + k), w = *(const bf16x8s*)(bp + k);
        acc0 = __builtin_amdgcn_mfma_f32_16x16x32_bf16(x0, w, acc0, 0, 0, 0); acc1 = __builtin_amdgcn_mfma_f32_16x16x32_bf16(x1, w, acc1, 0, 0, 0); }
    *(LAS f32x4*)(red + (F.wave * 2 + 0) * 256 + lane * 4) = acc0; *(LAS f32x4*)(red + (F.wave * 2 + 1) * 256 + lane * 4) = acc1;
    if (rs_src) {
#pragma unroll
        for (int i = 0; i < 4; ++i) { float ss = 0.f;
#pragma unroll
            for (int j = 0; j < 4; ++j) { const f32x4 v = rv[i][j]; ss += (v.x * v.x + v.y * v.y) + (v.z * v.z + v.w * v.w); }
            ss = wave_sum(ss); if (lane == 0) rsl[F.wave * 4 + i] = 1.0f / sqrtf(ss * (1.0f / D) + EPS); } }
    LDS_WAIT(); __syncthreads();
    const int tid = TID(); float s = 0.f;
#pragma unroll
    for (int w = 0; w < 8; ++w) s += red[(w * 2 + (tid >> 8)) * 256 + (tid & 255)];
    LDS_WAIT(); __syncthreads();
    return s;
}

__device__ __forceinline__ float sgemm16_f32w(Frame& F, const float* Amat, const float* gain, const float* W, int N, int ct, LAS float* red) {
    const int lane = LANE(), r = lane & 15, q = lane >> 4, k0 = F.wave * 128 + 8 * q, n = 16 * ct + r; const bool nv = n < N;
    const float* a0 = Amat + (size_t)r * D + k0; const float* a1 = a0 + (size_t)16 * D; const float* wp = W + (size_t)k0 * N + (nv ? n : 0);
    f32x4 acc0 = {0.f, 0.f, 0.f, 0.f}, acc1 = {0.f, 0.f, 0.f, 0.f};
#pragma unroll
    for (int ks = 0; ks < 4; ++ks) {
        const f32x4 g0 = *(const f32x4*)(gain + k0 + 32 * ks), g1 = *(const f32x4*)(gain + k0 + 32 * ks + 4);
        const f32x4 p0 = *(const f32x4*)(a0 + 32 * ks) * g0, p1 = *(const f32x4*)(a0 + 32 * ks + 4) * g1, p2 = *(const f32x4*)(a1 + 32 * ks) * g0, p3 = *(const f32x4*)(a1 + 32 * ks + 4) * g1;
        float wv[8];
#pragma unroll
        for (int j = 0; j < 8; ++j) wv[j] = wp[(size_t)(32 * ks + j) * N];
        const v4u x0 = {pk2(p0[0], p0[1]), pk2(p0[2], p0[3]), pk2(p1[0], p1[1]), pk2(p1[2], p1[3])}, x1 = {pk2(p2[0], p2[1]), pk2(p2[2], p2[3]), pk2(p3[0], p3[1]), pk2(p3[2], p3[3])};
        v4u w = {pk2(wv[0], wv[1]), pk2(wv[2], wv[3]), pk2(wv[4], wv[5]), pk2(wv[6], wv[7])}; if (!nv) w = (v4u){0u, 0u, 0u, 0u};
        acc0 = __builtin_amdgcn_mfma_f32_16x16x32_bf16(__builtin_bit_cast(bf16x8s, x0), __builtin_bit_cast(bf16x8s, w), acc0, 0, 0, 0);
        acc1 = __builtin_amdgcn_mfma_f32_16x16x32_bf16(__builtin_bit_cast(bf16x8s, x1), __builtin_bit_cast(bf16x8s, w), acc1, 0, 0, 0); }
    *(LAS f32x4*)(red + (F.wave * 2 + 0) * 256 + lane * 4) = acc0; *(LAS f32x4*)(red + (F.wave * 2 + 1) * 256 + lane * 4) = acc1;
    LDS_WAIT(); __syncthreads();
    const int tid = TID(); float s = 0.f;
#pragma unroll
    for (int w = 0; w < 8; ++w) s += red[(w * 2 + (tid >> 8)) * 256 + (tid & 255)];
    LDS_WAIT(); __syncthreads();
    return s;
}

__device__ __forceinline__ void rg_ab(float rp, float ip, float cv, float lam, float& a, float& b) {
    const float r = 1.0f / (1.0f + expf(-rp)), i = 1.0f / (1.0f + expf(-ip));
    const float sp = log1pf(expf(-lam)); const float la = -8.0f * r * sp;
    a = expf(la); b = sqrtf(-expm1f(2.0f * la)) * (i * cv);
}

__device__ __forceinline__ void sample_post(Frame& F, const Args& A, int b) {
    const int lane = LANE(); const float* z = SMP(SM_ZS) + (size_t)b * EIN;
    const float* convw = A.in[I_CONVW]; const float* sc = A.in[I_SCONV] + (size_t)b * 3 * LRU;
    float* convs = F.out + O_CONVS + (size_t)b * 3 * LRU;
    for (int n = 0; n < 8; ++n) {
        const int ch = n * 64 + lane; const float xa = z[ch];
        const float s0 = sc[ch], s1 = sc[LRU + ch], s2 = sc[2 * LRU + ch];
        const float cv = A.in[I_CONVB][ch] + convw[ch] * s0 + convw[LRU + ch] * s1 + convw[2 * LRU + ch] * s2 + convw[3 * LRU + ch] * xa;
        convs[ch] = s1; convs[LRU + ch] = s2; convs[2 * LRU + ch] = xa;
        float rp = A.in[I_BA][ch], ip = A.in[I_BX][ch];
        const float* wa = A.in[I_WA] + (size_t)n * 4096 + lane; const float* wx = A.in[I_WX] + (size_t)n * 4096 + lane;
        for (int c = 0; c < 64; ++c) { const float cc = __shfl(cv, c); rp += cc * wa[c * 64]; ip += cc * wx[c * 64]; }
        float a, bb; rg_ab(rp, ip, cv, A.in[I_LAM][ch], a, bb);
        const float h = a * A.in[I_SH][(size_t)b * LRU + ch] + bb;
        F.out[O_HS + (size_t)b * LRU + ch] = h;
        { const float ya = h * gelu_tanh(z[LRU + ch]); SMP(SM_YABS)[(size_t)b * D + ch] = ya; SMB(SB_YABS)[(size_t)b * D + ch] = (bf16)f2bf(ya); }
    }
    {
        const float* q = z + 1024 + lane * 8; float v[8], ss = 0.f;
#pragma unroll
        for (int j = 0; j < 8; ++j) { v[j] = q[j]; ss += v[j] * v[j]; }
        ss += __shfl_xor(ss, 1); ss += __shfl_xor(ss, 2); ss += __shfl_xor(ss, 4);
        const float rstd = 1.0f / sqrtf(ss * (1.0f / 64.0f) + EPS);
#pragma unroll
        for (int j = 0; j < 8; ++j) SMP(SM_QS)[(size_t)b * 512 + lane * 8 + j] = v[j] * rstd * A.in[I_QG][(lane & 7) * 8 + j];
    }
    for (int s = 0; s < 6; ++s) {
        const float* p = z + 1536 + s * 128 + lane * 2; float v0 = p[0], v1 = p[1];
        if (s == 2 || s == 4) { float ss = v0 * v0 + v1 * v1;
#pragma unroll
            for (int o = 1; o < 32; o <<= 1) ss += __shfl_xor(ss, o);
            const float rstd = 1.0f / sqrtf(ss * (1.0f / 64.0f) + EPS); const float* kg = A.in[I_KG] + (s == 2 ? 64 : 128) + (lane & 31) * 2;
            v0 = v0 * rstd * kg[0]; v1 = v1 * rstd * kg[1]; }
        if (s < 4) { float* o = F.out + O_KVS + (size_t)b * 512 + s * 128 + lane * 2; o[0] = v0; o[1] = v1; }
        else { float* o = SMP(SM_WNS) + (size_t)b * 256 + (s - 4) * 128 + lane * 2; o[0] = v0; o[1] = v1;
               float* w = F.out + O_WINS + ((size_t)b * 512 + 511) * 256 + (s - 4) * 128 + lane * 2; w[0] = v0; w[1] = v1; }
    }
    if (lane < 24) SMP(SM_GATES)[b * 24 + lane] = sigmoidf_(z[2304 + lane]);
}
__host__ __device__ __forceinline__ int kv_off_k(int r, int d) { return (((r >> 4) * 2 + (d >> 5)) * 64 + ((d & 31) >> 3) * 16 + (r & 15)) * 8 + (d & 7); }
__host__ __device__ __forceinline__ int kv_off_v(int s, int d) { return 4096 + (((s >> 5) * 4 + (d >> 4)) * 64 + ((s & 31) >> 3) * 16 + (d & 15)) * 8 + (s & 7); }
#if FUSE_HEADNORM
__device__ __forceinline__ void ktile_token4(Frame& F, const Args& A, int t0) {
    const int lane = LANE(), l = lane & 31;
    f32x4 a[4];
#pragma unroll
    for (int i = 0; i < 4; ++i) a[i] = *(const f32x4*)((lane < 32) ? (F.out + O_KVP + (size_t)(t0 + i) * 512 + 256 + l * 4) : (WSF(WS_WINB) + (size_t)(t0 + i) * 256 + l * 4));
#pragma unroll
    for (int i = 0; i < 4; ++i) { const int t = t0 + i;
#if SEL_FP8
        if (lane < 32) { const int r = t & 63, d = 4 * (l & 15);
            int w = __builtin_amdgcn_cvt_pk_fp8_f32(a[i].x, a[i].y, 0, false); w = __builtin_amdgcn_cvt_pk_fp8_f32(a[i].z, a[i].w, w, true);
            *(int*)((unsigned char*)(WSB(WS_KVS) + (size_t)((t >> 6) * 2 + (l >> 4)) * 8192) + ((r >> 4) * 64 + ((d & 31) >> 3) * 16 + (r & 15)) * 16 + (d >> 5) * 8 + (d & 7)) = w; }
        else
#endif
        *(v2u*)(WSB(lane < 32 ? WS_KVS : WS_KVW) + (size_t)((t >> 6) * 2 + (l >> 4)) * 8192 + kv_off_k(t & 63, 4 * (l & 15))) = (v2u){pk2(a[i].x, a[i].y), pk2(a[i].z, a[i].w)}; }
}
#endif
__device__ __forceinline__ void head_norm_token(Frame& F, const Args& A, int t) {
    const int lane = LANE();
    {   float* q = WSF(WS_QR) + (size_t)t * 512 + lane * 8; f32x4 a = *(f32x4*)q, b = *(f32x4*)(q + 4);
        float ss = pg8::dot4(a) + pg8::dot4(b); ss += __shfl_xor(ss, 1); ss += __shfl_xor(ss, 2); ss += __shfl_xor(ss, 4);
        const float rstd = 1.0f / sqrtf(ss * (1.0f / 64.0f) + EPS); const float* g = A.in[I_QG] + (lane & 7) * 8;
        a = a * rstd * *(const f32x4*)g; b = b * rstd * *(const f32x4*)(g + 4); *(f32x4*)q = a; *(f32x4*)(q + 4) = b; }
    {   const int l = lane & 31; float* p = (lane < 32) ? (F.out + O_KVP + (size_t)t * 512 + 256 + l * 4) : (WSF(WS_WINB) + (size_t)t * 256 + l * 4);
        f32x4 a = *(f32x4*)p; float ss = pg8::dot4(a);
#pragma unroll
        for (int o = 1; o < 16; o <<= 1) ss += __shfl_xor(ss, o);
        const float rstd = 1.0f / sqrtf(ss * (1.0f / 64.0f) + EPS); const float* g = A.in[I_KG] + (lane < 32 ? 64 : 128) + (l & 15) * 4;
        a = a * rstd * *(const f32x4*)g; *(f32x4*)p = a;
#if SEL_FP8
        if (lane < 32) { const int r = t & 63, d = 4 * (l & 15);
            int w = __builtin_amdgcn_cvt_pk_fp8_f32(a.x, a.y, 0, false); w = __builtin_amdgcn_cvt_pk_fp8_f32(a.z, a.w, w, true);
            *(int*)((unsigned char*)(WSB(WS_KVS) + (size_t)((t >> 6) * 2 + (l >> 4)) * 8192) + ((r >> 4) * 64 + ((d & 31) >> 3) * 16 + (r & 15)) * 16 + (d >> 5) * 8 + (d & 7)) = w; }
        else
#endif
        *(v2u*)(WSB(lane < 32 ? WS_KVS : WS_KVW) + (size_t)((t >> 6) * 2 + (l >> 4)) * 8192 + kv_off_k(t & 63, 4 * (l & 15))) = (v2u){pk2(a.x, a.y), pk2(a.z, a.w)};
        if (t >= T - 512) {
            float* wo = F.out + O_WINP + (size_t)(t - (T - 512)) * 256;
            if (lane >= 32) *(f32x4*)(wo + l * 4) = a;
            else *(f32x4*)(wo + 128 + l * 4) = *(const f32x4*)(WSF(WS_WINB) + (size_t)t * 256 + 128 + l * 4);
        }
    }
    if (t >= T - 3) {
        const float* x = WSF(WS_XA) + (size_t)t * 512 + lane * 8; float* o = F.out + O_CONVP + (size_t)(t - (T - 3)) * 512 + lane * 8;
        *(f32x4*)o = *(const f32x4*)x; *(f32x4*)(o + 4) = *(const f32x4*)(x + 4);
    }
}

__host__ __device__ __forceinline__ int vt_slot(int r);

__device__ __forceinline__ void rg1_item(Frame& F, const Args& A, int sc, int n, LAS float* wscr) {
    typedef float f32x16 __attribute__((ext_vector_type(16)));
    const int lane = LANE(), ch = n * 64 + lane, t0 = sc * 64, l31 = lane & 31, lh = lane >> 5;
    const float* cw = A.in[I_CONVW];
    const float cw0 = cw[ch], cw1 = cw[LRU + ch], cw2 = cw[2 * LRU + ch], cw3 = cw[3 * LRU + ch], cb = A.in[I_CONVB][ch];
    const float* xa = WSF(WS_XA); bf16* HL = WSB(WS_HL); bf16* CP = WSB(WS_CP);
    float xm3 = 0.f, xm2 = 0.f, xm1 = 0.f;
    if (t0 > 0) { xm3 = xa[(size_t)(t0 - 3) * LRU + ch]; xm2 = xa[(size_t)(t0 - 2) * LRU + ch]; xm1 = xa[(size_t)(t0 - 1) * LRU + ch]; }
    float h = 0.f, cp = 1.f;
    float ba2[2], bx2[2], sp2[2];
#pragma unroll
    for (int dt = 0; dt < 2; ++dt) { const int cd = n * 64 + dt * 32 + l31; ba2[dt] = A.in[I_BA][cd]; bx2[dt] = A.in[I_BX][cd]; sp2[dt] = -8.0f * log1pf(expf(-A.in[I_LAM][cd])); }
    for (int hf = 0; hf < 2; ++hf) {
        const int tb = t0 + hf * 32;
        LDS_WAIT();
        {   float xv[32];
#pragma unroll
            for (int i = 0; i < 32; ++i) xv[i] = xa[(size_t)(tb + i) * LRU + ch];
#pragma unroll
            for (int i = 0; i < 32; ++i) { const float x = xv[i];
                const float cv = cb + cw0 * xm3 + cw1 * xm2 + cw2 * xm1 + cw3 * x; xm3 = xm2; xm2 = xm1; xm1 = x;
                wscr[i * 65 + lane] = cv; } }
        LDS_WAIT();
        float ra[2][16], rb[2][16];
#pragma unroll
        for (int dt = 0; dt < 2; ++dt) {
            f32x16 pa, px;
#pragma unroll
            for (int r = 0; r < 16; ++r) { pa[r] = 0.f; px[r] = 0.f; }
            const float* wa = A.in[I_WA] + (size_t)n * 4096 + dt * 32 + l31 + lh * 64; const float* wx = A.in[I_WX] + (size_t)n * 4096 + dt * 32 + l31 + lh * 64;
            const LAS float* ap = wscr + l31 * 65 + lh;
#pragma unroll 1
            for (int kh = 0; kh < 2; ++kh) {
                float wav[16], wxv[16];
#pragma unroll
                for (int k2 = 0; k2 < 16; ++k2) { wav[k2] = wa[(kh * 16 + k2) * 128]; wxv[k2] = wx[(kh * 16 + k2) * 128]; }
#pragma unroll
                for (int k2 = 0; k2 < 16; ++k2) { const float av = ap[2 * (kh * 16 + k2)];
                    pa = __builtin_amdgcn_mfma_f32_32x32x2f32(av, wav[k2], pa, 0, 0, 0); px = __builtin_amdgcn_mfma_f32_32x32x2f32(av, wxv[k2], px, 0, 0, 0); } }
#pragma unroll
            for (int r = 0; r < 16; ++r) { const int tt = (r & 3) + 8 * (r >> 2) + 4 * lh;
                const float cv = wscr[tt * 65 + dt * 32 + l31];
                const float rg = __builtin_amdgcn_rcpf(1.0f + __expf(-(pa[r] + ba2[dt]))), ig = __builtin_amdgcn_rcpf(1.0f + __expf(-(px[r] + bx2[dt])));
                const float la = sp2[dt] * rg, x2 = 2.0f * la;
                const float om = x2 > -0.0625f ? -x2 * (1.0f + x2 * (0.5f + x2 * (0.16666667f + x2 * 0.041666668f))) : 1.0f - __expf(x2);
                ra[dt][r] = __expf(la); rb[dt][r] = __builtin_amdgcn_sqrtf(om) * (ig * cv); }
        }
        LDS_WAIT();
#pragma unroll
        for (int dt = 0; dt < 2; ++dt)
#pragma unroll
            for (int r = 0; r < 16; ++r) { const int tt = (r & 3) + 8 * (r >> 2) + 4 * lh; wscr[tt * 64 + dt * 32 + l31] = ra[dt][r]; wscr[2048 + tt * 64 + dt * 32 + l31] = rb[dt][r]; }
        LDS_WAIT();
#pragma unroll 8
        for (int i = 0; i < 32; ++i) { const float a = wscr[i * 64 + lane], b = wscr[2048 + i * 64 + lane];
            h = a * h + b; cp *= a; HL[(size_t)(tb + i) * LRU + ch] = (bf16)f2bf(h); CP[(size_t)(tb + i) * LRU + ch] = (bf16)f2bf(cp); }
    }
    WSF(WS_SUMP)[(size_t)sc * LRU + ch] = cp; WSF(WS_SUME)[(size_t)sc * LRU + ch] = h;
}
__device__ __forceinline__ void rg3_item(Frame& F, const Args& A, int sc, int n) {
    const int lane = LANE(), ch = n * 64 + lane, t0 = sc * 64;
    const float* SP = WSF(WS_SUMP) + ch; const float* SE = WSF(WS_SUME) + ch;
    float H = 0.f;
    int s = 0;
    for (; s + 8 <= sc; s += 8) { float p[8], e[8];
#pragma unroll
        for (int j = 0; j < 8; ++j) { p[j] = SP[(size_t)(s + j) * LRU]; e[j] = SE[(size_t)(s + j) * LRU]; }
#pragma unroll
        for (int j = 0; j < 8; ++j) H = p[j] * H + e[j]; }
    for (; s < sc; ++s) H = SP[(size_t)s * LRU] * H + SE[(size_t)s * LRU];
    const bf16* HL = WSB(WS_HL); const bf16* CP = WSB(WS_CP); const bf16* GG = WSB(WS_GG); bf16* Y = WSB(WS_YAB);
    float hlast = 0.f;
#pragma unroll 8
    for (int i = 0; i < 64; ++i) { const size_t t = (size_t)(t0 + i);
        const float h = __builtin_bit_cast(float, (unsigned)HL[t * LRU + ch] << 16) + __builtin_bit_cast(float, (unsigned)CP[t * LRU + ch] << 16) * H; hlast = h;
        Y[t * D + ch] = (bf16)f2bf(h * __builtin_bit_cast(float, (unsigned)GG[t * LRU + ch] << 16)); }
    if (sc == T / 64 - 1) F.out[O_HP + ch] = hlast;
}

__device__ __forceinline__ void cmp_prompt_item(Frame& F, const Args& A, int jq, int kv, LAS float* scr) {
    const int lane = LANE(); const float* W = A.in[kv ? I_CWV : I_CWK]; const float* pe = A.in[kv ? I_PEV : I_PEK]; const float* kvp = F.out + O_KVP;
    float acc[8];
#pragma unroll
    for (int o = 0; o < 8; ++o) acc[o] = 0.f;
    for (int i = 0; i < 32; ++i) {
        const float pv = pe[i * 64 + lane];
#pragma unroll
        for (int o = 0; o < 8; ++o) scr[lane * 8 + o] = kvp[(size_t)(32 * (4 * jq + (o >> 1)) + i) * 512 + kv * 128 + (o & 1) * 64 + lane] + pv;
        LDS_WAIT();
#pragma unroll 8
        for (int c = 0; c < 64; ++c) { const float w = W[(size_t)(i * 64 + c) * 64 + lane];
            const f32x4 x0 = *(const LAS f32x4*)(scr + c * 8), x1 = *(const LAS f32x4*)(scr + c * 8 + 4);
            acc[0] += x0.x * w; acc[1] += x0.y * w; acc[2] += x0.z * w; acc[3] += x0.w * w; acc[4] += x1.x * w; acc[5] += x1.y * w; acc[6] += x1.z * w; acc[7] += x1.w * w; }
        LDS_WAIT();
    }
    float* dst = WSF(kv ? WS_VC : WS_KC);
#pragma unroll
    for (int o = 0; o < 8; ++o) { float v = acc[o];
        if (kv == 0) { const float ss = wave_sum(v * v); v = v * (1.0f / sqrtf(ss * (1.0f / 64.0f) + EPS)) * A.in[I_KG][lane]; }
        dst[(size_t)((4 * jq + (o >> 1)) * 2 + (o & 1)) * 64 + lane] = v;
        const int j = 4 * jq + (o >> 1), gg = o & 1;
        bf16* tile = WSB(WS_KVC) + (size_t)((j >> 6) * 2 + gg) * 8192;
        if (kv == 0) tile[kv_off_k(j & 63, lane)] = (bf16)f2bf(v);
        else tile[kv_off_v(vt_slot(j & 63), lane)] = (bf16)f2bf(v); }
}
__device__ __forceinline__ void cmp_sample_item(Frame& F, const Args& A, int b, int pg) {
    LAS float* xs = (LAS float*)(F.lds + RING_OFF);
    LAS float* red = (LAS float*)(F.lds + RING_OFF + 65536);
    const int lane = LANE(), phys = ((const int*)A.in[I_PT])[b * NPG + pg];
    for (int kv = 0; kv < 2; ++kv) {
        const float* W = A.in[kv ? I_CWV : I_CWK]; const float* pe = A.in[kv ? I_PEV : I_PEK];
        for (int idx = TID(); idx < 128 * 32; idx += NWAVES * 64) { const int r = idx >> 5, q = idx & 31;
            const f32x4 v = *(const f32x4*)(A.in[I_CKV] + ((size_t)(phys * 128 + r) * 4 + kv) * 128 + q * 4), p4 = *(const f32x4*)(pe + (r & 31) * 64 + (q & 15) * 4);
            *(LAS f32x4*)(xs + r * 128 + q * 4) = v + p4; }
        LDS_WAIT(); __syncthreads();
        float acc[8];
#pragma unroll
        for (int o = 0; o < 8; ++o) acc[o] = 0.f;
        for (int ii = 0; ii < 4; ++ii) { const int i = 4 * F.wave + ii;
#pragma unroll 2
            for (int c = 0; c < 64; c += 4) {
                const float w0 = W[(size_t)(i * 64 + c) * 64 + lane], w1 = W[(size_t)(i * 64 + c + 1) * 64 + lane], w2 = W[(size_t)(i * 64 + c + 2) * 64 + lane], w3 = W[(size_t)(i * 64 + c + 3) * 64 + lane];
#pragma unroll
                for (int o = 0; o < 8; ++o) { const f32x4 x = *(const LAS f32x4*)(xs + ((o >> 1) * 32 + i) * 128 + (o & 1) * 64 + c);
                    acc[o] += (x.x * w0 + x.y * w1) + (x.z * w2 + x.w * w3); }
            }
        }
#pragma unroll
        for (int o = 0; o < 8; ++o) red[(F.wave * 8 + o) * 64 + lane] = acc[o];
        LDS_WAIT(); __syncthreads();
        {   const int o = F.wave; float v = 0.f;
#pragma unroll
            for (int w = 0; w < 8; ++w) v += red[(w * 8 + o) * 64 + lane];
            if (kv == 0) { const float ss = wave_sum(v * v); v = v * (1.0f / sqrtf(ss * (1.0f / 64.0f) + EPS)) * A.in[I_KG][lane]; }
            WSF(kv ? WS_VCS : WS_KCS)[((size_t)(b * 512 + 4 * pg + (o >> 1)) * 2 + (o & 1)) * 64 + lane] = v; }
        LDS_WAIT(); __syncthreads();
    }
}

constexpr int AW_SC = 0, AW_IMP = 8192, AW_PT = 9472, AW_SEL = 9728, AW_Q = 9792;
struct SrcPromptCmp { const float* kc; const float* vc; const LAS float* btab; int t, g;
    __device__ __forceinline__ bool valid(int) const { return true; }
    __device__ __forceinline__ float bias(int k, int hh) const { int d = t - (32 * k + 31); d = d > 113 ? 113 : d; return btab[d * 8 + g * 4 + hh]; }
    __device__ __forceinline__ const float* kptr(int k) const { return kc + (size_t)(k * 2 + g) * 64; }
    __device__ __forceinline__ const float* vptr(int k) const { return vc + (size_t)(k * 2 + g) * 64; } };
struct SrcPromptSel { const float* kvp; const LAS float* btab; const LAS int* sel; int t, g;
    __device__ __forceinline__ int kpos(int k) const { return sel[k >> 6] * 64 + (k & 63); }
    __device__ __forceinline__ bool valid(int k) const { return kpos(k) <= t; }
    __device__ __forceinline__ float bias(int k, int hh) const { int d = t - kpos(k); d = d > 113 ? 113 : d; return btab[d * 8 + g * 4 + hh]; }
    __device__ __forceinline__ const float* kptr(int k) const { return kvp + (size_t)kpos(k) * 512 + 256 + g * 64; }
    __device__ __forceinline__ const float* vptr(int k) const { return kvp + (size_t)kpos(k) * 512 + 384 + g * 64; } };
struct SrcPromptWin { const float* winb; const LAS float* btab; int t, g;
    __device__ __forceinline__ bool valid(int k) const { return t - 511 + k >= 0; }
    __device__ __forceinline__ float bias(int k, int hh) const { int d = 511 - k; d = d > 113 ? 113 : d; return btab[d * 8 + g * 4 + hh]; }
    __device__ __forceinline__ const float* kptr(int k) const { return winb + (size_t)(t - 511 + k) * 256 + g * 64; }
    __device__ __forceinline__ const float* vptr(int k) const { return winb + (size_t)(t - 511 + k) * 256 + 128 + g * 64; } };
struct SrcSampleCmp { const float* kc; const float* vc; const LAS float* btab; int g;
    __device__ __forceinline__ bool valid(int) const { return true; }
    __device__ __forceinline__ float bias(int k, int hh) const { int d = T - (32 * k + 31); d = d > 113 ? 113 : d; return btab[d * 8 + g * 4 + hh]; }
    __device__ __forceinline__ const float* kptr(int k) const { return kc + (size_t)(k * 2 + g) * 64; }
    __device__ __forceinline__ const float* vptr(int k) const { return vc + (size_t)(k * 2 + g) * 64; } };
struct SrcSampleSel { const float* cache; const int* pt; const float* newrow; const LAS float* btab; const LAS int* sel; int g;
    __device__ __forceinline__ int kpos(int k) const { return sel[k >> 6] * 64 + (k & 63); }
    __device__ __forceinline__ bool valid(int k) const { return kpos(k) <= T; }
    __device__ __forceinline__ float bias(int k, int hh) const { int d = T - kpos(k); d = d > 113 ? 113 : d; return btab[d * 8 + g * 4 + hh]; }
    __device__ __forceinline__ const float* rowp(int k, int s) const { const int kp = kpos(k); if (kp >= T) return newrow + s * 128 + g * 64;
        const int phys = pt[kp >> 7]; return cache + ((size_t)(phys * 128 + (kp & 127)) * 4 + s) * 128 + g * 64; }
    __device__ __forceinline__ const float* kptr(int k) const { return rowp(k, 2); }
    __device__ __forceinline__ const float* vptr(int k) const { return rowp(k, 3); } };
struct SrcSampleWin { const float* cwin; const float* wns; const LAS float* btab; int g;
    __device__ __forceinline__ bool valid(int) const { return true; }
    __device__ __forceinline__ float bias(int k, int hh) const { int d = 511 - k; d = d > 113 ? 113 : d; return btab[d * 8 + g * 4 + hh]; }
    __device__ __forceinline__ const float* kptr(int k) const { return k < 511 ? cwin + (size_t)(k + 1) * 256 + g * 64 : wns + g * 64; }
    __device__ __forceinline__ const float* vptr(int k) const { return k < 511 ? cwin + (size_t)(k + 1) * 256 + 128 + g * 64 : wns + 128 + g * 64; } };

template <class Src, bool STASH>
__device__ __forceinline__ void attn_branch(const Src& S, int nkeys, LAS float* wscr, float& m, float& l, float (&o)[4], int lane) {
    const int kk = lane >> 2, hh = lane & 3;
    LAS float* pt = (LAS float*)((LAS unsigned char*)wscr + AW_PT); LAS float* sc = (LAS float*)((LAS unsigned char*)wscr + AW_SC);
    m = -1e30f; l = 0.f; o[0] = 0.f; o[1] = 0.f; o[2] = 0.f; o[3] = 0.f;
    for (int k0 = 0; k0 < nkeys; k0 += 16) {
        const int kidx = k0 + kk; const bool valid = kidx < nkeys && S.valid(kidx);
        float s = -1e30f;
        if (valid) { const f32x4* kr = (const f32x4*)S.kptr(kidx); const LAS f32x4* qv = (const LAS f32x4*)((LAS unsigned char*)wscr + AW_Q) + hh * 17; float d0 = 0.f, d1 = 0.f;
#pragma unroll 4
            for (int c = 0; c < 16; c += 2) { const f32x4 a = kr[c], b = kr[c + 1], qa = qv[c], qb = qv[c + 1];
                d0 += (a.x * qa.x + a.y * qa.y) + (a.z * qa.z + a.w * qa.w);
                d1 += (b.x * qb.x + b.y * qb.y) + (b.z * qb.z + b.w * qb.w); }
            s = (d0 + d1) * 0.125f + S.bias(kidx, hh); }
        if (STASH) sc[kidx * 4 + hh] = s;
        float mt = s; mt = fmaxf(mt, __shfl_xor(mt, 4)); mt = fmaxf(mt, __shfl_xor(mt, 8)); mt = fmaxf(mt, __shfl_xor(mt, 16)); mt = fmaxf(mt, __shfl_xor(mt, 32));
        const float mn = fmaxf(m, mt), alpha = __expf(m - mn), p = valid ? __expf(s - mn) : 0.f;
        float ps = p; ps += __shfl_xor(ps, 4); ps += __shfl_xor(ps, 8); ps += __shfl_xor(ps, 16); ps += __shfl_xor(ps, 32);
        l = l * alpha + ps; m = mn;
        pt[lane] = p;
        LDS_WAIT();
#pragma unroll
        for (int h = 0; h < 4; ++h) o[h] *= __shfl(alpha, h);
        const int nk = (nkeys - k0) < 16 ? (nkeys - k0) : 16;
        for (int j = 0; j < nk; ++j) { const f32x4 pj = *(const LAS f32x4*)(pt + j * 4);
            if (pj.x == 0.f && pj.y == 0.f && pj.z == 0.f && pj.w == 0.f) continue;
            const float v = S.vptr(k0 + j)[lane];
            o[0] += pj.x * v; o[1] += pj.y * v; o[2] += pj.z * v; o[3] += pj.w * v; }
        LDS_WAIT();
    }
}
template <bool EXP2 = false>
__device__ __forceinline__ void attn_importance(int nkeys, LAS float* wscr, float m, float l, int lane) {
    const int kk = lane >> 2, hh = lane & 3;
    const LAS float* sc = (const LAS float*)((LAS unsigned char*)wscr + AW_SC); LAS float* imp = (LAS float*)((LAS unsigned char*)wscr + AW_IMP);
    const float rl = l > 0.f ? 1.0f / l : 0.f;
    for (int k0 = 0; k0 < 512; k0 += 16) { const int kidx = k0 + kk;
        float p = (kidx < nkeys && l > 0.f) ? (EXP2 ? __builtin_amdgcn_exp2f(sc[kidx * 4 + hh] - m) : __expf(sc[kidx * 4 + hh] - m)) * rl : 0.f;
        p += __shfl_xor(p, 1); p += __shfl_xor(p, 2); p += __shfl_xor(p, 4);
        if ((lane & 7) == 0) imp[kidx >> 1] = p; }
    if (lane < 64) imp[256 + lane] = 0.f;
    LDS_WAIT();
}
__device__ __forceinline__ int attn_topk(int nsb, int cur, LAS float* wscr, int lane) {
    const LAS float* imp = (const LAS float*)((LAS unsigned char*)wscr + AW_IMP); LAS int* sel = (LAS int*)((LAS unsigned char*)wscr + AW_SEL);
    float v[5];
#pragma unroll
    for (int i = 0; i < 5; ++i) { const int sb = lane + 64 * i;
        v[i] = (sb >= nsb || sb > cur) ? -1.0f : ((sb == 0 || sb == cur || sb == cur - 1) ? 1.0e4f : imp[sb]); }
    int nsel = 0;
    for (int it = 0; it < 16; ++it) {
        float bv = v[0]; int bi = lane;
#pragma unroll
        for (int i = 1; i < 5; ++i) if (v[i] > bv) { bv = v[i]; bi = lane + 64 * i; }
#pragma unroll
        for (int off = 32; off >= 1; off >>= 1) { const float ov = __shfl_xor(bv, off); const int oi = __shfl_xor(bi, off);
            if (ov > bv || (ov == bv && oi < bi)) { bv = ov; bi = oi; } }
        if (bv < 0.f) break;
        if (lane == 0) sel[nsel] = bi;
        ++nsel;
#pragma unroll
        for (int i = 0; i < 5; ++i) if (bi == lane + 64 * i) v[i] = -2.0f;
    }
    LDS_WAIT();
    return nsel;
}
__device__ __forceinline__ void attn_accum(float (&of)[4], const float (&o)[4], float l, float gate_h_unused, const float* gates3, int j, int lane) {
#pragma unroll
    for (int h = 0; h < 4; ++h) { const float lh = __shfl(l, h); if (lh > 0.f) of[h] += gates3[h * 3 + j] * o[h] / lh; }
}
__device__ __forceinline__ void attn_prompt_item(Frame& F, const Args& A, int t, int g, LAS float* wscr, const LAS float* btab) {
    const int lane = LANE();
    {
        const f32x4 v = *((const f32x4*)(WSF(WS_QR) + (size_t)t * 512 + g * 256) + lane);
        *((LAS f32x4*)((LAS unsigned char*)wscr + AW_Q) + (lane >> 4) * 17 + (lane & 15)) = v; LDS_WAIT(); }
    const float* g3 = WSF(WS_GATE) + (size_t)t * 24 + g * 12;
    float of[4] = {0.f, 0.f, 0.f, 0.f}, o[4], m, l;
    const int nvis = (t + 1) >> 5, cur = t >> 6;
    {   SrcPromptCmp S{WSF(WS_KC), WSF(WS_VC), btab, t, g};
        attn_branch<SrcPromptCmp, true>(S, nvis, wscr, m, l, o, lane);
        attn_accum(of, o, l, 0.f, g3, 0, lane);
        attn_importance(nvis, wscr, m, l, lane); }
    const int nsel = attn_topk(256, cur, wscr, lane);
    {   SrcPromptSel S{F.out + O_KVP, btab, (const LAS int*)((LAS unsigned char*)wscr + AW_SEL), t, g};
        attn_branch<SrcPromptSel, false>(S, nsel * 64, wscr, m, l, o, lane);
        attn_accum(of, o, l, 0.f, g3, 1, lane); }
    {   SrcPromptWin S{WSF(WS_WINB), btab, t, g};
        attn_branch<SrcPromptWin, false>(S, 512, wscr, m, l, o, lane);
        attn_accum(of, o, l, 0.f, g3, 2, lane); }
    bf16* y = WSB(WS_YAB) + (size_t)t * D + 512 + g * 256 + lane;
#pragma unroll
    for (int h = 0; h < 4; ++h) y[h * 64] = (bf16)f2bf(of[h]);
}
__device__ __forceinline__ void attn_sample_item(Frame& F, const Args& A, int b, int g, LAS float* wscr, const LAS float* btab) {
    const int lane = LANE();
    {   const f32x4 v = *((const f32x4*)(SMP(SM_QS) + (size_t)b * 512 + g * 256) + lane);
        *((LAS f32x4*)((LAS unsigned char*)wscr + AW_Q) + (lane >> 4) * 17 + (lane & 15)) = v; LDS_WAIT(); }
    const float* g3 = SMP(SM_GATES) + b * 24 + g * 12;
    float of[4] = {0.f, 0.f, 0.f, 0.f}, o[4], m, l;
    {   SrcSampleCmp S{WSF(WS_KCS) + (size_t)b * 512 * 128, WSF(WS_VCS) + (size_t)b * 512 * 128, btab, g};
        attn_branch<SrcSampleCmp, true>(S, 512, wscr, m, l, o, lane);
        attn_accum(of, o, l, 0.f, g3, 0, lane);
        attn_importance(512, wscr, m, l, lane); }
    const int nsel = attn_topk(257, 256, wscr, lane);
    {   SrcSampleSel S{A.in[I_CKV], (const int*)A.in[I_PT] + b * NPG, F.out + O_KVS + (size_t)b * 512, btab, (const LAS int*)((LAS unsigned char*)wscr + AW_SEL), g};
        attn_branch<SrcSampleSel, false>(S, nsel * 64, wscr, m, l, o, lane);
        attn_accum(of, o, l, 0.f, g3, 1, lane); }
    {   SrcSampleWin S{A.in[I_CWIN] + (size_t)b * 512 * 256, SMP(SM_WNS) + (size_t)b * 256, btab, g};
        attn_branch<SrcSampleWin, false>(S, 512, wscr, m, l, o, lane);
        attn_accum(of, o, l, 0.f, g3, 2, lane); }
    float* y = SMP(SM_YABS) + (size_t)b * D + 512 + g * 256 + lane;
#pragma unroll
    for (int h = 0; h < 4; ++h) y[h * 64] = of[h];
}

typedef short bf16x8v __attribute__((ext_vector_type(8)));
__host__ __device__ __forceinline__ int vt_slot(int r) { const int rr = r & 31; return 32 * (r >> 5) + (rr < 16 ? 8 * (rr >> 2) + (rr & 3) : 8 * ((rr - 16) >> 2) + 4 + (rr & 3)); }
__device__ __forceinline__ void build_vt_block(const float* vsrc, int ldv, bf16* vt, int lane) {
    unsigned pk[32];
#pragma unroll
    for (int s2 = 0; s2 < 32; ++s2) {
        const int s0 = 2 * s2, i2 = s0 >> 5, q = (s0 & 31) >> 3, j = s0 & 7;
        const int r0 = 32 * i2 + (j < 4 ? 4 * q + j : 16 + 4 * q + (j - 4));
        const float a = vsrc[(size_t)r0 * ldv + lane], b = vsrc[(size_t)(r0 + 1) * ldv + lane];
        pk[s2] = pk2(a, b); }
#pragma unroll
    for (int i = 0; i < 8; ++i) *(v4u*)(vt + kv_off_v(32 * (i >> 2) + 8 * (i & 3), lane)) = (v4u){pk[4 * i], pk[4 * i + 1], pk[4 * i + 2], pk[4 * i + 3]};
}
#define MFMA16(a, b, c) __builtin_amdgcn_mfma_f32_16x16x32_bf16((a), (b), (c), 0, 0, 0)
struct KVFrag { bf16x8v kf[4][2]; bf16x8v vf[2][4]; };
#if KV_NT
#define KV_LD(p) __builtin_nontemporal_load(p)
#else
#define KV_LD(p) (*(p))
#endif
template <bool WITH_V>
__device__ __forceinline__ void kv_load(KVFrag& f, const bf16* KV, int b, int g, int lane) {
    const bf16* p = KV + (size_t)(b * 2 + g) * 8192 + lane * 8;
#pragma unroll
    for (int kt = 0; kt < 4; ++kt)
#pragma unroll
        for (int ks = 0; ks < 2; ++ks) f.kf[kt][ks] = KV_LD((const bf16x8v*)(p + (kt * 2 + ks) * 512));
    if (WITH_V) {
#pragma unroll
        for (int i2 = 0; i2 < 2; ++i2)
#pragma unroll
            for (int dt = 0; dt < 4; ++dt) f.vf[i2][dt] = KV_LD((const bf16x8v*)(p + 4096 + (i2 * 4 + dt) * 512)); }
}
template <int MODE, bool STASH>
__device__ __forceinline__ void mf_block(const KVFrag& f, int b, int t, int lo, int g, const bf16x8v (&qf)[2], const LAS float* btab2, LAS float* sc,
                                         float& l, f32x4 (&o)[4], int q4, int c) {
    const int hh = c & 3;
    f32x4 s[4];
#pragma unroll
    for (int kt = 0; kt < 4; ++kt) { s[kt] = MFMA16(f.kf[kt][0], qf[0], ((f32x4){0.f, 0.f, 0.f, 0.f})); s[kt] = MFMA16(f.kf[kt][1], qf[1], s[kt]); }
    const int kmax = b * 64 + 63, pmax = MODE == 0 ? 32 * kmax + 31 : kmax, pmin = MODE == 0 ? 32 * (b * 64) + 31 : b * 64;
    const bool far = (t - pmax >= 113) && (pmin > lo);
    if (far) { const float bb = btab2[113 * 8 + g * 4 + hh];
#pragma unroll
        for (int kt = 0; kt < 4; ++kt)
#pragma unroll
            for (int j = 0; j < 4; ++j) s[kt][j] = fminf(s[kt][j] + bb, 64.0f);
    } else {
#pragma unroll
        for (int kt = 0; kt < 4; ++kt)
#pragma unroll
            for (int j = 0; j < 4; ++j) { const int k = b * 64 + 16 * kt + 4 * q4 + j, pos = MODE == 0 ? 32 * k + 31 : k; const bool ok = pos <= t && pos > lo;
                int d = t - pos; d = d < 0 ? 0 : (d > 113 ? 113 : d);
                const float bias = btab2[d * 8 + g * 4 + hh];
                s[kt][j] = ok ? fminf(s[kt][j] + bias, 64.0f) : -1e30f; }
    }
    if (STASH) {
#pragma unroll
        for (int kt = 0; kt < 4; ++kt)
#pragma unroll
            for (int j = 0; j < 4; ++j) { if (c < 4) sc[(b * 64 + 16 * kt + 4 * q4 + j) * 4 + c] = s[kt][j]; }
    }
#pragma unroll
    for (int kt = 0; kt < 4; ++kt)
#pragma unroll
        for (int j = 0; j < 4; ++j) { const float p = __builtin_amdgcn_exp2f(s[kt][j]); s[kt][j] = p; l += p; }
    if (!STASH) {
        bf16x8v pf[2];
#pragma unroll
        for (int i2 = 0; i2 < 2; ++i2) { v4u w; w.x = pg8::cvt_pk_bf16(s[2 * i2][0], s[2 * i2][1]); w.y = pg8::cvt_pk_bf16(s[2 * i2][2], s[2 * i2][3]); w.z = pg8::cvt_pk_bf16(s[2 * i2 + 1][0], s[2 * i2 + 1][1]); w.w = pg8::cvt_pk_bf16(s[2 * i2 + 1][2], s[2 * i2 + 1][3]);
            pf[i2] = __builtin_bit_cast(bf16x8v, w); }
#pragma unroll
        for (int dt = 0; dt < 4; ++dt) { o[dt] = MFMA16(f.vf[0][dt], pf[0], o[dt]); o[dt] = MFMA16(f.vf[1][dt], pf[1], o[dt]); }
    }
}
template <int MODE, bool STASH>
__device__ __forceinline__ void mf_branch(const bf16* KV, int nblk, int b0, const LAS int* sel, int t, int lo, int g, const bf16x8v (&qf)[2],
                                          const LAS float* btab, LAS float* wscr, float& l, f32x4 (&o)[4], int lane) {
    const int q4 = lane >> 4, c = lane & 15;
    LAS float* sc = (LAS float*)((LAS unsigned char*)wscr + AW_SC);
    l = 0.f;
#pragma unroll
    for (int dt = 0; dt < 4; ++dt) o[dt] = (f32x4){0.f, 0.f, 0.f, 0.f};
#if HOTBLK
#define MF_BLK(i_) (MODE == 0 ? (i_) : (MODE == 1 ? (__builtin_amdgcn_readfirstlane(sel[(i_)]) & 1) : (b0 & 1) + ((i_) & 1)))
#else
#define MF_BLK(i_) (MODE == 0 ? (i_) : (MODE == 1 ? __builtin_amdgcn_readfirstlane(sel[(i_)]) : b0 + (i_)))
#endif
#if ATTN_DBUF
    if (!STASH) {
        KVFrag f0, f1;
        if (nblk > 0) kv_load<true>(f0, KV, MF_BLK(0), g, lane);
        for (int i = 0; i < nblk; i += 2) {
            const int bA = MF_BLK(i); const bool hasB = i + 1 < nblk; const int bB = hasB ? MF_BLK(i + 1) : bA;
            if (hasB) kv_load<true>(f1, KV, bB, g, lane);
            mf_block<MODE, STASH>(f0, bA, t, lo, g, qf, btab, sc, l, o, q4, c);
            if (hasB) { if (i + 2 < nblk) kv_load<true>(f0, KV, MF_BLK(i + 2), g, lane); mf_block<MODE, STASH>(f1, bB, t, lo, g, qf, btab, sc, l, o, q4, c); }
        }
    } else
#endif
    for (int i = 0; i < nblk; ++i) { const int bA = MF_BLK(i); KVFrag f0; kv_load<!STASH>(f0, KV, bA, g, lane); mf_block<MODE, STASH>(f0, bA, t, lo, g, qf, btab, sc, l, o, q4, c); }
#undef MF_BLK
    l += __shfl_xor(l, 16); l += __shfl_xor(l, 32);
}
__device__ __forceinline__ void mf_cmp_pv(const bf16* KV, int nblk, int g, const LAS float* wscr, f32x4 (&o)[4], int lane) {
    const int q4 = lane >> 4, c = lane & 15, hh = c & 3;
    const LAS float* sc = (const LAS float*)((const LAS unsigned char*)wscr + AW_SC);
    for (int b = 0; b < nblk; ++b) {
        const bf16* vp = KV + (size_t)(b * 2 + g) * 8192 + 4096 + lane * 8;
        bf16x8v vf[2][4];
#pragma unroll
        for (int i2 = 0; i2 < 2; ++i2)
#pragma unroll
            for (int dt = 0; dt < 4; ++dt) vf[i2][dt] = *(const bf16x8v*)(vp + (i2 * 4 + dt) * 512);
        float p[4][4];
#pragma unroll
        for (int kt = 0; kt < 4; ++kt)
#pragma unroll
            for (int j = 0; j < 4; ++j) p[kt][j] = __builtin_amdgcn_exp2f(sc[(b * 64 + 16 * kt + 4 * q4 + j) * 4 + hh]);
#pragma unroll
        for (int i2 = 0; i2 < 2; ++i2) { v4u w; w.x = pg8::cvt_pk_bf16(p[2 * i2][0], p[2 * i2][1]); w.y = pg8::cvt_pk_bf16(p[2 * i2][2], p[2 * i2][3]); w.z = pg8::cvt_pk_bf16(p[2 * i2 + 1][0], p[2 * i2 + 1][1]); w.w = pg8::cvt_pk_bf16(p[2 * i2 + 1][2], p[2 * i2 + 1][3]);
            const bf16x8v pf = __builtin_bit_cast(bf16x8v, w);
#pragma unroll
            for (int dt = 0; dt < 4; ++dt) o[dt] = MFMA16(vf[i2][dt], pf, o[dt]); }
    }
}
__device__ __forceinline__ int mf_select(int nkeys, int nsb, int cur, LAS float* wscr, float l, int lane, bool excl = false, int K = 16) {
    const LAS f32x4* sc4 = (const LAS f32x4*)((const LAS unsigned char*)wscr + AW_SC); LAS int* sel = (LAS int*)((LAS unsigned char*)wscr + AW_SEL);
    float rl[4];
#pragma unroll
    for (int h = 0; h < 4; ++h) { const float lh = __builtin_bit_cast(float, __builtin_amdgcn_readlane(__builtin_bit_cast(int, l), h)); rl[h] = lh > 0.f ? 1.0f / lh : 0.f; }
    int v[5];
#pragma unroll
    for (int i = 0; i < 5; ++i) { const int sb = lane + 64 * i; float imp = 0.f;
        if (i < 4) {
#pragma unroll
            for (int j = 0; j < 2; ++j) { const int k = 2 * sb + j; if (k < nkeys) { const f32x4 x = sc4[k];
                imp += __builtin_amdgcn_exp2f(x.x) * rl[0] + __builtin_amdgcn_exp2f(x.y) * rl[1] + __builtin_amdgcn_exp2f(x.z) * rl[2] + __builtin_amdgcn_exp2f(x.w) * rl[3]; } } }
        const float val = (sb >= nsb || sb > cur) ? -1.0f : ((sb == 0 || sb == cur || sb == cur - 1) ? (excl ? -1.0f : 1.0e4f) : imp);
        v[i] = __builtin_bit_cast(int, val); }
    int thr = 0;
#pragma unroll 1
    for (int bit = 30; bit >= 0; --bit) { const int tr = thr | (1 << bit); int cnt = 0;
#pragma unroll
        for (int i = 0; i < 5; ++i) cnt += __builtin_popcountll(__builtin_amdgcn_ballot_w64(v[i] >= tr));
        if (cnt >= K) thr = tr; }
    int n = 0;
    const unsigned lo_mask_lo = __builtin_amdgcn_mbcnt_lo(~0u, 0u);
    (void)lo_mask_lo;
#pragma unroll
    for (int pass = 0; pass < 2; ++pass)
#pragma unroll
        for (int i = 0; i < 5; ++i) { const bool pick = pass == 0 ? (v[i] > thr) : (v[i] == thr);
            const unsigned long long mk = __builtin_amdgcn_ballot_w64(pick);
            const int before = (int)__builtin_amdgcn_mbcnt_hi((unsigned)(mk >> 32), __builtin_amdgcn_mbcnt_lo((unsigned)mk, 0u));
            const int slot = n + before;
            if (pick && slot < K) sel[slot] = lane + 64 * i;
            n += __builtin_popcountll(mk); }
    LDS_WAIT();
    return n < K ? n : K;
}
__device__ __forceinline__ void attn_prompt_mfma(Frame& F, const Args& A, int t, int g, LAS float* wscr, const LAS float* btab, bf16* yab) {
    const int lane = LANE(), q4 = lane >> 4, c = lane & 15;
#if DBG_SECT >= 0
    LAS unsigned long long* tacc = (LAS unsigned long long*)((LAS unsigned char*)wscr + 16000); unsigned long long ts0 = __builtin_amdgcn_s_memrealtime(), ts1;
#define SECT(k) do { asm volatile("s_waitcnt vmcnt(0) lgkmcnt(0)" ::: "memory"); ts1 = __builtin_amdgcn_s_memrealtime(); if (lane == 0) tacc[k] += ts1 - ts0; ts0 = ts1; } while (0)
#else
#define SECT(k) do {} while (0)
#endif
    bf16x8v qf[2];
    {   const float* qp = WSF(WS_QR) + (size_t)t * 512 + (g * 4 + (c & 3)) * 64 + 8 * q4;
#pragma unroll
        for (int ks = 0; ks < 2; ++ks) { const f32x4 a = *(const f32x4*)(qp + 32 * ks), b = *(const f32x4*)(qp + 32 * ks + 4);
            v4u w; const float qs = 0.125f * 1.4426950408889634f; w.x = pk2(a.x * qs, a.y * qs); w.y = pk2(a.z * qs, a.w * qs); w.z = pk2(b.x * qs, b.y * qs); w.w = pk2(b.z * qs, b.w * qs);
            if (c >= 4) w = (v4u){0u, 0u, 0u, 0u};
            qf[ks] = __builtin_bit_cast(bf16x8v, w); } }
    SECT(0);
    const float* g3 = WSF(WS_GATE) + (size_t)t * 24 + (g * 4 + (c & 3)) * 3;
    f32x4 of[4], o[4]; float l;
#pragma unroll
    for (int dt = 0; dt < 4; ++dt) of[dt] = (f32x4){0.f, 0.f, 0.f, 0.f};
    const int nvis = (t + 1) >> 5, cur = t >> 6; float lcmp = 0.f;
    {
        const int nb = (nvis + 63) >> 6;
        mf_branch<0, true>(WSB(WS_KVC), nb, 0, nullptr, t, -1, g, qf, btab + 114 * 8, wscr, l, o, lane);
        LDS_WAIT();
        mf_cmp_pv(WSB(WS_KVC), nb, g, wscr, o, lane);
        lcmp = l;
        if (l > 0.f) { const float sc_ = g3[0] / l;
#pragma unroll
            for (int dt = 0; dt < 4; ++dt) of[dt] += o[dt] * sc_; }
    }
    SECT(1);
    const int nsel = mf_select(nvis, 256, cur, wscr, lcmp, lane);
    SECT(2);
    {   mf_branch<1, false>(WSB(WS_KVS), nsel, 0, (const LAS int*)((LAS unsigned char*)wscr + AW_SEL), t, -1, g, qf, btab + 114 * 8, wscr, l, o, lane);
        if (l > 0.f) { const float sc_ = g3[1] / l;
#pragma unroll
            for (int dt = 0; dt < 4; ++dt) of[dt] += o[dt] * sc_; } }
    SECT(3);
    {   const int bl = (t - 511) < 0 ? 0 : (t - 511) >> 6;
        mf_branch<2, false>(WSB(WS_KVW), cur - bl + 1, bl, nullptr, t, t - 512, g, qf, btab + 114 * 8, wscr, l, o, lane);
        if (l > 0.f) { const float sc_ = g3[2] / l;
#pragma unroll
            for (int dt = 0; dt < 4; ++dt) of[dt] += o[dt] * sc_; } }
    SECT(4);
    if (c < 4) { bf16* y = yab + (size_t)t * D + 512 + (g * 4 + c) * 64 + 4 * q4;
#pragma unroll
        for (int dt = 0; dt < 4; ++dt) *(v2u*)(y + 16 * dt) = (v2u){pk2(of[dt][0], of[dt][1]), pk2(of[dt][2], of[dt][3])}; }
    SECT(5);
#undef SECT
}

template <int MODE, bool STASH>
__device__ __forceinline__ void mfx_block(const KVFrag& f, int b, int tl, bool act, int tmin, int tmax, int g, const bf16x8v (&qf)[2], const LAS float* btab2, LAS float* sc,
                                          float& l, f32x4 (&o)[4], int q4, int c) {
    const int hh = c & 3;
    f32x4 s[4];
#pragma unroll
    for (int kt = 0; kt < 4; ++kt) { s[kt] = MFMA16(f.kf[kt][0], qf[0], ((f32x4){0.f, 0.f, 0.f, 0.f})); s[kt] = MFMA16(f.kf[kt][1], qf[1], s[kt]); }
    const int kmax = b * 64 + 63, pmax = MODE == 0 ? 32 * kmax + 31 : kmax, pmin = MODE == 0 ? 32 * (b * 64) + 31 : b * 64;
    const bool far = (tmin - pmax >= 113) && (MODE != 2 || pmin > tmax - 512);
    if (far) { const float bb = act ? btab2[113 * 8 + g * 4 + hh] : -1e30f;
#pragma unroll
        for (int kt = 0; kt < 4; ++kt)
#pragma unroll
            for (int j = 0; j < 4; ++j) s[kt][j] = fminf(s[kt][j] + bb, 64.0f);
    } else { const int lo = MODE == 2 ? tl - 512 : -1;
#pragma unroll
        for (int kt = 0; kt < 4; ++kt)
#pragma unroll
            for (int j = 0; j < 4; ++j) { const int k = b * 64 + 16 * kt + 4 * q4 + j, pos = MODE == 0 ? 32 * k + 31 : k; const bool ok = act && pos <= tl && pos > lo;
                int d = tl - pos; d = d < 0 ? 0 : (d > 113 ? 113 : d);
                const float bias = btab2[d * 8 + g * 4 + hh];
                s[kt][j] = ok ? fminf(s[kt][j] + bias, 64.0f) : -1e30f; }
    }
    if (STASH) {
#pragma unroll
        for (int kt = 0; kt < 4; ++kt)
#pragma unroll
            for (int j = 0; j < 4; ++j) { if (act) sc[(b * 64 + 16 * kt + 4 * q4 + j) * 4 + hh] = s[kt][j]; }
    }
#pragma unroll
    for (int kt = 0; kt < 4; ++kt)
#pragma unroll
        for (int j = 0; j < 4; ++j) { const float p = __builtin_amdgcn_exp2f(s[kt][j]); s[kt][j] = p; l += p; }
    if (!STASH) {
        bf16x8v pf[2];
#pragma unroll
        for (int i2 = 0; i2 < 2; ++i2) { v4u w; w.x = pg8::cvt_pk_bf16(s[2 * i2][0], s[2 * i2][1]); w.y = pg8::cvt_pk_bf16(s[2 * i2][2], s[2 * i2][3]); w.z = pg8::cvt_pk_bf16(s[2 * i2 + 1][0], s[2 * i2 + 1][1]); w.w = pg8::cvt_pk_bf16(s[2 * i2 + 1][2], s[2 * i2 + 1][3]);
            pf[i2] = __builtin_bit_cast(bf16x8v, w); }
#pragma unroll
        for (int dt = 0; dt < 4; ++dt) { o[dt] = MFMA16(f.vf[0][dt], pf[0], o[dt]); o[dt] = MFMA16(f.vf[1][dt], pf[1], o[dt]); }
    }
}
template <int MODE>
__device__ __forceinline__ void mfx_scores(const KVFrag& f, int b, int tl, bool act, int tmin, int tmax, int g, const bf16x8v (&qf)[2], const LAS float* btab2, int q4, int c, f32x4 (&s)[4]) {
    const int hh = c & 3;
#pragma unroll
    for (int kt = 0; kt < 4; ++kt) { s[kt] = MFMA16(f.kf[kt][0], qf[0], ((f32x4){0.f, 0.f, 0.f, 0.f})); s[kt] = MFMA16(f.kf[kt][1], qf[1], s[kt]); }
    const int kmax = b * 64 + 63, pmax = MODE == 0 ? 32 * kmax + 31 : kmax, pmin = MODE == 0 ? 32 * (b * 64) + 31 : b * 64;
    const bool far = (tmin - pmax >= 113) && (MODE != 2 || pmin > tmax - 512);
    if (far) { const float bb = act ? btab2[113 * 8 + g * 4 + hh] : -1e30f;
#pragma unroll
        for (int kt = 0; kt < 4; ++kt)
#pragma unroll
            for (int j = 0; j < 4; ++j) s[kt][j] = fminf(s[kt][j] + bb, 64.0f);
    } else { const int lo = MODE == 2 ? tl - 512 : -1;
#pragma unroll
        for (int kt = 0; kt < 4; ++kt)
#pragma unroll
            for (int j = 0; j < 4; ++j) { const int k = b * 64 + 16 * kt + 4 * q4 + j, pos = MODE == 0 ? 32 * k + 31 : k; const bool ok = act && pos <= tl && pos > lo;
                int d = tl - pos; d = d < 0 ? 0 : (d > 113 ? 113 : d);
                const float bias = btab2[d * 8 + g * 4 + hh];
                s[kt][j] = ok ? fminf(s[kt][j] + bias, 64.0f) : -1e30f; }
    }
}
__device__ __forceinline__ float dpp_xor1(float v) { return __builtin_bit_cast(float, __builtin_amdgcn_update_dpp(0, __builtin_bit_cast(int, v), 0xB1, 0xF, 0xF, true)); }
__device__ __forceinline__ float dpp_xor2(float v) { return __builtin_bit_cast(float, __builtin_amdgcn_update_dpp(0, __builtin_bit_cast(int, v), 0x4E, 0xF, 0xF, true)); }
__device__ __forceinline__ int mfx_cmp_pack(const bf16* KV, int t0, int tl, int g, const bf16x8v (&qf)[2], const LAS float* btab2, LAS float* impq, float& l, f32x4 (&o)[4], int lane) {
    const int q4 = lane >> 4, c = lane & 15, qc = c >> 2;
    const int nb = ((((t0 + 4) >> 5)) + 63) >> 6;
    l = 0.f;
#pragma unroll
    for (int dt = 0; dt < 4; ++dt) o[dt] = (f32x4){0.f, 0.f, 0.f, 0.f};
    for (int b = 0; b < nb; ++b) { KVFrag f; kv_load<false>(f, KV, b, g, lane); f32x4 s[4]; mfx_scores<0>(f, b, tl, true, t0, t0 + 3, g, qf, btab2, q4, c, s);
#pragma unroll
        for (int kt = 0; kt < 4; ++kt)
#pragma unroll
            for (int j = 0; j < 4; ++j) l += __builtin_amdgcn_exp2f(s[kt][j]); }
    l += __shfl_xor(l, 16); l += __shfl_xor(l, 32);
    const float rl = l > 0.f ? 1.0f / l : 0.f;
    for (int b = 0; b < nb; ++b) { KVFrag f; kv_load<true>(f, KV, b, g, lane); f32x4 s[4]; mfx_scores<0>(f, b, tl, true, t0, t0 + 3, g, qf, btab2, q4, c, s);
#pragma unroll
        for (int kt = 0; kt < 4; ++kt)
#pragma unroll
            for (int j = 0; j < 4; ++j) s[kt][j] = __builtin_amdgcn_exp2f(s[kt][j]);
#pragma unroll
        for (int kt = 0; kt < 4; ++kt)
#pragma unroll
            for (int jp = 0; jp < 2; ++jp) { float v = (s[kt][2 * jp] + s[kt][2 * jp + 1]) * rl; v += dpp_xor1(v); v += dpp_xor2(v);
                if ((c & 3) == 0) impq[qc * 256 + b * 32 + 8 * kt + 2 * q4 + jp] = v; }
        bf16x8v pf[2];
#pragma unroll
        for (int i2 = 0; i2 < 2; ++i2) { v4u w; w.x = pg8::cvt_pk_bf16(s[2 * i2][0], s[2 * i2][1]); w.y = pg8::cvt_pk_bf16(s[2 * i2][2], s[2 * i2][3]); w.z = pg8::cvt_pk_bf16(s[2 * i2 + 1][0], s[2 * i2 + 1][1]); w.w = pg8::cvt_pk_bf16(s[2 * i2 + 1][2], s[2 * i2 + 1][3]);
            pf[i2] = __builtin_bit_cast(bf16x8v, w); }
#pragma unroll
        for (int dt = 0; dt < 4; ++dt) { o[dt] = MFMA16(f.vf[0][dt], pf[0], o[dt]); o[dt] = MFMA16(f.vf[1][dt], pf[1], o[dt]); }
    }
    LDS_WAIT();
    return nb * 32;
}
__device__ __forceinline__ int mf_select_lds(const LAS float* imp, int nsbw, int nsb, int cur, LAS float* wscr, int lane, bool excl, int K) {
    LAS int* sel = (LAS int*)((LAS unsigned char*)wscr + AW_SEL);
    int v[5];
#pragma unroll
    for (int i = 0; i < 5; ++i) { const int sb = lane + 64 * i; const float im = (i < 4 && sb < nsbw) ? imp[sb] : 0.f;
        const float val = (sb >= nsb || sb > cur) ? -1.0f : ((sb == 0 || sb == cur || sb == cur - 1) ? (excl ? -1.0f : 1.0e4f) : im);
        v[i] = __builtin_bit_cast(int, val); }
    int thr = 0;
#pragma unroll 1
    for (int bit = 30; bit >= 0; --bit) { const int tr = thr | (1 << bit); int cnt = 0;
#pragma unroll
        for (int i = 0; i < 5; ++i) cnt += __builtin_popcountll(__builtin_amdgcn_ballot_w64(v[i] >= tr));
        if (cnt >= K) thr = tr; }
    int n = 0;
#pragma unroll
    for (int pass = 0; pass < 2; ++pass)
#pragma unroll
        for (int i = 0; i < 5; ++i) { const bool pick = pass == 0 ? (v[i] > thr) : (v[i] == thr);
            const unsigned long long mk = __builtin_amdgcn_ballot_w64(pick);
            const int before = (int)__builtin_amdgcn_mbcnt_hi((unsigned)(mk >> 32), __builtin_amdgcn_mbcnt_lo((unsigned)mk, 0u));
            const int slot = n + before;
            if (pick && slot < K) sel[slot] = lane + 64 * i;
            n += __builtin_popcountll(mk); }
    LDS_WAIT();
    return n < K ? n : K;
}
#if SEL_FP8
struct KVFrag8 { v4u k[4]; bf16x8v vf[2][4]; };
__device__ __forceinline__ void kv_load8(KVFrag8& f, const bf16* KV, int b, int g, int lane) {
    const unsigned char* p8 = (const unsigned char*)(KV + (size_t)(b * 2 + g) * 8192) + lane * 16;
#pragma unroll
    for (int kt = 0; kt < 4; ++kt) f.k[kt] = *(const v4u*)(p8 + kt * 1024);
    const bf16* p = KV + (size_t)(b * 2 + g) * 8192 + lane * 8;
#pragma unroll
    for (int i2 = 0; i2 < 2; ++i2)
#pragma unroll
        for (int dt = 0; dt < 4; ++dt) f.vf[i2][dt] = *(const bf16x8v*)(p + 4096 + (i2 * 4 + dt) * 512);
}
__device__ __forceinline__ void mfx_block8(const KVFrag8& f, int b, int tl, bool act, int tmin, int g, const long (&q8)[2], const LAS float* btab2, float& l, f32x4 (&o)[4], int q4, int c) {
    const int hh = c & 3; const float qs = 0.125f * 1.4426950408889634f;
    f32x4 s[4];
#pragma unroll
    for (int kt = 0; kt < 4; ++kt) { const long k0 = (long)(((unsigned long long)f.k[kt].y << 32) | f.k[kt].x), k1 = (long)(((unsigned long long)f.k[kt].w << 32) | f.k[kt].z);
        s[kt] = __builtin_amdgcn_mfma_f32_16x16x32_fp8_fp8(k0, q8[0], ((f32x4){0.f, 0.f, 0.f, 0.f}), 0, 0, 0); s[kt] = __builtin_amdgcn_mfma_f32_16x16x32_fp8_fp8(k1, q8[1], s[kt], 0, 0, 0); }
    const int pmax = b * 64 + 63;
    const bool far = (tmin - pmax >= 113);
    if (far) { const float bb = act ? btab2[113 * 8 + g * 4 + hh] : -1e30f;
#pragma unroll
        for (int kt = 0; kt < 4; ++kt)
#pragma unroll
            for (int j = 0; j < 4; ++j) s[kt][j] = fminf(s[kt][j] * qs + bb, 64.0f);
    } else {
#pragma unroll
        for (int kt = 0; kt < 4; ++kt)
#pragma unroll
            for (int j = 0; j < 4; ++j) { const int pos = b * 64 + 16 * kt + 4 * q4 + j; const bool ok = act && pos <= tl;
                int d = tl - pos; d = d < 0 ? 0 : (d > 113 ? 113 : d);
                const float bias = btab2[d * 8 + g * 4 + hh];
                s[kt][j] = ok ? fminf(s[kt][j] * qs + bias, 64.0f) : -1e30f; }
    }
#pragma unroll
    for (int kt = 0; kt < 4; ++kt)
#pragma unroll
        for (int j = 0; j < 4; ++j) { const float p = __builtin_amdgcn_exp2f(s[kt][j]); s[kt][j] = p; l += p; }
    bf16x8v pf[2];
#pragma unroll
    for (int i2 = 0; i2 < 2; ++i2) { v4u w; w.x = pg8::cvt_pk_bf16(s[2 * i2][0], s[2 * i2][1]); w.y = pg8::cvt_pk_bf16(s[2 * i2][2], s[2 * i2][3]); w.z = pg8::cvt_pk_bf16(s[2 * i2 + 1][0], s[2 * i2 + 1][1]); w.w = pg8::cvt_pk_bf16(s[2 * i2 + 1][2], s[2 * i2 + 1][3]);
        pf[i2] = __builtin_bit_cast(bf16x8v, w); }
#pragma unroll
    for (int dt = 0; dt < 4; ++dt) { o[dt] = MFMA16(f.vf[0][dt], pf[0], o[dt]); o[dt] = MFMA16(f.vf[1][dt], pf[1], o[dt]); }
}
#endif
template <int MODE, bool STASH, bool ACCUM = false>
__device__ __forceinline__ void mfx_branch(const bf16* KV, int nblk, int b0, const LAS int* sel, int tl, bool act, int tmin, int tmax, int g, const bf16x8v (&qf)[2],
                                           const LAS float* btab2, LAS float* wscr, float& l, f32x4 (&o)[4], int lane) {
    const int q4 = lane >> 4, c = lane & 15;
    LAS float* sc = (LAS float*)((LAS unsigned char*)wscr + AW_SC);
    if (!ACCUM) { l = 0.f;
#pragma unroll
        for (int dt = 0; dt < 4; ++dt) o[dt] = (f32x4){0.f, 0.f, 0.f, 0.f}; }
    for (int i = 0; i < nblk; ++i) { const int bA = MODE == 0 ? i : (MODE == 1 ? __builtin_amdgcn_readfirstlane(sel[i]) : b0 + i);
        KVFrag f0; kv_load<!STASH>(f0, KV, bA, g, lane); mfx_block<MODE, STASH>(f0, bA, tl, act, tmin, tmax, g, qf, btab2, sc, l, o, q4, c); }
    if (!ACCUM) { l += __shfl_xor(l, 16); l += __shfl_xor(l, 32); }
}
__device__ __forceinline__ void mfx_cmp_pv(const bf16* KV, int nblk, int g, const LAS float* wscr, bool act, f32x4 (&o)[4], int lane) {
    const int q4 = lane >> 4, c = lane & 15, hh = c & 3;
    const LAS float* sc = (const LAS float*)((const LAS unsigned char*)wscr + AW_SC);
    for (int b = 0; b < nblk; ++b) {
        const bf16* vp = KV + (size_t)(b * 2 + g) * 8192 + 4096 + lane * 8;
        bf16x8v vf[2][4];
#pragma unroll
        for (int i2 = 0; i2 < 2; ++i2)
#pragma unroll
            for (int dt = 0; dt < 4; ++dt) vf[i2][dt] = *(const bf16x8v*)(vp + (i2 * 4 + dt) * 512);
        float p[4][4];
#pragma unroll
        for (int kt = 0; kt < 4; ++kt)
#pragma unroll
            for (int j = 0; j < 4; ++j) { const float e = __builtin_amdgcn_exp2f(sc[(b * 64 + 16 * kt + 4 * q4 + j) * 4 + hh]); p[kt][j] = act ? e : 0.f; }
#pragma unroll
        for (int i2 = 0; i2 < 2; ++i2) { v4u w; w.x = pg8::cvt_pk_bf16(p[2 * i2][0], p[2 * i2][1]); w.y = pg8::cvt_pk_bf16(p[2 * i2][2], p[2 * i2][3]); w.z = pg8::cvt_pk_bf16(p[2 * i2 + 1][0], p[2 * i2 + 1][1]); w.w = pg8::cvt_pk_bf16(p[2 * i2 + 1][2], p[2 * i2 + 1][3]);
            const bf16x8v pf = __builtin_bit_cast(bf16x8v, w);
#pragma unroll
            for (int dt = 0; dt < 4; ++dt) o[dt] = MFMA16(vf[i2][dt], pf, o[dt]); }
    }
}
__device__ __forceinline__ void attn_prompt_pack(Frame& F, const Args& A, int t0, int g, LAS float* wscr, const LAS float* btab, bf16* yab) {
    const int lane = LANE(), q4 = lane >> 4, c = lane & 15, qc = c >> 2, tl = t0 + qc;
    const LAS float* btab2 = btab + 114 * 8;
    bf16x8v qf16[2];
    {   const float* qp = WSF(WS_QR) + (size_t)tl * 512 + (g * 4 + (c & 3)) * 64 + 8 * q4; const float qs = 0.125f * 1.4426950408889634f;
#pragma unroll
        for (int ks = 0; ks < 2; ++ks) { const f32x4 a = *(const f32x4*)(qp + 32 * ks), b = *(const f32x4*)(qp + 32 * ks + 4);
            v4u w; w.x = pk2(a.x * qs, a.y * qs); w.y = pk2(a.z * qs, a.w * qs); w.z = pk2(b.x * qs, b.y * qs); w.w = pk2(b.z * qs, b.w * qs);
            qf16[ks] = __builtin_bit_cast(bf16x8v, w); } }
#if SEL_FP8
    long q8[2];
    {   const float* qp = WSF(WS_QR) + (size_t)tl * 512 + (g * 4 + (c & 3)) * 64 + 8 * q4;
#pragma unroll
        for (int ks = 0; ks < 2; ++ks) { const f32x4 a = *(const f32x4*)(qp + 32 * ks), b = *(const f32x4*)(qp + 32 * ks + 4);
            int w0 = __builtin_amdgcn_cvt_pk_fp8_f32(a.x, a.y, 0, false); w0 = __builtin_amdgcn_cvt_pk_fp8_f32(a.z, a.w, w0, true);
            int w1 = __builtin_amdgcn_cvt_pk_fp8_f32(b.x, b.y, 0, false); w1 = __builtin_amdgcn_cvt_pk_fp8_f32(b.z, b.w, w1, true);
            q8[ks] = (long)(((unsigned long long)(unsigned)w1 << 32) | (unsigned)w0); } }
#endif
    const float* g3 = WSF(WS_GATE) + (size_t)tl * 24 + (g * 4 + (c & 3)) * 3;
    f32x4 of[4], o[4]; float l;
#pragma unroll
    for (int dt = 0; dt < 4; ++dt) of[dt] = (f32x4){0.f, 0.f, 0.f, 0.f};
    {
        const int bl = (t0 - 511) < 0 ? 0 : (t0 - 511) >> 6, bh = (t0 + 3) >> 6;
        mfx_branch<2, false>(WSB(WS_KVW), bh - bl + 1, bl, nullptr, tl, true, t0, t0 + 3, g, qf16, btab2, wscr, l, o, lane);
        if (l > 0.f) { const float sc_ = g3[2] / l;
#pragma unroll
            for (int dt = 0; dt < 4; ++dt) of[dt] += o[dt] * sc_; } }
    f32x4 os[4]; float ls = 0.f;
#pragma unroll
    for (int dt = 0; dt < 4; ++dt) os[dt] = (f32x4){0.f, 0.f, 0.f, 0.f};
    const int cur0 = t0 >> 6; const bool uni = cur0 == ((t0 + 3) >> 6); const int nf = uni ? (cur0 >= 2 ? 3 : cur0 + 1) : 0;
    for (int i = 0; i < nf; ++i) { const int b = i == 0 ? 0 : cur0 - (nf - 1 - i);
#if SEL_FP8
        KVFrag8 f; kv_load8(f, WSB(WS_KVS), b, g, lane); mfx_block8(f, b, tl, true, t0, g, q8, btab2, ls, os, q4, c); }
#else
        KVFrag f; kv_load<true>(f, WSB(WS_KVS), b, g, lane); mfx_block<1, false>(f, b, tl, true, t0, t0 + 3, g, qf16, btab2, nullptr, ls, os, q4, c); }
#endif
    LAS float* impq = (LAS float*)((LAS unsigned char*)wscr + AW_SC);
    const int nsbw = mfx_cmp_pack(WSB(WS_KVC), t0, tl, g, qf16, btab2, impq, l, o, lane);
    if (l > 0.f) { const float sc_ = g3[0] / l;
#pragma unroll
        for (int dt = 0; dt < 4; ++dt) of[dt] += o[dt] * sc_; }
#pragma unroll 1
    for (int qi = 0; qi < 4; ++qi) {
        const int t = t0 + qi, cur = t >> 6; const bool act = qc == qi;
        const int nsel = mf_select_lds(impq + qi * 256, nsbw, 256, cur, wscr, lane, uni, 16 - nf);
#if SEL_FP8
        {   const LAS int* sel = (const LAS int*)((LAS unsigned char*)wscr + AW_SEL);
            for (int i = 0; i < nsel; ++i) { const int bA = __builtin_amdgcn_readfirstlane(sel[i]); KVFrag8 f; kv_load8(f, WSB(WS_KVS), bA, g, lane); mfx_block8(f, bA, t, act, t, g, q8, btab2, ls, os, q4, c); } }
#else
        mfx_branch<1, false, true>(WSB(WS_KVS), nsel, 0, (const LAS int*)((LAS unsigned char*)wscr + AW_SEL), t, act, t, t, g, qf16, btab2, wscr, ls, os, lane);
#endif
        LDS_WAIT();
    }
    ls += __shfl_xor(ls, 16); ls += __shfl_xor(ls, 32);
    if (ls > 0.f) { const float sc_ = g3[1] / ls;
#pragma unroll
        for (int dt = 0; dt < 4; ++dt) of[dt] += os[dt] * sc_; }
    {   bf16* y = yab + (size_t)tl * D + 512 + (g * 4 + (c & 3)) * 64 + 4 * q4;
#pragma unroll
        for (int dt = 0; dt < 4; ++dt) *(v2u*)(y + 16 * dt) = (v2u){pk2(of[dt][0], of[dt][1]), pk2(of[dt][2], of[dt][3])}; }
}

template <bool SAMPLE>
__device__ __forceinline__ void cmp_mfma(Frame& F, const Args& A, int b, int pgp, float* kcs, float* vcs, int ks0 = 0, int ks1 = 64, LAS float* part = nullptr, int nparts = 1) {
    const int lane = LANE(), q4 = lane >> 4, r = lane & 15, pg2 = r >> 3, jj = (r >> 1) & 3, g = r & 1;
    const float* rowbase;
    if (SAMPLE) { const int phys = ((const int*)A.in[I_PT])[b * NPG + 2 * pgp + pg2]; rowbase = A.in[I_CKV] + ((size_t)(phys * 128 + 32 * jj) * 4) * 128 + g * 64 + 8 * q4; }
    else rowbase = F.out + O_KVP + (size_t)(32 * (8 * pgp + (r >> 1))) * 512 + g * 64 + 8 * q4;
    const bf16* wk = WSB(WS_WCT) + (size_t)r * 2048 + 8 * q4;
    const float* pek = A.in[I_PEK] + 8 * q4; const float* pev = A.in[I_PEV] + 8 * q4;
    f32x4 acc[2][4];
#pragma unroll
    for (int kv = 0; kv < 2; ++kv)
#pragma unroll
        for (int nt = 0; nt < 4; ++nt) acc[kv][nt] = (f32x4){0.f, 0.f, 0.f, 0.f};
#pragma unroll 2
    for (int ks = ks0; ks < ks1; ++ks) {
        const int i = ks >> 1, co = (ks & 1) * 32;
        const float* ap = rowbase + (size_t)i * 512 + co;
        const f32x4 k0 = *(const f32x4*)ap, k1 = *(const f32x4*)(ap + 4), v0 = *(const f32x4*)(ap + 128), v1 = *(const f32x4*)(ap + 132);
        const f32x4 pk0 = *(const f32x4*)(pek + i * 64 + co), pk1 = *(const f32x4*)(pek + i * 64 + co + 4), pv0 = *(const f32x4*)(pev + i * 64 + co), pv1 = *(const f32x4*)(pev + i * 64 + co + 4);
        bf16x8v bk[4], bv[4];
#pragma unroll
        for (int nt = 0; nt < 4; ++nt) { bk[nt] = *(const bf16x8v*)(wk + (size_t)nt * 16 * 2048 + ks * 32); bv[nt] = *(const bf16x8v*)(wk + (size_t)(64 + nt * 16) * 2048 + ks * 32); }
        const f32x4 a0 = k0 + pk0, a1 = k1 + pk1, c0 = v0 + pv0, c1 = v1 + pv1;
        const bf16x8v ak = __builtin_bit_cast(bf16x8v, ((v4u){pk2(a0.x, a0.y), pk2(a0.z, a0.w), pk2(a1.x, a1.y), pk2(a1.z, a1.w)}));
        const bf16x8v av = __builtin_bit_cast(bf16x8v, ((v4u){pk2(c0.x, c0.y), pk2(c0.z, c0.w), pk2(c1.x, c1.y), pk2(c1.z, c1.w)}));
#pragma unroll
        for (int nt = 0; nt < 4; ++nt) { acc[0][nt] = MFMA16(ak, bk[nt], acc[0][nt]); acc[1][nt] = MFMA16(av, bv[nt], acc[1][nt]); }
    }
    if (nparts > 1) {
        const int slot = ks0 / (ks1 - ks0);
        if (slot != 0) {
#pragma unroll
            for (int kv = 0; kv < 2; ++kv)
#pragma unroll
                for (int nt = 0; nt < 4; ++nt) *(LAS f32x4*)(part + ((slot - 1) * 8 + kv * 4 + nt) * 256 + lane * 4) = acc[kv][nt];
        }
        asm volatile("s_waitcnt vmcnt(0) lgkmcnt(0)" ::: "memory"); __syncthreads(); asm volatile("" ::: "memory");
        if (slot == 0)
        for (int sl = 0; sl < nparts - 1; ++sl)
#pragma unroll
            for (int kv = 0; kv < 2; ++kv)
#pragma unroll
                for (int nt = 0; nt < 4; ++nt) acc[kv][nt] += *(const LAS f32x4*)(part + (sl * 8 + kv * 4 + nt) * 256 + lane * 4);
    }
    if (nparts == 1 || ks0 == 0)
#pragma unroll
    for (int rg = 0; rg < 4; ++rg) { const int ro = 4 * q4 + rg, j = SAMPLE ? 4 * (2 * pgp + (ro >> 3)) + ((ro >> 1) & 3) : 8 * pgp + (ro >> 1), gg = ro & 1;
        float ss = 0.f;
#pragma unroll
        for (int nt = 0; nt < 4; ++nt) ss += acc[0][nt][rg] * acc[0][nt][rg];
        ss += __shfl_xor(ss, 1); ss += __shfl_xor(ss, 2); ss += __shfl_xor(ss, 4); ss += __shfl_xor(ss, 8);
        const float rstd = 1.0f / sqrtf(ss * (1.0f / 64.0f) + EPS);
        const size_t off = ((size_t)(b * 512 + j) * 2 + gg) * 64 + r;
#pragma unroll
        for (int nt = 0; nt < 4; ++nt) { const float kcv = acc[0][nt][rg] * rstd * A.in[I_KG][16 * nt + r], vcv = acc[1][nt][rg];
            kcs[off + 16 * nt] = kcv; vcs[off + 16 * nt] = vcv;
            bf16* tile = SAMPLE ? WSB(WS_KVCS) + (size_t)((b * 8 + (j >> 6)) * 2 + gg) * 8192 : WSB(WS_KVC) + (size_t)((j >> 6) * 2 + gg) * 8192;
            tile[kv_off_k(j & 63, 16 * nt + r)] = (bf16)f2bf(kcv); tile[kv_off_v(vt_slot(j & 63), 16 * nt + r)] = (bf16)f2bf(vcv); } }
}

__device__ __forceinline__ void cmp_sample2(Frame& F, const Args& A, int b, int pq, float* kcs, float* vcs, LAS float* wscr) {
    const int lane = LANE(), q4 = lane >> 4, r = lane & 15, pg2 = r >> 3, jj = (r >> 1) & 3, g = r & 1;
    {   f32x4 t[16];
#pragma unroll
        for (int j = 0; j < 8; ++j) { t[j] = ((const f32x4*)A.in[I_PEK])[lane + 64 * j]; t[8 + j] = ((const f32x4*)A.in[I_PEV])[lane + 64 * j]; }
#pragma unroll
        for (int j = 0; j < 16; ++j) *(LAS f32x4*)(wscr + (size_t)(lane + 64 * j) * 4) = t[j]; }
    LDS_WAIT();
    const float* rb0; const float* rb1;
    {   const int ph0 = ((const int*)A.in[I_PT])[b * NPG + 4 * pq + pg2], ph1 = ((const int*)A.in[I_PT])[b * NPG + 4 * pq + 2 + pg2];
        rb0 = A.in[I_CKV] + ((size_t)(ph0 * 128 + 32 * jj) * 4) * 128 + g * 64 + 8 * q4; rb1 = A.in[I_CKV] + ((size_t)(ph1 * 128 + 32 * jj) * 4) * 128 + g * 64 + 8 * q4; }
    const bf16* wk = WSB(WS_WCT) + (size_t)r * 2048 + 8 * q4;
    const LAS float* pel = wscr + 8 * q4;
    f32x4 acc[2][2][4];
#pragma unroll
    for (int s = 0; s < 2; ++s)
#pragma unroll
        for (int kv = 0; kv < 2; ++kv)
#pragma unroll
            for (int nt = 0; nt < 4; ++nt) acc[s][kv][nt] = (f32x4){0.f, 0.f, 0.f, 0.f};
#pragma unroll 2
    for (int ks = 0; ks < 64; ++ks) {
        const int i = ks >> 1, co = (ks & 1) * 32;
        const float* ap0 = rb0 + (size_t)i * 512 + co; const float* ap1 = rb1 + (size_t)i * 512 + co;
        const f32x4 k00 = *(const f32x4*)ap0, k01 = *(const f32x4*)(ap0 + 4), v00 = *(const f32x4*)(ap0 + 128), v01 = *(const f32x4*)(ap0 + 132);
        const f32x4 k10 = *(const f32x4*)ap1, k11 = *(const f32x4*)(ap1 + 4), v10 = *(const f32x4*)(ap1 + 128), v11 = *(const f32x4*)(ap1 + 132);
        bf16x8v bk[4], bv[4];
#pragma unroll
        for (int nt = 0; nt < 4; ++nt) { bk[nt] = *(const bf16x8v*)(wk + (size_t)nt * 16 * 2048 + ks * 32); bv[nt] = *(const bf16x8v*)(wk + (size_t)(64 + nt * 16) * 2048 + ks * 32); }
        const f32x4 pk0 = *(const LAS f32x4*)(pel + i * 64 + co), pk1 = *(const LAS f32x4*)(pel + i * 64 + co + 4), pv0 = *(const LAS f32x4*)(pel + 2048 + i * 64 + co), pv1 = *(const LAS f32x4*)(pel + 2048 + i * 64 + co + 4);
        f32x4 a0 = k00 + pk0, a1 = k01 + pk1, c0 = v00 + pv0, c1 = v01 + pv1;
        const bf16x8v ak0 = __builtin_bit_cast(bf16x8v, ((v4u){pk2(a0.x, a0.y), pk2(a0.z, a0.w), pk2(a1.x, a1.y), pk2(a1.z, a1.w)}));
        const bf16x8v av0 = __builtin_bit_cast(bf16x8v, ((v4u){pk2(c0.x, c0.y), pk2(c0.z, c0.w), pk2(c1.x, c1.y), pk2(c1.z, c1.w)}));
        a0 = k10 + pk0; a1 = k11 + pk1; c0 = v10 + pv0; c1 = v11 + pv1;
        const bf16x8v ak1 = __builtin_bit_cast(bf16x8v, ((v4u){pk2(a0.x, a0.y), pk2(a0.z, a0.w), pk2(a1.x, a1.y), pk2(a1.z, a1.w)}));
        const bf16x8v av1 = __builtin_bit_cast(bf16x8v, ((v4u){pk2(c0.x, c0.y), pk2(c0.z, c0.w), pk2(c1.x, c1.y), pk2(c1.z, c1.w)}));
#pragma unroll
        for (int nt = 0; nt < 4; ++nt) { acc[0][0][nt] = MFMA16(ak0, bk[nt], acc[0][0][nt]); acc[0][1][nt] = MFMA16(av0, bv[nt], acc[0][1][nt]);
                                         acc[1][0][nt] = MFMA16(ak1, bk[nt], acc[1][0][nt]); acc[1][1][nt] = MFMA16(av1, bv[nt], acc[1][1][nt]); }
    }
#pragma unroll
    for (int s = 0; s < 2; ++s) { const int pgp = 2 * pq + s;
#pragma unroll
    for (int rg = 0; rg < 4; ++rg) { const int ro = 4 * q4 + rg, j = 4 * (2 * pgp + (ro >> 3)) + ((ro >> 1) & 3), gg = ro & 1;
        float ss = 0.f;
#pragma unroll
        for (int nt = 0; nt < 4; ++nt) ss += acc[s][0][nt][rg] * acc[s][0][nt][rg];
        ss += __shfl_xor(ss, 1); ss += __shfl_xor(ss, 2); ss += __shfl_xor(ss, 4); ss += __shfl_xor(ss, 8);
        const float rstd = 1.0f / sqrtf(ss * (1.0f / 64.0f) + EPS);
        const size_t off = ((size_t)(b * 512 + j) * 2 + gg) * 64 + r;
#pragma unroll
        for (int nt = 0; nt < 4; ++nt) { const float kcv = acc[s][0][nt][rg] * rstd * A.in[I_KG][16 * nt + r], vcv = acc[s][1][nt][rg];
            kcs[off + 16 * nt] = kcv; vcs[off + 16 * nt] = vcv;
            bf16* tile = WSB(WS_KVCS) + (size_t)((b * 8 + (j >> 6)) * 2 + gg) * 8192;
            tile[kv_off_k(j & 63, 16 * nt + r)] = (bf16)f2bf(kcv); tile[kv_off_v(vt_slot(j & 63), 16 * nt + r)] = (bf16)f2bf(vcv); } } }
    LDS_WAIT();
}
__device__ __forceinline__ void build_win_sample(Frame& F, const Args& A, int b, int blk) {
    const int lane = LANE();
#pragma unroll 8
    for (int r = 0; r < 64; r += 2) { const int rr = r + (lane >> 5), kidx = blk * 64 + rr, l = lane & 31;
        const float* src = kidx < 511 ? A.in[I_CWIN] + ((size_t)b * 512 + kidx + 1) * 256 : SMP(SM_WNS) + (size_t)b * 256;
        const f32x4 v = *(const f32x4*)(src + l * 4);
        *(v2u*)(WSB(WS_KVWS) + (size_t)((b * 8 + blk) * 2 + (l >> 4)) * 8192 + kv_off_k(rr, 4 * (l & 15))) = (v2u){pk2(v.x, v.y), pk2(v.z, v.w)}; }
#pragma unroll 1
    for (int g = 0; g < 2; ++g) {
        unsigned pk[32];
#pragma unroll
        for (int s2 = 0; s2 < 32; ++s2) { const int s0 = 2 * s2, i2 = s0 >> 5, q = (s0 & 31) >> 3, j = s0 & 7; const int r0 = 32 * i2 + (j < 4 ? 4 * q + j : 16 + 4 * q + (j - 4));
            const int k0 = blk * 64 + r0, k1 = k0 + 1;
            const float* p0 = k0 < 511 ? A.in[I_CWIN] + ((size_t)b * 512 + k0 + 1) * 256 : SMP(SM_WNS) + (size_t)b * 256;
            const float* p1 = k1 < 511 ? A.in[I_CWIN] + ((size_t)b * 512 + k1 + 1) * 256 : SMP(SM_WNS) + (size_t)b * 256;
            pk[s2] = pk2(p0[128 + g * 64 + lane], p1[128 + g * 64 + lane]); }
        bf16* tile = WSB(WS_KVWS) + (size_t)((b * 8 + blk) * 2 + g) * 8192;
#pragma unroll
        for (int i = 0; i < 8; ++i) *(v4u*)(tile + kv_off_v(32 * (i >> 2) + 8 * (i & 3), lane)) = (v4u){pk[4 * i], pk[4 * i + 1], pk[4 * i + 2], pk[4 * i + 3]};
    }
}
__device__ __forceinline__ void attn_sample_mfma(Frame& F, const Args& A, int b, int g, LAS float* wscr, const LAS float* btab, float* yabs) {
    const int lane = LANE(), q4 = lane >> 4, c = lane & 15;
    bf16x8v qf[2];
    {   const float* qp = SMP(SM_QS) + (size_t)b * 512 + (g * 4 + (c & 3)) * 64 + 8 * q4;
#pragma unroll
        for (int ks = 0; ks < 2; ++ks) { const f32x4 a = *(const f32x4*)(qp + 32 * ks), bq = *(const f32x4*)(qp + 32 * ks + 4);
            v4u w; const float qs = 0.125f * 1.4426950408889634f; w.x = pk2(a.x * qs, a.y * qs); w.y = pk2(a.z * qs, a.w * qs); w.z = pk2(bq.x * qs, bq.y * qs); w.w = pk2(bq.z * qs, bq.w * qs);
            if (c >= 4) w = (v4u){0u, 0u, 0u, 0u};
            qf[ks] = __builtin_bit_cast(bf16x8v, w); } }
    const float* g3 = SMP(SM_GATES) + b * 24 + (g * 4 + (c & 3)) * 3;
    f32x4 of[4], o[4]; float l, lcmp = 0.f;
#pragma unroll
    for (int dt = 0; dt < 4; ++dt) of[dt] = (f32x4){0.f, 0.f, 0.f, 0.f};
    {   mf_branch<0, true>(WSB(WS_KVCS) + (size_t)b * 8 * 2 * 8192, 8, 0, nullptr, T, -1, g, qf, btab + 114 * 8, wscr, l, o, lane);
        LDS_WAIT();
        mf_cmp_pv(WSB(WS_KVCS) + (size_t)b * 8 * 2 * 8192, 8, g, wscr, o, lane);
        lcmp = l;
        if (l > 0.f) { const float sc_ = g3[0] / l;
#pragma unroll
            for (int dt = 0; dt < 4; ++dt) of[dt] += o[dt] * sc_; }
    }
    const int nsel = mf_select(512, 257, 256, wscr, lcmp, lane);
    {
        const LAS int* sel = (const LAS int*)((LAS unsigned char*)wscr + AW_SEL); LAS bf16* vt = (LAS bf16*)((LAS unsigned char*)wscr + AW_SC);
        const int* pt = (const int*)A.in[I_PT] + b * NPG;
        LAS f32x4* park = (LAS f32x4*)((LAS unsigned char*)wscr + 11264) + lane * 4;
#pragma unroll
        for (int dt = 0; dt < 4; ++dt) park[dt] = of[dt];
        l = 0.f;
#pragma unroll
        for (int dt = 0; dt < 4; ++dt) o[dt] = (f32x4){0.f, 0.f, 0.f, 0.f};
        for (int n = 0; n < nsel; ++n) {
            const int blk = __builtin_amdgcn_readfirstlane(sel[n]);
            KVFrag f;
            if (blk < 256) {
                const int phys = pt[blk >> 1]; const float* base = A.in[I_CKV] + ((size_t)(phys * 128 + (blk & 1) * 64) * 4 + 2) * 128 + g * 64;
                f32x4 ka[4][2][2], va[16];
#pragma unroll
                for (int kt = 0; kt < 4; ++kt)
#pragma unroll
                    for (int ks = 0; ks < 2; ++ks) { const float* kp = base + (size_t)(16 * kt + c) * 512 + 32 * ks + 8 * q4; ka[kt][ks][0] = *(const f32x4*)kp; ka[kt][ks][1] = *(const f32x4*)(kp + 4); }
#pragma unroll
                for (int i = 0; i < 16; ++i) va[i] = *(const f32x4*)(base + 128 + (size_t)(q4 + 4 * i) * 512 + 4 * c);
#pragma unroll
                for (int kt = 0; kt < 4; ++kt)
#pragma unroll
                    for (int ks = 0; ks < 2; ++ks) { const f32x4 x = ka[kt][ks][0], y = ka[kt][ks][1];
                        f.kf[kt][ks] = __builtin_bit_cast(bf16x8v, ((v4u){pk2(x.x, x.y), pk2(x.z, x.w), pk2(y.x, y.y), pk2(y.z, y.w)})); }
                LDS_WAIT();
#pragma unroll
                for (int i = 0; i < 16; ++i) { const int sl = vt_slot(q4 + 4 * i);
                    vt[(4 * c + 0) * 64 + sl] = (bf16)f2bf(va[i].x); vt[(4 * c + 1) * 64 + sl] = (bf16)f2bf(va[i].y); vt[(4 * c + 2) * 64 + sl] = (bf16)f2bf(va[i].z); vt[(4 * c + 3) * 64 + sl] = (bf16)f2bf(va[i].w); }
            } else {
                const float* nr = F.out + O_KVS + (size_t)b * 512 + 256 + g * 64;
#pragma unroll
                for (int kt = 0; kt < 4; ++kt)
#pragma unroll
                    for (int ks = 0; ks < 2; ++ks) { v4u w = (v4u){0u, 0u, 0u, 0u};
                        if (kt == 0 && c == 0) { const f32x4 x = *(const f32x4*)(nr + 32 * ks + 8 * q4), y = *(const f32x4*)(nr + 32 * ks + 8 * q4 + 4); w = (v4u){pk2(x.x, x.y), pk2(x.z, x.w), pk2(y.x, y.y), pk2(y.z, y.w)}; }
                        f.kf[kt][ks] = __builtin_bit_cast(bf16x8v, w); }
                LDS_WAIT();
                for (int i = lane; i < 64 * 32; i += 64) ((LAS unsigned*)vt)[i] = 0u;
                LDS_WAIT();
                vt[lane * 64 + vt_slot(0)] = (bf16)f2bf(nr[128 + lane]);
            }
            LDS_WAIT();
#pragma unroll
            for (int i2 = 0; i2 < 2; ++i2)
#pragma unroll
                for (int dt = 0; dt < 4; ++dt) f.vf[i2][dt] = *(const LAS bf16x8v*)(vt + (16 * dt + c) * 64 + 32 * i2 + 8 * q4);
            mf_block<1, false>(f, blk, T, -1, g, qf, btab + 114 * 8, nullptr, l, o, q4, c);
        }
        l += __shfl_xor(l, 16); l += __shfl_xor(l, 32);
        LDS_WAIT();
#pragma unroll
        for (int dt = 0; dt < 4; ++dt) of[dt] = park[dt];
        if (l > 0.f) { const float sc_ = g3[1] / l;
#pragma unroll
            for (int dt = 0; dt < 4; ++dt) of[dt] += o[dt] * sc_; } }
    {   mf_branch<2, false>(WSB(WS_KVWS) + (size_t)b * 8 * 2 * 8192, 8, 0, nullptr, 511, -1, g, qf, btab + 114 * 8, wscr, l, o, lane);
        if (l > 0.f) { const float sc_ = g3[2] / l;
#pragma unroll
            for (int dt = 0; dt < 4; ++dt) of[dt] += o[dt] * sc_; } }
    if (c < 4) { float* y = yabs + (size_t)b * D + 512 + (g * 4 + c) * 64 + 4 * q4; bf16* yb = SMB(SB_YABS) + (size_t)b * D + 512 + (g * 4 + c) * 64 + 4 * q4;
#pragma unroll
        for (int dt = 0; dt < 4; ++dt) { *(f32x4*)(y + 16 * dt) = of[dt]; if (yabs == SMP(SM_YABS)) *(v2u*)(yb + 16 * dt) = (v2u){pk2(of[dt][0], of[dt][1]), pk2(of[dt][2], of[dt][3])}; } }
}

__device__ __forceinline__ void p0_prologue(Frame& F, const Args& A) {
    LAS float* scr = (LAS float*)(F.lds + RING_OFF + F.wave * 16384);
    const int gw = F.vcu * NWAVES + F.wave, NGW = F.G * NWAVES, lane = LANE();
    constexpr int I_IN0 = 16 * 73, I_SQ = 16 * 32, I_UP = 16 * 128, I_DN = 64 * 32, I_PJ = 4 * 32, I_IN1 = 16 * 64;
    constexpr int I_CW = 32 * 2;
    constexpr int NITEMS = I_IN0 + I_SQ + 2 * I_UP + 2 * I_DN + 2 * I_SQ + 2 * I_PJ + I_IN1 + I_SQ + 2 * I_CW;
    for (int it = gw; it < NITEMS; it += NGW) {
        int r = it;
        if (r < I_IN0) { transpose_item(A.in[I_WINE], D, EIN, A.in[I_GMIX], WSB(WS_WIN0), scr, r, lane, true); continue; } r -= I_IN0;
        if (r < I_SQ) { transpose_item(A.in[I_WOUTE], D, D, nullptr, WSB(WS_WOUT0), scr, r, lane); continue; } r -= I_SQ;
        if (r < I_UP) { transpose_item(A.in[I_WUP], D, FF, A.in[I_GMLP], WSB(WS_WUP), scr, r, lane); continue; } r -= I_UP;
        if (r < I_UP) { transpose_item(A.in[I_WUP] + (size_t)D * FF, D, FF, A.in[I_GMLP] + D, WSB(WS_WUP) + (size_t)D * FF, scr, r, lane); continue; } r -= I_UP;
        if (r < I_DN) { transpose_item(A.in[I_WDOWN], FF, D, nullptr, WSB(WS_WDOWN), scr, r, lane); continue; } r -= I_DN;
        if (r < I_DN) { transpose_item(A.in[I_WDOWN] + (size_t)D * FF, FF, D, nullptr, WSB(WS_WDOWN) + (size_t)D * FF, scr, r, lane); continue; } r -= I_DN;
        if (r < I_SQ) { transpose_item(A.in[I_WPG], D, D, A.in[I_GPLE], WSB(WS_WGATE), scr, r, lane); continue; } r -= I_SQ;
        if (r < I_SQ) { transpose_item(A.in[I_WPG] + (size_t)D * D, D, D, A.in[I_GPLE] + D, WSB(WS_WGATE) + (size_t)D * D, scr, r, lane); continue; } r -= I_SQ;
        if (r < I_PJ) { transpose_item(A.in[I_WPP], PLE, D, nullptr, WSB(WS_WPROJ), scr, r, lane); continue; } r -= I_PJ;
        if (r < I_PJ) { transpose_item(A.in[I_WPP] + (size_t)PLE * D, PLE, D, nullptr, WSB(WS_WPROJ) + (size_t)PLE * D, scr, r, lane); continue; } r -= I_PJ;
        if (r < I_IN1) { transpose_item(A.in[I_WINO], D, 2 * D, A.in[I_GMIX] + D, WSB(WS_WIN1), scr, r, lane); continue; } r -= I_IN1;
        if (r < I_SQ) { transpose_item(A.in[I_WOUTO], D, D, nullptr, WSB(WS_WOUT1), scr, r, lane); continue; } r -= I_SQ;
        if (r < I_CW) { transpose_item(A.in[I_CWK], 2048, 64, nullptr, WSB(WS_WCT), scr, r, lane); continue; } r -= I_CW;
        transpose_item(A.in[I_CWV], 2048, 64, nullptr, WSB(WS_WCT) + (size_t)64 * 2048, scr, r, lane);
    }
    {
        v4u* z = (v4u*)(WSB(WS_WIN0) + (size_t)2336 * D); const int n16 = (EINP - 2336) * D * 2 / 16;
        for (int i = gw * 64 + lane; i < n16; i += NGW * 64) z[i] = (v4u){0u, 0u, 0u, 0u};
    }
    for (int m = 4 * gw; m < T; m += 4 * NGW) x_row4_to_bf16(lane, A.in[I_XP] + (size_t)m * D, WSB(WS_HBA) + (size_t)m * D, WSF(WS_RSA) + (size_t)m * 16);
    for (int m = 8 * gw; m < 2 * T; m += 8 * NGW) { f32x4 v[8];
#pragma unroll
        for (int i = 0; i < 8; ++i) v[i] = *((const f32x4*)(A.in[I_PP] + (size_t)(m + i) * PLE) + lane);
#pragma unroll
        for (int i = 0; i < 8; ++i) *((v2u*)(WSB(WS_PB) + (size_t)(m + i) * PLE) + lane) = (v2u){pk2(v[i].x, v[i].y), pk2(v[i].z, v[i].w)}; }
    for (int i = gw * 64 + lane; i < 8 * 128 * 128 / 4; i += NGW * 64) { const f32x4 v = ((const f32x4*)A.in[I_SGW])[i]; const int tt = (i >> 5) & 127, s0 = (i & 31) * 4;
        ((v2u*)WSB(WS_SGWB))[i] = (v2u){pk2(s0 <= tt ? v.x : 0.f, s0 + 1 <= tt ? v.y : 0.f), pk2(s0 + 2 <= tt ? v.z : 0.f, s0 + 3 <= tt ? v.w : 0.f)}; }
    for (int i = gw * 64 + lane; i < 2 * NS * PLE / 4; i += NGW * 64) { const f32x4 v = ((const f32x4*)A.in[I_PS])[i]; ((v2u*)SMB(SB_PS))[i] = (v2u){pk2(v.x, v.y), pk2(v.z, v.w)}; }
#if DBG_ZERO_OUT
    for (size_t i = (size_t)gw * 64 + lane; i < O_END / 4; i += (size_t)NGW * 64) ((f32x4*)F.out)[i] = (f32x4){0.f, 0.f, 0.f, 0.f};
#endif
    {
        LAS float* red = (LAS float*)(F.lds + RING_OFF); LAS float* rs = (LAS float*)(F.lds + RING_OFF + 16384);
        __syncthreads();
        sample_rstd(F, A.in[I_XS], rs);
        for (int ct = F.vcu; ct < (EIN + 15) / 16; ct += F.G) {
            const float s = sgemm16_f32w(F, A.in[I_XS], A.in[I_GMIX], A.in[I_WINE], EIN, ct, red);
            const int tid = TID(), r = SG_ROW(tid), n = 16 * ct + SG_COL(tid); if (n < EIN) SMP(SM_ZS)[(size_t)r * EIN + n] = s * rs[r];
        }
    }
}


__device__ __forceinline__ void sgu_item(Frame& F, const Args& A, int c, int g) {
    LAS bf16* vt = (LAS bf16*)(F.lds + RING_OFF);
    const int lane = LANE(), tid = TID();
    for (int idx = tid; idx < 128 * 32; idx += NWAVES * 64) { const int r = idx >> 5, q4 = (idx & 31) * 4; const size_t row = (size_t)c * 128 + r;
        const f32x4* lp = (const f32x4*)(WSF(WS_LNS) + row * 32); float s1 = 0.f, s2 = 0.f;
#pragma unroll
        for (int j = 0; j < 8; ++j) { const f32x4 x = lp[j]; s1 += x.x + x.z; s2 += x.y + x.w; }
        const float mu = s1 * (1.0f / 1024.0f), var = s2 * (1.0f / 1024.0f) - mu * mu, rstd = 1.0f / sqrtf(var + EPS);
        const int col = g * 128 + q4; const pg8::u32x2 vw = *(const pg8::u32x2*)(WSB(WS_V1) + row * D + col); const f32x4 v = {__uint_as_float(vw.x << 16), __uint_as_float(vw.x & 0xffff0000u), __uint_as_float(vw.y << 16), __uint_as_float(vw.y & 0xffff0000u)}, lg = *(const f32x4*)(A.in[I_LNG] + col), lb = *(const f32x4*)(A.in[I_LNB] + col);
        const f32x4 y = (v - mu) * rstd * lg + lb;
        vt[(q4 + 0) * 136 + r] = (bf16)f2bf(y.x); vt[(q4 + 1) * 136 + r] = (bf16)f2bf(y.y); vt[(q4 + 2) * 136 + r] = (bf16)f2bf(y.z); vt[(q4 + 3) * 136 + r] = (bf16)f2bf(y.w); }
    LDS_WAIT(); __syncthreads();
    const int r16 = lane & 15, q = lane >> 4, w = F.wave, nks = ((16 * w + 15) >> 5) + 1;
    const bf16* wp = WSB(WS_SGWB) + ((size_t)g * 128 + 16 * w + r16) * 128 + 8 * q;
    f32x4 acc[8];
#pragma unroll
    for (int nt = 0; nt < 8; ++nt) acc[nt] = (f32x4){0.f, 0.f, 0.f, 0.f};
    for (int ks = 0; ks < nks; ++ks) { const bf16x8s af = *(const bf16x8s*)(wp + 32 * ks);
#pragma unroll
        for (int nt = 0; nt < 8; ++nt) { const bf16x8s bfr = *(const LAS bf16x8s*)(vt + (16 * nt + r16) * 136 + 32 * ks + 8 * q); acc[nt] = __builtin_amdgcn_mfma_f32_16x16x32_bf16(af, bfr, acc[nt], 0, 0, 0); } }
#pragma unroll
    for (int rg = 0; rg < 4; ++rg) { const int t = 16 * w + 4 * q + rg; const float bb = A.in[I_SGB][g * 128 + t]; const size_t off = ((size_t)c * 128 + t) * D + g * 128 + r16;
#pragma unroll
        for (int nt = 0; nt < 8; ++nt) { const float u = __builtin_bit_cast(float, (unsigned)WSB(WS_U1)[off + 16 * nt] << 16); WSB(WS_YAB)[off + 16 * nt] = (bf16)f2bf(u * (acc[nt][rg] + bb)); } }
    __syncthreads();
}
__device__ __forceinline__ void sgu_sample(Frame& F, const Args& A, int b) {
    const int lane = LANE(); const float* v = SMP(SM_V1S) + (size_t)b * D; const float* u = SMP(SM_U1S) + (size_t)b * D;
    f32x4 x[4]; float s = 0.f;
#pragma unroll
    for (int j = 0; j < 4; ++j) { x[j] = *((const f32x4*)v + lane + 64 * j); s += pg8::sum4(x[j]); }
    const float mu = wave_sum(s) * (1.0f / D); float s2 = 0.f;
#pragma unroll
    for (int j = 0; j < 4; ++j) { x[j] = x[j] - mu; s2 += pg8::dot4(x[j]); }
    const float rstd = 1.0f / sqrtf(wave_sum(s2) * (1.0f / D) + EPS);
#pragma unroll
    for (int j = 0; j < 4; ++j) { const int col = (lane + 64 * j) * 4, g = col >> 7;
        const f32x4 vn = x[j] * rstd * *(const f32x4*)(A.in[I_LNG] + col) + *(const f32x4*)(A.in[I_LNB] + col);
        *(f32x4*)(F.out + O_VS + (size_t)b * D + col) = vn;
        const float w00 = A.in[I_SGW][(size_t)g * 128 * 128], b0 = A.in[I_SGB][g * 128];
        const f32x4 us = *(const f32x4*)(u + col) * (vn * w00 + b0);
        *(f32x4*)(SMP(SM_USS) + (size_t)b * D + col) = us; *(v2u*)(SMB(SB_USS) + (size_t)b * D + col) = (v2u){pk2(us.x, us.y), pk2(us.z, us.w)}; }
}

__global__ void __launch_bounds__(NWAVES * 64, 2) mega_fwd(Args args) {
    extern __shared__ __attribute__((aligned(16))) unsigned char lds[];
    Frame F;
    F.lds = (LAS unsigned char*)lds;
    F.MISC = (volatile LAS unsigned*)(F.lds + MISC_OFF);
    F.wave = __builtin_amdgcn_readfirstlane((int)threadIdx.x >> 6);
    F.G = gridDim.x; { const int bx = blockIdx.x; F.vcu = (F.G % 8 == 0) ? (bx % 8) * (F.G / 8) + bx / 8 : bx; }
    F.out = args.out; F.ws = args.ws;
    F.ctl = (gu32*)(args.ws + WS_CTL);
    for (int u = TID(); u < (LDS_BYTES - LDSCTL_OFF) / 4; u += NWAVES * 64) ((LAS unsigned*)(F.lds + LDSCTL_OFF))[u] = 0u;
    __syncthreads();
    XcdBarrier bar = xcd_barrier_post((unsigned*)(F.ctl + CW_BAR), F.MISC + 8);
    const int lo = args.ph_lo, hi = args.ph_hi;
#ifndef PHASE_MASK
#define PHASE_MASK 0xffffffffu
#endif
#define IN(k) (((PHASE_MASK >> (k)) & 1u) && lo <= (k) && (k) < hi)
#define BOTH(k) (IN(k) && IN((k) + 1))
#define GRID_BAR() xcd_barrier(bar)
    const int gw = F.vcu * NWAVES + F.wave, NGW = F.G * NWAVES;
#if DBG_TIME_PHASE >= 0
    unsigned long long ts_a = 0, ts_b = 0;
#define STAMP(k) do { if ((k) == DBG_TIME_PHASE) ts_a = __builtin_amdgcn_s_memrealtime(); if ((k) == DBG_TIME_PHASE + 1) ts_b = __builtin_amdgcn_s_memrealtime(); } while (0)
#else
#define STAMP(k) do {} while (0)
#endif
    STAMP(0);

    if (IN(0)) { p0_prologue(F, args); if (BOTH(0)) GRID_BAR(); }
    STAMP(1);

    if (IN(1)) {
        {
        const bool light = (F.G == 256) ? ((int)blockIdx.x >= 128) : true; const int lw = (F.G == 256) ? ((int)blockIdx.x - 128) * NWAVES + F.wave : gw, NLW = (F.G == 256) ? 128 * NWAVES : NGW;
        if (light && lw < NS) sample_post(F, args, lw);
        if (light)
        for (int it = lw * 4; it < NS * 511; it += NLW * 4) { f32x4 v[4];
#pragma unroll
            for (int i = 0; i < 4; ++i) { const int q = it + i < NS * 511 ? it + i : NS * 511 - 1, b = q / 511, r = q % 511; v[i] = *((const f32x4*)(args.in[I_CWIN] + ((size_t)b * 512 + r + 1) * 256) + LANE()); }
#pragma unroll
            for (int i = 0; i < 4; ++i) { const int q = it + i < NS * 511 ? it + i : NS * 511 - 1, b = q / 511, r = q % 511; *((f32x4*)(F.out + O_WINS + ((size_t)b * 512 + r) * 256) + LANE()) = v[i]; } }
        }
        if (F.G == 256 ? (int)blockIdx.x >= 128 : true) {
            LAS float* red1 = (LAS float*)(F.lds + RING_OFF); const int j0 = (F.G == 256) ? (int)blockIdx.x - 128 : (int)blockIdx.x, jn = (F.G == 256) ? 128 : F.G;
            for (int j = j0; j < 2 * (D / 16); j += jn) { const int l = j >> 6, ct = j & 63;
                const float s = sgemm16(F, SMB(SB_PS) + (size_t)l * NS * PLE, PLE, WSB(WS_WPROJ) + (size_t)l * PLE * D, ct, red1);
                const int tid = TID(), r = SG_ROW(tid), n = 16 * ct + SG_COL(tid); SMP(SM_PPS)[(l * NS + r) * D + n] = s; }
        }
        pg8::Gemm g{WSB(WS_HBA), WSB(WS_WIN0), T, EINP, D}; pg8::StaticOrder S; S.init(T, EINP, F.G, (int)blockIdx.x);
        pg8::EpiIn0 E{WSF(WS_RSA), WSF(WS_XA), WSB(WS_GG), WSF(WS_QR), F.out + O_KVP, WSF(WS_WINB), WSF(WS_GATE), args.in[I_QG], args.in[I_KG], WSB(WS_KVS), WSB(WS_KVW), F.out + O_WINP, F.out + O_CONVP, T};
        pg8::gemm_phase<pg8::EpiIn0, pg8::StaticOrder, PG8_ALIGN, PG8_SP2>(F.lds + RING_OFF, g, S, E, F.wave);
        if (F.G == 256 ? (int)blockIdx.x >= 128 : true) {
            __syncthreads();
            pg8::Gemm g2{WSB(WS_PB), WSB(WS_WPROJ), T, D, PLE}; pg8::StaticOrder S2;
            if (F.G == 256) S2.init(T, D, 128, (int)blockIdx.x - 128); else S2.init(T, D, F.G, (int)blockIdx.x);
            pg8::EpiProj E2{WSB(WS_PP)};
            pg8::gemm_phase<pg8::EpiProj, pg8::StaticOrder, PG8_ALIGN, PG8_SP2>(F.lds + RING_OFF, g2, S2, E2, F.wave);
        }
        if (BOTH(1)) GRID_BAR();
    }
    STAMP(2);

    const LAS float* btab = (const LAS float*)(F.lds + BTAB_OFF);
    {   for (int i = TID(); i < 114 * 8; i += NWAVES * 64) { const int n = i >> 3;
            int bk = n; if (n >= 16) { bk = 16 + (n >= 19) + (n >= 21) + (n >= 24) + (n >= 27) + (n >= 31) + (n >= 35) + (n >= 40) + (n >= 46) + (n >= 52) + (n >= 59) + (n >= 67) + (n >= 77) + (n >= 87) + (n >= 99) + (n >= 113); }
            const float bv = args.in[I_RELB][bk * 8 + (i & 7)]; ((LAS float*)(F.lds + BTAB_OFF))[i] = bv; ((LAS float*)(F.lds + BTAB_OFF))[114 * 8 + i] = bv * 1.4426950408889634f; }
        LDS_WAIT(); __syncthreads(); }
    LAS float* red = (LAS float*)(F.lds + RING_OFF); LAS float* rsl = (LAS float*)(F.lds + RING_OFF + 16384);

    if (IN(2)) {
        LAS float* wscr = (LAS float*)(F.lds + RING_OFF + F.wave * 16384);
#if DBG_SECT2 >= 0
        unsigned long long t2a = __builtin_amdgcn_s_memrealtime(), t2b; float t2v = 0.f;
#define SECT2(k) do { asm volatile("s_waitcnt vmcnt(0) lgkmcnt(0)" ::: "memory"); t2b = __builtin_amdgcn_s_memrealtime(); if ((k) == DBG_SECT2) t2v = (float)(t2b - t2a); t2a = t2b; } while (0)
#else
#define SECT2(k) do {} while (0)
#endif
#if CMPP_IMPL == 0
        for (int it = gw; it < 256; it += NGW) cmp_prompt_item(F, args, it >> 1, it & 1, wscr);
#elif CMPP_IMPL == 1
#if CMPP_SPLIT
        for (int it = F.vcu; it < 32; it += F.G) { cmp_mfma<false>(F, args, 0, 2 * it + (F.wave >> 2), WSF(WS_KC), WSF(WS_VC), (F.wave & 3) * 16, (F.wave & 3) * 16 + 16, (LAS float*)(F.lds + RING_OFF) + (F.wave >> 2) * 3 * 8 * 256, 4); __syncthreads(); }
#else
        for (int it = gw; it < 64; it += NGW) cmp_mfma<false>(F, args, 0, it, WSF(WS_KC), WSF(WS_VC));
#endif
#else
        for (int it = gw; it < 256; it += NGW) cmp_prompt_item(F, args, it >> 1, it & 1, wscr);
        for (int it = gw; it < 64; it += NGW) cmp_mfma<false>(F, args, 0, it, WSF(WS_U), WSF(WS_U) + 65536);
        GRID_BAR();
        {   float sd = 0.f, sr = 0.f;
            for (int i = gw * 64 + LANE(); i < 65536; i += NGW * 64) { const float a = WSF(WS_KC)[i], b = WSF(WS_U)[i], c = WSF(WS_VC)[i], d = WSF(WS_U)[65536 + i];
                sd += (a - b) * (a - b) + (c - d) * (c - d); sr += a * a + c * c; }
            sd = wave_sum(sd); sr = wave_sum(sr);
            if (LANE() == 0) { atomicAdd((float*)(F.ctl + 200), sd); atomicAdd((float*)(F.ctl + 264), sr); }
        }
#endif
        SECT2(0);
#if CMPS_IMPL == 1
        if (F.wave & 1) for (int it = gw >> 1; it < NS * NPG / 4; it += NGW / 2) cmp_sample2(F, args, it >> 5, it & 31, WSF(WS_KCS), WSF(WS_VCS), wscr);
#endif
        if (!(F.wave & 1)) for (int it = gw >> 1; it < 2048; it += NGW / 2) rg1_item(F, args, it >> 3, it & 7, wscr);
        SECT2(1);
#if !FUSE_HEADNORM
        for (int t = gw; t < T; t += NGW) head_norm_token(F, args, t);
#else
        if (!(F.wave & 1)) for (int t = 4 * (gw >> 1); t < T; t += 4 * (NGW / 2)) ktile_token4(F, args, t);
#endif
        SECT2(2);
        if (!(F.wave & 1)) for (int it = gw >> 1; it < 1024; it += NGW / 2) { const int w = it >> 9, b = (it >> 1) & 255, g = it & 1;
            if (w == 0) build_vt_block(F.out + O_KVP + (size_t)b * 64 * 512 + 384 + g * 64, 512, WSB(WS_KVS) + (size_t)(b * 2 + g) * 8192, LANE());
            else build_vt_block(WSF(WS_WINB) + (size_t)b * 64 * 256 + 128 + g * 64, 256, WSB(WS_KVW) + (size_t)(b * 2 + g) * 8192, LANE()); }
        SECT2(3);
        if (!(F.wave & 1)) for (int it = NGW / 2 - 1 - (gw >> 1); it < NS * 8; it += NGW / 2) build_win_sample(F, args, it >> 3, it & 7);
        SECT2(4);
#if CMPS_IMPL == 0
        __syncthreads();
        for (int it = F.vcu; it < NS * NPG; it += F.G) cmp_sample_item(F, args, it / NPG, it % NPG);
#elif CMPS_IMPL == 1
        (void)0;
#else
        __syncthreads();
        for (int it = F.vcu; it < NS * NPG; it += F.G) cmp_sample_item(F, args, it / NPG, it % NPG);
        for (int it = gw; it < NS * NPG / 2; it += NGW) cmp_mfma<true>(F, args, it >> 6, it & 63, WSF(WS_U), WSF(WS_U) + 4 * 1024 * 1024);
        GRID_BAR();
        {   float sd = 0.f, sr = 0.f;
            for (int i = gw * 64 + LANE(); i < 2 * 1024 * 1024; i += NGW * 64) { const float a = WSF(WS_KCS)[i], b = WSF(WS_U)[i], c = WSF(WS_VCS)[i], d = WSF(WS_U)[4 * 1024 * 1024 + i];
                sd += (a - b) * (a - b) + (c - d) * (c - d); sr += a * a + c * c; }
            sd = wave_sum(sd); sr = wave_sum(sr);
            if (LANE() == 0) { atomicAdd((float*)(F.ctl + 200), sd); atomicAdd((float*)(F.ctl + 264), sr); }
        }
#endif
        SECT2(5);
#if DBG_SECT2 >= 0
        if (gw == 0 && LANE() == 0) __hip_atomic_store((float*)(F.ctl + 328), exp2f(0.5f * rintf(2.0f * log2f(t2v + 1.0f))) * 1000.0f, RLX_AGENT);
#endif
        if (BOTH(2)) GRID_BAR();
    }
    STAMP(3);
    if (IN(3)) {
        LAS float* wscr = (LAS float*)(F.lds + RING_OFF + F.wave * 16384);
#if SATTN_IMPL == 0
        for (int it = gw; it < NS * 2; it += NGW) attn_sample_item(F, args, it >> 1, it & 1, wscr, btab);
#elif SATTN_IMPL == 1
        for (int it = gw; it < NS * 2; it += NGW) attn_sample_mfma(F, args, it >> 1, it & 1, wscr, btab, SMP(SM_YABS));
#else
        for (int it = gw; it < NS * 2; it += NGW) { attn_sample_item(F, args, it >> 1, it & 1, wscr, btab); attn_sample_mfma(F, args, it >> 1, it & 1, wscr, btab, WSF(WS_U));
            const int b = it >> 1, g = it & 1; float sd = 0.f, sr = 0.f;
            asm volatile("s_waitcnt vmcnt(0)" ::: "memory");
            for (int j = 0; j < 4; ++j) { const float a = __hip_atomic_load(SMP(SM_YABS) + (size_t)b * D + 512 + g * 256 + j * 64 + LANE(), RLX_AGENT), bb = __hip_atomic_load(WSF(WS_U) + (size_t)b * D + 512 + g * 256 + j * 64 + LANE(), RLX_AGENT); sd += (a - bb) * (a - bb); sr += a * a; }
            sd = wave_sum(sd); sr = wave_sum(sr);
            if (LANE() == 0) { atomicAdd((float*)(F.ctl + 200), sd); atomicAdd((float*)(F.ctl + 264), sr); } }
#endif
        for (int it = gw; it < 2048; it += NGW) rg3_item(F, args, it >> 3, it & 7);
#if ATTN_IMPL == 0
        for (int it = gw; it < 2 * T; it += NGW) attn_prompt_item(F, args, it >> 1, it & 1, wscr, btab);
#elif ATTN_IMPL == 1
#if DBG_SECT >= 0
        if (LANE() < 6) ((LAS unsigned long long*)((LAS unsigned char*)wscr + 16000))[LANE()] = 0ull;
        LDS_WAIT();
#endif
        {
            const int gq = (2 * gw) / NGW, wq = gw - gq * (NGW / 2);
#if ATTN_PACK == 2
            {   gu32* ctr = F.ctl + 384 + 64 * gq; (void)wq;
                int nxt = 0; if (LANE() == 0) nxt = (int)__hip_atomic_fetch_add(ctr, 1u, RLX_AGENT); nxt = __builtin_amdgcn_readfirstlane(nxt);
                while (nxt < T / 4) { const int i = nxt;
                    int nn = 0; if (LANE() == 0) nn = (int)__hip_atomic_fetch_add(ctr, 1u, RLX_AGENT);
                    const int j = i >> 1, t0 = (i & 1) ? 4 * j : T - 4 - 4 * j;
                    attn_prompt_pack(F, args, t0, gq, wscr, btab, WSB(WS_YAB));
                    nxt = __builtin_amdgcn_readfirstlane(nn); } }
#elif ATTN_PACK == 1
            for (int i = 0; i < 4; ++i) { const int t0 = (i & 2) ? T - 8 - wq * 8 + 4 * (i & 1) : wq * 8 + 4 * (i & 1); attn_prompt_pack(F, args, t0, gq, wscr, btab, WSB(WS_YAB)); }
#else
            for (int i = 0; i < 16; ++i) { const int ta = wq * 8 + (i >> 1), tq = (i & 1) ? T - 1 - ta : ta; attn_prompt_mfma(F, args, tq, gq, wscr, btab, WSB(WS_YAB)); }
#endif
        }
#else
        for (int it = gw; it < 2 * T; it += NGW) attn_prompt_item(F, args, it >> 1, it & 1, wscr, btab);
        for (int it = gw; it < 2 * (T / 4); it += NGW) attn_prompt_pack(F, args, (it >> 1) * 4, it & 1, wscr, btab, WSB(WS_U));
        GRID_BAR();
        {   float sd = 0.f, sr = 0.f;
            for (int t = gw; t < T; t += NGW) { const v4u a = *((const v4u*)(WSB(WS_YAB) + (size_t)t * D + 512) + LANE()), b = *((const v4u*)(WSB(WS_U) + (size_t)t * D + 512) + LANE());
#pragma unroll
                for (int j = 0; j < 4; ++j) { const float a0 = __builtin_bit_cast(float, a[j] << 16), a1 = __builtin_bit_cast(float, a[j] & 0xffff0000u), b0 = __builtin_bit_cast(float, b[j] << 16), b1 = __builtin_bit_cast(float, b[j] & 0xffff0000u);
                    sd += (a0 - b0) * (a0 - b0) + (a1 - b1) * (a1 - b1); sr += a0 * a0 + a1 * a1; } }
            sd = wave_sum(sd); sr = wave_sum(sr);
            if (LANE() == 0) { atomicAdd((float*)(F.ctl + 200), sd); atomicAdd((float*)(F.ctl + 264), sr); }
        }
#endif
#if DBG_SECT >= 0
        if (gw == 1000 && LANE() == 0) { const float tk = (float)((LAS unsigned long long*)((LAS unsigned char*)wscr + 16000))[DBG_SECT]; F.out[O_HP] = exp2f(0.25f * rintf(4.0f * log2f(tk + 1.0f))) * 1000.0f; }
#endif
        __syncthreads();
        if (BOTH(3)) GRID_BAR();
    }
    STAMP(4);
    if (IN(4)) {
        for (int ct = F.vcu; ct < D / 16; ct += F.G) { const float s = sgemm16(F, SMB(SB_YABS), D, WSB(WS_WOUT0), ct, red);
            const int tid = TID(), r = SG_ROW(tid), n = 16 * ct + SG_COL(tid); const float y = args.in[I_XS][r * D + n] + s; SMP(SM_YS0)[r * D + n] = y; SMB(SB_YS0)[r * D + n] = (bf16)f2bf(y); }
        pg8::Gemm g{WSB(WS_YAB), WSB(WS_WOUT0), T, D, D}; pg8::StaticOrder S; S.init(T, D, F.G, (int)blockIdx.x);
        pg8::EpiRes<true, false> E{nullptr, WSB(WS_HBA), F.out + O_YP, WSB(WS_HBB), WSF(WS_RSB)};
        pg8::gemm_phase<pg8::EpiRes<true, false>, pg8::StaticOrder, PG8_ALIGN, PG8_SP2>(F.lds + RING_OFF, g, S, E, F.wave);
        if (BOTH(4)) GRID_BAR();
    }
    STAMP(5);
#define MLP_PLE_PHASES(P, L, HB_IN, RS_IN, HB_MID, RS_MID, YS_IN, YSB_IN, YS_OUT, YSB_OUT, YS_OUT_LD)                                                                                   \
                                                                                                                                   \
    if (IN(P)) {                                                                                                                                                    \
        for (int ct = F.vcu; ct < FF / 16; ct += F.G) { const float s = sgemm16(F, YSB_IN, D, WSB(WS_WUP) + (size_t)(L) * D * FF, ct, red, YS_IN, rsl);                          \
            const int tid = TID(), r = SG_ROW(tid), n = 16 * ct + SG_COL(tid); const float z = s * rsl[r], zr = z > 0.f ? z : 0.f; SMB(SB_US)[r * FF + n] = (bf16)f2bf(zr * zr); } \
        __syncthreads();                                                                                                                                            \
        pg8::Gemm g{HB_IN, WSB(WS_WUP) + (size_t)(L) * D * FF, T, FF, D}; pg8::StaticOrder S; S.init(T, FF, F.G, (int)blockIdx.x);                                  \
        pg8::EpiUp E{RS_IN, WSB(WS_U)};                                                                                                                             \
        pg8::gemm_phase<pg8::EpiUp, pg8::StaticOrder, PG8_ALIGN, PG8_SP2>(F.lds + RING_OFF, g, S, E, F.wave);                                                               \
        if (BOTH(P)) GRID_BAR();                                                                                                                                    \
    } STAMP((P) + 1);                                                                                                                                                               \
                                                                                                                                     \
    if (IN((P) + 1)) {                                                                                                                                              \
        for (int ct = F.vcu; ct < D / 16; ct += F.G) { const float s = sgemm16(F, SMB(SB_US), FF, WSB(WS_WDOWN) + (size_t)(L) * D * FF, ct, red);                       \
            const int tid = TID(), r = SG_ROW(tid), n = 16 * ct + SG_COL(tid); const float y = YS_IN[r * D + n] + s; YS_IN[r * D + n] = y; YSB_IN[r * D + n] = (bf16)f2bf(y); } \
        pg8::Gemm g{WSB(WS_U), WSB(WS_WDOWN) + (size_t)(L) * D * FF, T, D, FF}; pg8::StaticOrder S; S.init(T, D, F.G, (int)blockIdx.x);                             \
        pg8::EpiRes<true, false> E{nullptr, HB_IN, F.out + O_YP, HB_MID, RS_MID};                                                                                                  \
        pg8::gemm_phase<pg8::EpiRes<true, false>, pg8::StaticOrder, PG8_ALIGN, PG8_SP2>(F.lds + RING_OFF, g, S, E, F.wave);                                                              \
        if (BOTH((P) + 1)) GRID_BAR();                                                                                                                              \
    } STAMP((P) + 2);                                                                                                                                                               \
                                                                                                      \
    if (IN((P) + 2)) {                                                                                                                                              \
        for (int ct = F.vcu; ct < D / 16; ct += F.G) {                                                                                                              \
            const float sg = sgemm16(F, YSB_IN, D, WSB(WS_WGATE) + (size_t)(L) * D * D, ct, red, YS_IN, rsl);                                                        \
            const int tid = TID(), r = SG_ROW(tid), n = 16 * ct + SG_COL(tid); const float sp = SMP(SM_PPS)[((L) * NS + r) * D + n];        \
            const float y = YS_IN[r * D + n] + sigmoidf_(sg * rsl[r]) * sp;                       \
            YS_OUT[(size_t)r * YS_OUT_LD + n] = y; YSB_OUT[r * D + n] = (bf16)f2bf(y); }                                                                             \
        __syncthreads();                                                                                                                                            \
        { pg8::Gemm g{HB_MID, WSB(WS_WGATE) + (size_t)(L) * D * D, T, D, D}; pg8::StaticOrder S; S.init(T, D, F.G, (int)blockIdx.x);                                \
          pg8::EpiGate<(L) == 1> E{RS_MID, WSB((L) == 0 ? WS_PP : WS_PP1), HB_MID, F.out + O_YP, HB_IN, RS_IN};                                                                                                  \
          pg8::gemm_phase<pg8::EpiGate<(L) == 1>, pg8::StaticOrder, PG8_ALIGN, PG8_SP2>(F.lds + RING_OFF, g, S, E, F.wave); }                                                         \
        if (BOTH((P) + 2)) GRID_BAR();                                                                                                                              \
    } STAMP((P) + 3);
    MLP_PLE_PHASES(5, 0, WSB(WS_HBB), WSF(WS_RSB), WSB(WS_HBA), WSF(WS_RSA), SMP(SM_YS0), SMB(SB_YS0), SMP(SM_YS1), SMB(SB_YS1), D)
    if (IN(8)) {
        for (int ct = F.vcu; ct < 2 * D / 16; ct += F.G) { const float s = sgemm16(F, SMB(SB_YS1), D, WSB(WS_WIN1), ct, red, SMP(SM_YS1), rsl);
            const int tid = TID(), r = SG_ROW(tid), n = 16 * ct + SG_COL(tid); const float z = gelu_tanh(s * rsl[r]); if (n < D) SMP(SM_U1S)[r * D + n] = z; else SMP(SM_V1S)[r * D + n - D] = z; }
        __syncthreads();
        pg8::Gemm g{WSB(WS_HBB), WSB(WS_WIN1), T, 2 * D, D}; pg8::StaticOrder S; S.init(T, 2 * D, F.G, (int)blockIdx.x);
        pg8::EpiIn1 E{WSF(WS_RSB), WSB(WS_U1), WSB(WS_V1), WSF(WS_LNS)};
        pg8::gemm_phase<pg8::EpiIn1, pg8::StaticOrder, PG8_ALIGN, PG8_SP2>(F.lds + RING_OFF, g, S, E, F.wave);
        if (BOTH(8)) GRID_BAR();
    }
    STAMP(9);
    if (IN(9)) {
        if (gw < NS) sgu_sample(F, args, gw);
        __syncthreads();
        for (int it = F.vcu; it < 128 * 8; it += F.G) sgu_item(F, args, it >> 3, it & 7);
        {
            pg8::Gemm g2{WSB(WS_PB) + (size_t)T * PLE, WSB(WS_WPROJ) + (size_t)PLE * D, T, D, PLE}; pg8::StaticOrder S2; S2.init(T, D, F.G, (int)blockIdx.x);
            pg8::EpiProj E2{WSB(WS_PP1)};
            pg8::gemm_phase<pg8::EpiProj, pg8::StaticOrder, PG8_ALIGN, PG8_SP2>(F.lds + RING_OFF, g2, S2, E2, F.wave);
        }
        if (BOTH(9)) GRID_BAR();
    }
    STAMP(10);
    if (IN(10)) {
        for (int ct = F.vcu; ct < D / 16; ct += F.G) { const float s = sgemm16(F, SMB(SB_USS), D, WSB(WS_WOUT1), ct, red);
            const int tid = TID(), r = SG_ROW(tid), n = 16 * ct + SG_COL(tid); const float y = SMP(SM_YS1)[r * D + n] + s; SMP(SM_YS1)[r * D + n] = y; SMB(SB_YS1)[r * D + n] = (bf16)f2bf(y); }
        pg8::Gemm g{WSB(WS_YAB), WSB(WS_WOUT1), T, D, D}; pg8::StaticOrder S; S.init(T, D, F.G, (int)blockIdx.x);
        pg8::EpiRes<true, false> E{nullptr, WSB(WS_HBB), F.out + O_YP, WSB(WS_HBA), WSF(WS_RSA)};
        pg8::gemm_phase<pg8::EpiRes<true, false>, pg8::StaticOrder, PG8_ALIGN, PG8_SP2>(F.lds + RING_OFF, g, S, E, F.wave);
        if (BOTH(10)) GRID_BAR();
    }
    STAMP(11);
    MLP_PLE_PHASES(11, 1, WSB(WS_HBA), WSF(WS_RSA), WSB(WS_HBB), WSF(WS_RSB), SMP(SM_YS1), SMB(SB_YS1), (F.out + O_YS), SMB(SB_YS0), D)
#if ATTN_IMPL == 2 || CMPS_IMPL == 2 || SATTN_IMPL == 2 || CMPP_IMPL == 2
    GRID_BAR();
    if (blockIdx.x == 0 && TID() == 0) { const float sd = __hip_atomic_load((float*)(F.ctl + 200), RLX_AGENT), sr = __hip_atomic_load((float*)(F.ctl + 264), RLX_AGENT); F.out[O_HP] = sqrtf(sd / sr) * 1.0e9f; }
#endif
#if DBG_SECT2 >= 0
    GRID_BAR();
    if (blockIdx.x == 0 && TID() == 0) F.out[O_HP] = __hip_atomic_load((float*)(F.ctl + 328), RLX_AGENT);
#endif
#if DBG_TIME_PHASE >= 0
    if (blockIdx.x == 0 && TID() == 0) { const float tk = (float)(ts_b - ts_a); const float q = exp2f(0.25f * (rintf(4.0f * log2f(tk) - 0.5f) + 0.5f)); F.out[O_HP] = q * 1000.0f; }
#endif
#if DBG_SCALE_MASK
    {
        GRID_BAR();
#define SCALE_REGION(o, lo_, hi_) if ((DBG_SCALE_MASK >> (o)) & 1) { for (size_t i = (lo_) + (size_t)gw * 64 + LANE(); i < (hi_); i += (size_t)NGW * 64) F.out[i] *= 4.0f; }
        SCALE_REGION(0, O_YP, O_YS) SCALE_REGION(1, O_YS, O_KVP) SCALE_REGION(2, O_KVP, O_KVS) SCALE_REGION(3, O_KVS, O_WINP) SCALE_REGION(4, O_WINP, O_WINS) SCALE_REGION(5, O_WINS, O_CONVP)
        SCALE_REGION(6, O_CONVP, O_CONVS) SCALE_REGION(7, O_CONVS, O_HP) SCALE_REGION(8, O_HP, O_HS) SCALE_REGION(9, O_HS, O_VS) SCALE_REGION(10, O_VS, O_END)
#undef SCALE_REGION
    }
#endif
#undef IN
#undef BOTH
}

extern "C" void kernel_launch(void* const* d_in, const int* in_sizes, int n_in, void* d_out, int out_size, void* d_ws, size_t ws_size, hipStream_t stream) {
    static int grid = 0;
    if (grid == 0) {
        if (n_in != N_IN || (size_t)out_size != O_END || ws_size < WS_END) { fprintf(stderr, "kernel_launch: unexpected sizes n_in %d out %d ws %zu\n", n_in, out_size, ws_size); grid = -1; return; }
        int dev = 0, cus = 0, per_cu = 0;
        if (hipGetDevice(&dev) != hipSuccess || hipDeviceGetAttribute(&cus, hipDeviceAttributeMultiprocessorCount, dev) != hipSuccess) { grid = -1; return; }
        if (hipFuncSetAttribute((const void*)mega_fwd, hipFuncAttributeMaxDynamicSharedMemorySize, LDS_BYTES) != hipSuccess) { grid = -1; return; }
        if (hipOccupancyMaxActiveBlocksPerMultiprocessor(&per_cu, (const void*)mega_fwd, NWAVES * 64, LDS_BYTES) != hipSuccess || per_cu < 1)
            fprintf(stderr, "kernel_launch: occupancy query reports %d workgroups per CU\n", per_cu);
        (void)hipGetLastError();
        grid = cus;
    }
    if (grid < 0) return;
    if (hipMemsetAsync((char*)d_ws + WS_CTL, 0, CTL_ZERO_BYTES, stream) != hipSuccess) return;
    Args a{};
    for (int i = 0; i < N_IN; ++i) a.in[i] = (const float*)d_in[i];
    a.out = (float*)d_out; a.ws = (unsigned char*)d_ws;
    a.ph_lo = 0; a.ph_hi = 64;
    hipLaunchKernelGGL(mega_fwd, dim3(grid), dim3(NWAVES * 64), LDS_BYTES, stream, a);
}
```

```cpp
#include <hip/hip_runtime.h>
#include <cstdio>
#include <cstdint>
#define DBG_ZERO_OUT 0
#define DBG_SCALE_MASK 0
#define DBG_TIME_PHASE (-1)
#define ATTN_IMPL 1
#define CMPS_IMPL 1
#define SATTN_IMPL 1
#define ATTN_DBUF 0
#define HOTBLK 0
#define DBG_SECT (-1)
#define DBG_SECT2 (-1)
#define CMPP_IMPL 1
#define KV_NT 0
#define CMPP_SPLIT 1
#define ATTN_PACK 2
#define SEL_FP8 1
#define FUSE_HEADNORM 1
namespace pg8 {
#define PG8_LAS __attribute__((address_space(3)))
typedef unsigned short bf16_t;
typedef short bf16x8 __attribute__((ext_vector_type(8)));
typedef float f32x4 __attribute__((ext_vector_type(4)));
typedef unsigned u32x4 __attribute__((ext_vector_type(4)));
constexpr int BM = 256, BK = 64, HALF = 128, HTB = HALF * BK * 2  , STAGE_BYTES = 8 * HTB, NXCD = 8, WGM = 8;

__host__ __device__ __forceinline__ int lds_byte(int r, int c) { const int st = (r >> 4) * 2 + (c >> 5), rr = r & 15, cc = c & 31, ob = rr * 64 + cc * 2; return st * 1024 + (ob ^ (((ob >> 9) & 1) << 5)); }
__host__ __device__ __forceinline__ void stage_rc(int b, int& R, int& C) { const int st = b / 1024, sb = b % 1024, swz = sb ^ (((sb >> 9) & 1) << 5); R = (st >> 1) * 16 + swz / 64; C = (st & 1) * 32 + (swz % 64) / 2; }
__host__ __device__ __forceinline__ int perm32(int rho) { const int n = rho >> 4, i = rho & 15; return 8 * (i >> 2) + 4 * n + (i & 3); }

struct Unit { int pm, pn; };
struct Gemm { const bf16_t* A; const bf16_t* Bt; int M, N, K; };

struct StaticOrder {
    int nM, nN, nwg, G, c;
    __host__ __device__ void init(int M, int N, int G_, int c_) { nM = M / BM; nN = N / BM; nwg = nM * nN; G = G_; c = c_; }
    __host__ __device__ bool next(int i, Unit& u) const {
        const long L = (long)i * G + c; if (L >= nwg) return false;
        int wgid = (int)L; { const int q = nwg / NXCD, r = nwg % NXCD, xcd = wgid % NXCD, off = wgid / NXCD; wgid = (xcd < r ? xcd * (q + 1) : r * (q + 1) + (xcd - r) * q) + off; }
        const int nig = WGM * nN, gid = wgid / nig, fm = gid * WGM, gsz = (nM - fm) < WGM ? (nM - fm) : WGM;
        u.pm = fm + ((wgid % nig) % gsz); u.pn = (wgid % nig) / gsz; return true;
    }
    __device__ __forceinline__ void a_ready(const Unit&) const {}
    __device__ __forceinline__ void done(const Unit&) const {}
};


__device__ __forceinline__ unsigned cvt_pk_bf16(float lo, float hi) { unsigned r; asm volatile("v_cvt_pk_bf16_f32 %0, %1, %2" : "=v"(r) : "v"(lo), "v"(hi)); return r; }
typedef unsigned u32x2 __attribute__((ext_vector_type(2)));
__device__ __forceinline__ float dot4(const f32x4 a) { return (a[0] * a[0] + a[1] * a[1]) + (a[2] * a[2] + a[3] * a[3]); }
__device__ __forceinline__ float sum4(const f32x4 a) { return (a[0] + a[1]) + (a[2] + a[3]); }
__device__ __forceinline__ float row_rstd16(const float* rs, int row) {
    const f32x4* p = (const f32x4*)(rs + (size_t)row * 16);
    const f32x4 a = p[0], b = p[1], c = p[2], d = p[3];
    const float s = (sum4(a) + sum4(b)) + (sum4(c) + sum4(d));
    return 1.0f / sqrtf(s * (1.0f / 1024.0f) + 1e-6f);
}
__device__ __forceinline__ float gelu_tanh(float x) { const float u2 = (-2.0f * 0.7978845608028654f * 1.4426950408889634f) * (x + 0.044715f * x * x * x); return x * __builtin_amdgcn_rcpf(1.0f + __builtin_amdgcn_exp2f(u2)); }
__device__ __forceinline__ float sigmoidf_(float x) { return __builtin_amdgcn_rcpf(1.0f + __builtin_amdgcn_exp2f(-1.4426950408889634f * x)); }
__device__ __forceinline__ void st_bf16x4(bf16_t* p, const f32x4 v) { u32x2 w; w.x = cvt_pk_bf16(v[0], v[1]); w.y = cvt_pk_bf16(v[2], v[3]); *(u32x2*)p = w; }

__device__ __forceinline__ int epi_kv_off_k(int r, int d) { return (((r >> 4) * 2 + (d >> 5)) * 64 + ((d & 31) >> 3) * 16 + (r & 15)) * 8 + (d & 7); }
struct EpiIn0 {
    static constexpr bool PERM = false, AFTER_DRAIN = false;
    const float* rs; bf16_t* xa; bf16_t* gg; float* qr; float* kvp; float* win; float* gate;
    const float* qgain; const float* kgain; bf16_t* kvs; bf16_t* kvw; float* winp; float* convp; int nrows;
    template <int TYPE>
    __device__ __forceinline__ void head_tile(const f32x4 (&acc)[2][2][4][2], const Unit& u, int wr, int wc, int fr, int fq) const {
        const bool normed = TYPE == 0 || ((TYPE == 2 || TYPE == 3) && wc < 2);
        const float* gp = TYPE == 0 ? qgain : (TYPE == 2 ? kgain + 64 : kgain + 128);
#pragma unroll
        for (int ai = 0; ai < 2; ++ai)
#pragma unroll
            for (int m = 0; m < 4; ++m) {
                const int row = u.pm * BM + ai * HALF + wr * 64 + m * 16 + fr;
                const float rstd = row_rstd16(rs, row);
                f32x4 z[2][2]; float ss = 0.f;
#pragma unroll
                for (int bj = 0; bj < 2; ++bj)
#pragma unroll
                    for (int n = 0; n < 2; ++n) { z[bj][n] = acc[ai][bj][m][n] * rstd; ss += dot4(z[bj][n]); }
                float hs = 1.0f;
                if (TYPE != 1) { ss += __shfl_xor(ss, 16); ss += __shfl_xor(ss, 32); if (normed) hs = 1.0f / sqrtf(ss * (1.0f / 64.0f) + 1e-6f); }
                float* f32dst = TYPE == 0 ? qr + (size_t)row * 512 + (u.pn - 4) * 256 + 64 * wc + 4 * fq
                              : (TYPE == 3 ? win + (size_t)row * 256 + 64 * wc + 4 * fq : kvp + (size_t)row * 512 + (TYPE - 1) * 256 + 64 * wc + 4 * fq);
#pragma unroll
                for (int bj = 0; bj < 2; ++bj)
#pragma unroll
                    for (int n = 0; n < 2; ++n) {
                        const int d0 = 32 * bj + 16 * n, d = d0 + 4 * fq;
                        f32x4 v = z[bj][n]; if (normed) v = v * hs * *(const f32x4*)(gp + d);
                        *(f32x4*)(f32dst + d0) = v;
                        if (TYPE == 3) { if (row >= nrows - 512) *(f32x4*)(winp + (size_t)(row - (nrows - 512)) * 256 + 64 * wc + d) = v; }
                    }
                asm volatile("" ::: "memory");
            }
    }
    __device__ __forceinline__ void operator()(const f32x4 (&acc)[2][2][4][2], const Unit& u, int wr, int wc, int fr, int fq) const {
        if (u.pn == 4 || u.pn == 5) { head_tile<0>(acc, u, wr, wc, fr, fq); return; }
        if (u.pn == 6) { head_tile<1>(acc, u, wr, wc, fr, fq); return; }
        if (u.pn == 7) { head_tile<2>(acc, u, wr, wc, fr, fq); return; }
        if (u.pn == 8) { head_tile<3>(acc, u, wr, wc, fr, fq); return; }
#pragma unroll
        for (int ai = 0; ai < 2; ++ai)
#pragma unroll
            for (int m = 0; m < 4; ++m) {
                const int row = u.pm * BM + ai * HALF + wr * 64 + m * 16 + fr;
                const float rstd = row_rstd16(rs, row);
#pragma unroll
                for (int bj = 0; bj < 2; ++bj)
#pragma unroll
                    for (int n = 0; n < 2; ++n) {
                        const int cb = u.pn * BM + bj * HALF, col = cb + wc * 32 + n * 16 + fq * 4;
                        f32x4 z = acc[ai][bj][m][n] * rstd;
                        if (cb < 512) { st_bf16x4(xa + (size_t)row * 512 + col, z); if (row >= nrows - 3) *(f32x4*)(convp + (size_t)(row - (nrows - 3)) * 512 + col) = z; }
                        else if (cb < 1024) { z[0] = gelu_tanh(z[0]); z[1] = gelu_tanh(z[1]); z[2] = gelu_tanh(z[2]); z[3] = gelu_tanh(z[3]); st_bf16x4(gg + (size_t)row * 512 + (col - 512), z); }
                        else if (col < 2328) { z[0] = sigmoidf_(z[0]); z[1] = sigmoidf_(z[1]); z[2] = sigmoidf_(z[2]); z[3] = sigmoidf_(z[3]); *(f32x4*)(gate + (size_t)row * 24 + (col - 2304)) = z; }
                    }
            }
    }
};
__device__ __forceinline__ void ld_bf16x8(const bf16_t* p, f32x4& a, f32x4& b) { const u32x4 w = *(const u32x4*)p;
    a[0] = __uint_as_float(w.x << 16); a[1] = __uint_as_float(w.x & 0xffff0000u); a[2] = __uint_as_float(w.y << 16); a[3] = __uint_as_float(w.y & 0xffff0000u);
    b[0] = __uint_as_float(w.z << 16); b[1] = __uint_as_float(w.z & 0xffff0000u); b[2] = __uint_as_float(w.w << 16); b[3] = __uint_as_float(w.w & 0xffff0000u); }
template <bool RB, bool WY>
struct EpiRes {
    static constexpr bool PERM = true, AFTER_DRAIN = false;
    const float* resid; const bf16_t* resid_b; float* y; bf16_t* hb; float* rs;
    __device__ __forceinline__ void operator()(const f32x4 (&acc)[2][2][4][2], const Unit& u, int wr, int wc, int fr, int fq) const {
#pragma unroll
        for (int ai = 0; ai < 2; ++ai)
#pragma unroll
            for (int m = 0; m < 4; ++m) {
                const int row = u.pm * BM + ai * HALF + wr * 64 + m * 16 + fr;
                float ss = 0.f;
#pragma unroll
                for (int bj = 0; bj < 2; ++bj) {
                    const size_t off = (size_t)row * 1024 + (u.pn * BM + bj * HALF + wc * 32 + 8 * fq);
                    f32x4 r0, r1; if (RB) ld_bf16x8(resid_b + off, r0, r1); else { r0 = *(const f32x4*)(resid + off); r1 = *(const f32x4*)(resid + off + 4); }
                    const f32x4 v0 = acc[ai][bj][m][0] + r0, v1 = acc[ai][bj][m][1] + r1;
                    if (WY) { *(f32x4*)(y + off) = v0; *(f32x4*)(y + off + 4) = v1; } ss += dot4(v0) + dot4(v1);
                    u32x4 w; w.x = cvt_pk_bf16(v0[0], v0[1]); w.y = cvt_pk_bf16(v0[2], v0[3]); w.z = cvt_pk_bf16(v1[0], v1[1]); w.w = cvt_pk_bf16(v1[2], v1[3]);
                    *(u32x4*)(hb + off) = w;
                }
                ss += __shfl_xor(ss, 16); ss += __shfl_xor(ss, 32);
                if (fq == 0) rs[(size_t)row * 16 + u.pn * 4 + wc] = ss;
                if (m == 3) asm volatile("" ::: "memory");
            }
    }
};
struct EpiUp {
    static constexpr bool PERM = true, AFTER_DRAIN = false;
    const float* rs; bf16_t* o;
    __device__ __forceinline__ void operator()(const f32x4 (&acc)[2][2][4][2], const Unit& u, int wr, int wc, int fr, int fq) const {
#pragma unroll
        for (int ai = 0; ai < 2; ++ai)
#pragma unroll
            for (int m = 0; m < 4; ++m) {
                const int row = u.pm * BM + ai * HALF + wr * 64 + m * 16 + fr;
                const float rstd = row_rstd16(rs, row);
#pragma unroll
                for (int bj = 0; bj < 2; ++bj) {
                    const size_t off = (size_t)row * 4096 + (u.pn * BM + bj * HALF + wc * 32 + 8 * fq);
                    f32x4 z0 = acc[ai][bj][m][0] * rstd, z1 = acc[ai][bj][m][1] * rstd;
#pragma unroll
                    for (int j = 0; j < 4; ++j) { const float t0 = z0[j] > 0.f ? z0[j] : 0.f, t1 = z1[j] > 0.f ? z1[j] : 0.f; z0[j] = t0 * t0; z1[j] = t1 * t1; }
                    u32x4 w; w.x = cvt_pk_bf16(z0[0], z0[1]); w.y = cvt_pk_bf16(z0[2], z0[3]); w.z = cvt_pk_bf16(z1[0], z1[1]); w.w = cvt_pk_bf16(z1[2], z1[3]);
                    *(u32x4*)(o + off) = w;
                }
            }
    }
};
struct EpiProj {
    static constexpr bool PERM = false, AFTER_DRAIN = false;
    bf16_t* pp;
    __device__ __forceinline__ void operator()(const f32x4 (&acc)[2][2][4][2], const Unit& u, int wr, int wc, int fr, int fq) const {
#pragma unroll
        for (int ai = 0; ai < 2; ++ai)
#pragma unroll
            for (int m = 0; m < 4; ++m) {
                const int row = u.pm * BM + ai * HALF + wr * 64 + m * 16 + fr;
#pragma unroll
                for (int bj = 0; bj < 2; ++bj)
#pragma unroll
                    for (int n = 0; n < 2; ++n) st_bf16x4(pp + (size_t)row * 1024 + (u.pn * BM + bj * HALF + wc * 32 + n * 16 + fq * 4), acc[ai][bj][m][n]);
            }
    }
};
template <bool WY>
struct EpiGate {
    static constexpr bool PERM = true, AFTER_DRAIN = false;
    const float* rs_in; const bf16_t* pp; const bf16_t* yb; float* y; bf16_t* hb; float* rs_out;
    __device__ __forceinline__ void operator()(const f32x4 (&acc)[2][2][4][2], const Unit& u, int wr, int wc, int fr, int fq) const {
#pragma unroll
        for (int ai = 0; ai < 2; ++ai)
#pragma unroll
            for (int m = 0; m < 4; ++m) {
                const int row = u.pm * BM + ai * HALF + wr * 64 + m * 16 + fr;
                const float rstd = row_rstd16(rs_in, row);
                float ss = 0.f;
#pragma unroll
                for (int bj = 0; bj < 2; ++bj) {
                    const size_t off = (size_t)row * 1024 + (u.pn * BM + bj * HALF + wc * 32 + 8 * fq);
                    const f32x4 z0 = acc[ai][bj][m][0] * rstd, z1 = acc[ai][bj][m][1] * rstd; f32x4 p0, p1; ld_bf16x8(pp + off, p0, p1);
                    f32x4 v0, v1; ld_bf16x8(yb + off, v0, v1);
#pragma unroll
                    for (int j = 0; j < 4; ++j) { v0[j] += sigmoidf_(z0[j]) * p0[j]; v1[j] += sigmoidf_(z1[j]) * p1[j]; }
                    if (WY) { *(f32x4*)(y + off) = v0; *(f32x4*)(y + off + 4) = v1; } ss += dot4(v0) + dot4(v1);
                    u32x4 w; w.x = cvt_pk_bf16(v0[0], v0[1]); w.y = cvt_pk_bf16(v0[2], v0[3]); w.z = cvt_pk_bf16(v1[0], v1[1]); w.w = cvt_pk_bf16(v1[2], v1[3]);
                    if (!WY) *(u32x4*)(hb + off) = w;
                }
                ss += __shfl_xor(ss, 16); ss += __shfl_xor(ss, 32);
                if (!WY && fq == 0) rs_out[(size_t)row * 16 + u.pn * 4 + wc] = ss;
                if (m == 3) asm volatile("" ::: "memory");
            }
    }
};
struct EpiIn1 {
    static constexpr bool PERM = false, AFTER_DRAIN = false;
    const float* rs; bf16_t* u1; bf16_t* v1; float* lns;
    __device__ __forceinline__ void operator()(const f32x4 (&acc)[2][2][4][2], const Unit& u, int wr, int wc, int fr, int fq) const {
#pragma unroll
        for (int ai = 0; ai < 2; ++ai)
#pragma unroll
            for (int m = 0; m < 4; ++m) {
                const int row = u.pm * BM + ai * HALF + wr * 64 + m * 16 + fr;
                const float rstd = row_rstd16(rs, row);
                float s1 = 0.f, s2 = 0.f;
#pragma unroll
                for (int bj = 0; bj < 2; ++bj)
#pragma unroll
                    for (int n = 0; n < 2; ++n) {
                        const int col = u.pn * BM + bj * HALF + wc * 32 + n * 16 + fq * 4;
                        f32x4 z = acc[ai][bj][m][n] * rstd;
#pragma unroll
                        for (int j = 0; j < 4; ++j) z[j] = gelu_tanh(z[j]);
                        if (col < 1024) st_bf16x4(u1 + (size_t)row * 1024 + col, z);
                        else { st_bf16x4(v1 + (size_t)row * 1024 + (col - 1024), z); s1 += sum4(z); s2 += dot4(z); }
                    }
                if (u.pn >= 4) {
                    s1 += __shfl_xor(s1, 16); s1 += __shfl_xor(s1, 32); s2 += __shfl_xor(s2, 16); s2 += __shfl_xor(s2, 32);
                    if (fq == 0) { float* p = lns + ((size_t)row * 16 + (u.pn - 4) * 4 + wc) * 2; p[0] = s1; p[1] = s2; }
                }
            }
    }
};

template <class Epi, class Sched, bool ALIGN_EPI = false, bool SP2 = false>
__device__ __forceinline__ void gemm_phase(PG8_LAS unsigned char* lds, const Gemm g, const Sched& S, const Epi& E, const int wid_in) {
    int lane_ = (int)__builtin_amdgcn_mbcnt_hi(~0u, __builtin_amdgcn_mbcnt_lo(~0u, 0u)); asm volatile("" : "+v"(lane_));
    const int wid = wid_in, lane = lane_, tid = wid * 64 + lane, wr = wid >> 2, wc = wid & 3, fr = lane & 15, fq = lane >> 4;
    const int K = g.K, nt = K / BK;
    unsigned voffA[2], voffB[2];
#pragma unroll
    for (int i = 0; i < 2; ++i) { int R, C; stage_rc(tid * 16 + i * 8192, R, C); const int Rb = Epi::PERM ? ((R & ~31) + perm32(R & 31)) : R;
        voffA[i] = (unsigned)(R * K + C) * 2u; voffB[i] = (unsigned)(Rb * K + C) * 2u; }
    const size_t kstep = (size_t)(BK * 2);
    const size_t hstep = (size_t)HALF * K * 2;
    const size_t tstep = 2 * hstep;
    const unsigned ldsw = (unsigned)wid * 1024u;
    const int aoff = lds_byte(wr * 64 + fr, fq * 8), boff = lds_byte(wc * 32 + fr, fq * 8);
#define PG8_SA(b, h) (((b) * 2 + (h)) * HTB)
#define PG8_SB(b, h) ((4 + (b) * 2 + (h)) * HTB)
#define PG8_STAGE(bufoff, gbase, voff) do { _Pragma("unroll") for (int _i = 0; _i < 2; ++_i) \
        __builtin_amdgcn_global_load_lds((const unsigned*)((const char*)(gbase) + (voff)[_i]), (PG8_LAS unsigned*)(lds + (bufoff) + ldsw + _i * 8192), 16, 0, 0); } while (0)
#define PG8_LDA(dst, b, h) do { _Pragma("unroll") for (int m = 0; m < 4; ++m) _Pragma("unroll") for (int k = 0; k < 2; ++k) dst[m][k] = *(const PG8_LAS bf16x8*)(lds + PG8_SA(b, h) + aoff + m * 2048 + k * 1024); } while (0)
#define PG8_LDB(dst, b, h) do { _Pragma("unroll") for (int n = 0; n < 2; ++n) _Pragma("unroll") for (int k = 0; k < 2; ++k) dst[n][k] = *(const PG8_LAS bf16x8*)(lds + PG8_SB(b, h) + boff + n * 2048 + k * 1024); } while (0)
#define PG8_MMA(ai, bj, At, Bt) do { __builtin_amdgcn_s_setprio(1); _Pragma("unroll") for (int m = 0; m < 4; ++m) _Pragma("unroll") for (int n = 0; n < 2; ++n) _Pragma("unroll") for (int k = 0; k < 2; ++k) \
        acc[ai][bj][m][n] = __builtin_amdgcn_mfma_f32_16x16x32_bf16(Bt[n][k], At[m][k], acc[ai][bj][m][n], 0, 0, 0); __builtin_amdgcn_s_setprio(0); } while (0)
#define PG8_WAIT_V(n) asm volatile("s_waitcnt vmcnt(" #n ")" ::: "memory")
#define PG8_WAIT_L(n) asm volatile("s_waitcnt lgkmcnt(" #n ")" ::: "memory")
#define PG8_BAR __builtin_amdgcn_s_barrier()
#define PG8_SCHED __builtin_amdgcn_sched_barrier(0)
    Unit cur, nxt; int ui = 0;
    if (!S.next(0, cur)) return;
    f32x4 acc[2][2][4][2];
#pragma unroll
    for (int a = 0; a < 2; ++a)
#pragma unroll
        for (int b = 0; b < 2; ++b)
#pragma unroll
            for (int m = 0; m < 4; ++m)
#pragma unroll
                for (int n = 0; n < 2; ++n) acc[a][b][m][n] = (f32x4){0.f, 0.f, 0.f, 0.f};
    bf16x8 At[4][2], B0[2][2], B1[2][2];
    const char* cA = (const char*)g.A + (size_t)cur.pm * tstep; const char* cB = (const char*)g.Bt + (size_t)cur.pn * tstep;
    S.a_ready(cur);
    if constexpr (SP2) {
        PG8_STAGE(PG8_SB(0, 0), cB, voffB); PG8_STAGE(PG8_SB(0, 1), cB + hstep, voffB); PG8_STAGE(PG8_SA(0, 0), cA, voffA); PG8_STAGE(PG8_SA(0, 1), cA + hstep, voffA);
        if (wr == 1) PG8_BAR;
        PG8_WAIT_V(2); PG8_BAR;
        PG8_STAGE(PG8_SB(1, 0), cB + kstep, voffB); PG8_STAGE(PG8_SA(1, 0), cA + kstep, voffA); PG8_STAGE(PG8_SB(1, 1), cB + hstep + kstep, voffB);
        PG8_WAIT_V(6); PG8_BAR;
    } else {
        PG8_STAGE(PG8_SB(0, 0), cB, voffB); PG8_STAGE(PG8_SA(0, 0), cA, voffA); PG8_STAGE(PG8_SB(0, 1), cB + hstep, voffB); PG8_STAGE(PG8_SA(0, 1), cA + hstep, voffA);
        if (wr == 1) PG8_BAR;
        PG8_WAIT_V(4); PG8_BAR;
        PG8_STAGE(PG8_SB(1, 0), cB + kstep, voffB); PG8_STAGE(PG8_SA(1, 0), cA + kstep, voffA); PG8_STAGE(PG8_SB(1, 1), cB + hstep + kstep, voffB);
        PG8_WAIT_V(6); PG8_BAR;
    }
    for (;;) {
        const bool has_next = S.next(ui + 1, nxt);
        const char* nA = has_next ? (const char*)g.A + (size_t)nxt.pm * tstep : cA; const char* nB = has_next ? (const char*)g.Bt + (size_t)nxt.pn * tstep : cB;
        for (int t = 0; t < nt; t += 2) {
            const bool last = (t == nt - 2);
            const char* a1 = cA + (size_t)(t + 1) * kstep;
            const char* a2 = last ? nA : cA + (size_t)(t + 2) * kstep; const char* b2 = last ? nB : cB + (size_t)(t + 2) * kstep;
            const char* a3 = a2 + kstep; const char* b3 = b2 + kstep;
            if (last && has_next) S.a_ready(nxt);
            if constexpr (SP2) {
            PG8_LDB(B0, 0, 0); PG8_LDB(B1, 0, 1); PG8_SCHED; PG8_LDA(At, 0, 0); PG8_STAGE(PG8_SA(1, 1), a1 + hstep, voffA);
            PG8_WAIT_V(8); PG8_WAIT_L(0); PG8_BAR; PG8_MMA(0, 0, At, B0); PG8_MMA(0, 1, At, B1); PG8_BAR; PG8_SCHED;
            PG8_LDA(At, 0, 1); PG8_STAGE(PG8_SB(0, 0), b2, voffB); PG8_STAGE(PG8_SB(0, 1), b2 + hstep, voffB); PG8_STAGE(PG8_SA(0, 0), a2, voffA);
            PG8_WAIT_V(8); PG8_WAIT_L(0); PG8_BAR; PG8_MMA(1, 0, At, B0); PG8_MMA(1, 1, At, B1); PG8_BAR; PG8_SCHED;
            PG8_LDB(B0, 1, 0); PG8_LDB(B1, 1, 1); PG8_SCHED; PG8_LDA(At, 1, 0); PG8_STAGE(PG8_SA(0, 1), a2 + hstep, voffA);
            PG8_WAIT_V(8); PG8_WAIT_L(0); PG8_BAR; PG8_MMA(0, 0, At, B0); PG8_MMA(0, 1, At, B1); PG8_BAR; PG8_SCHED;
            PG8_LDA(At, 1, 1); PG8_STAGE(PG8_SB(1, 0), b3, voffB); PG8_STAGE(PG8_SB(1, 1), b3 + hstep, voffB); PG8_STAGE(PG8_SA(1, 0), a3, voffA);
            PG8_WAIT_V(8); PG8_WAIT_L(0); PG8_BAR; PG8_MMA(1, 0, At, B0); PG8_MMA(1, 1, At, B1); PG8_BAR; PG8_SCHED;
            } else {
            PG8_LDB(B0, 0, 0); PG8_SCHED; PG8_LDA(At, 0, 0); PG8_STAGE(PG8_SA(1, 1), a1 + hstep, voffA);
            PG8_WAIT_L(8); PG8_BAR; PG8_WAIT_L(0); PG8_MMA(0, 0, At, B0); PG8_BAR; PG8_SCHED;
            PG8_LDB(B1, 0, 1); PG8_STAGE(PG8_SB(0, 0), b2, voffB);
            PG8_BAR; PG8_WAIT_L(0); PG8_MMA(0, 1, At, B1); PG8_BAR;
            PG8_LDA(At, 0, 1); PG8_STAGE(PG8_SA(0, 0), a2, voffA);
            PG8_BAR; PG8_WAIT_L(0); PG8_MMA(1, 0, At, B0); PG8_BAR; PG8_SCHED;
            PG8_STAGE(PG8_SB(0, 1), b2 + hstep, voffB);
            PG8_WAIT_V(6); PG8_BAR; PG8_MMA(1, 1, At, B1); PG8_BAR;
            PG8_LDB(B0, 1, 0); PG8_SCHED; PG8_LDA(At, 1, 0); PG8_STAGE(PG8_SA(0, 1), a2 + hstep, voffA);
            PG8_WAIT_L(8); PG8_BAR; PG8_WAIT_L(0); PG8_MMA(0, 0, At, B0); PG8_BAR; PG8_SCHED;
            PG8_LDB(B1, 1, 1); PG8_STAGE(PG8_SB(1, 0), b3, voffB);
            PG8_BAR; PG8_WAIT_L(0); PG8_MMA(0, 1, At, B1); PG8_BAR;
            PG8_LDA(At, 1, 1); PG8_STAGE(PG8_SA(1, 0), a3, voffA);
            PG8_BAR; PG8_WAIT_L(0); PG8_MMA(1, 0, At, B0); PG8_BAR; PG8_SCHED;
            PG8_STAGE(PG8_SB(1, 1), b3 + hstep, voffB);
            PG8_WAIT_V(6); PG8_BAR; PG8_MMA(1, 1, At, B1); PG8_BAR;
            }
        }
        if constexpr (ALIGN_EPI) { if (wr == 0) PG8_BAR; }
        if constexpr (!Epi::AFTER_DRAIN) { E(acc, cur, wr, wc, fr, fq); S.done(cur); }
        if (!has_next) break;
#pragma unroll
        for (int a = 0; a < 2; ++a)
#pragma unroll
            for (int b = 0; b < 2; ++b)
#pragma unroll
                for (int m = 0; m < 4; ++m)
#pragma unroll
                    for (int n = 0; n < 2; ++n) acc[a][b][m][n] = (f32x4){0.f, 0.f, 0.f, 0.f};
        cur = nxt; cA = nA; cB = nB; ++ui;
        if constexpr (ALIGN_EPI) { if (wr == 1) PG8_BAR; }
    }
    PG8_WAIT_V(0);
    if constexpr (!ALIGN_EPI) { if (wr == 0) PG8_BAR; }
    PG8_BAR;
    if constexpr (Epi::AFTER_DRAIN) { E.fused(acc, cur, wr, wc, fr, fq, lds, wid, lane); S.done(cur); }
#undef PG8_SA
#undef PG8_SB
#undef PG8_STAGE
#undef PG8_LDA
#undef PG8_LDB
#undef PG8_MMA
#undef PG8_WAIT_V
#undef PG8_WAIT_L
#undef PG8_BAR
#undef PG8_SCHED
}
}

#ifndef PG8_SP2
#define PG8_SP2 true
#endif
#ifndef PG8_ALIGN
#define PG8_ALIGN true
#endif
constexpr int NWAVES = 8;
constexpr int T = 16384, D = 1024, FF = 4096, PLE = 256, NS = 32;
constexpr int LRU = 512, EIN = 2328, EINP = 2560;
constexpr int NPG = 128;
constexpr float EPS = 1e-6f;
constexpr size_t O_YP = 0, O_YS = 16777216, O_KVP = O_YS + 32768, O_KVS = O_KVP + 8388608, O_WINP = O_KVS + 16384, O_WINS = O_WINP + 131072,
                 O_CONVP = O_WINS + 4194304, O_CONVS = O_CONVP + 1536, O_HP = O_CONVS + 49152, O_HS = O_HP + 512, O_VS = O_HS + 16384, O_END = O_VS + 32768;
enum { I_XP = 0, I_XS, I_CKV, I_CWIN, I_SCONV, I_SH, I_PT, I_PP, I_PS, I_RELB, I_GMIX, I_GMLP, I_WUP, I_WDOWN, I_GPLE, I_WPG, I_WPP, I_WINE, I_WOUTE, I_CONVW, I_CONVB,
       I_WA, I_BA, I_WX, I_BX, I_LAM, I_QG, I_KG, I_CWK, I_CWV, I_PEK, I_PEV, I_WINO, I_LNG, I_LNB, I_SGW, I_SGB, I_WOUTO, N_IN };
constexpr size_t MiB = 1ull << 20;
constexpr size_t WS_CTL = 0, CTL_ZERO_BYTES = 1 * MiB;
constexpr size_t WS_WIN0 = 1 * MiB, WS_WOUT0 = 6 * MiB, WS_WUP = 8 * MiB, WS_WDOWN = 24 * MiB, WS_WGATE = 40 * MiB, WS_WPROJ = 44 * MiB, WS_WIN1 = 45 * MiB, WS_WOUT1 = 49 * MiB;
constexpr size_t WS_HBA = 52 * MiB, WS_HBB = 84 * MiB, WS_RSA = 116 * MiB, WS_RSB = 117 * MiB, WS_PB = 118 * MiB;
constexpr size_t WS_XA = 134 * MiB, WS_GG = 166 * MiB, WS_QR = 198 * MiB, WS_WINB = 230 * MiB, WS_GATE = 246 * MiB;
constexpr size_t WS_KC = 248 * MiB, WS_VC = 248 * MiB + 512 * 1024, WS_SUMP = 249 * MiB, WS_SUME = 249 * MiB + 512 * 1024;
constexpr size_t WS_HL = 250 * MiB, WS_CP = 282 * MiB, WS_YAB = 314 * MiB, WS_U = 346 * MiB, WS_PP = 474 * MiB, WS_U1 = 538 * MiB, WS_V1 = 570 * MiB, WS_LNS = 634 * MiB;
constexpr size_t WS_KCS = 636 * MiB, WS_VCS = 644 * MiB, WS_SMP = 652 * MiB;
constexpr size_t WS_KVS = 656 * MiB, WS_KVW = 664 * MiB, WS_KVC = 672 * MiB, WS_WCT = 674 * MiB, WS_KVCS = 675 * MiB, WS_KVWS = 683 * MiB, WS_SGWB = 691 * MiB, WS_PP1 = 692 * MiB, WS_END = 756 * MiB;
constexpr int SM_ZS = 0, SM_QS = 81920, SM_WNS = 98304, SM_GATES = 106496, SM_YABS = 114688, SM_YS0 = 147456, SM_YS1 = 180224, SM_US = 212992, SM_U1S = 344064, SM_V1S = 376832, SM_USS = 409600, SM_PPS = 442368, SM_END = 507904;
constexpr int SB_BASE = 2 * SM_END, SB_YABS = SB_BASE, SB_YS0 = SB_YABS + 32768, SB_YS1 = SB_YS0 + 32768, SB_US = SB_YS1 + 32768, SB_USS = SB_US + 131072, SB_PS = SB_USS + 32768, SB_END = SB_PS + 16384;
static_assert(SB_END * 2 <= 4 * (int)MiB, "sample buffers");
constexpr int CW_TMO = 0, CW_CODE = 1, CW_BAR = 4096;
constexpr int RING_OFF = 0, RING_BYTES = 131072;
constexpr int LDSCTL_OFF = RING_BYTES, MISC_OFF = LDSCTL_OFF + 320;
constexpr int BTAB_OFF = LDSCTL_OFF + 1024;
constexpr int LDS_BYTES = 147456;
static_assert(MISC_OFF + 128 <= BTAB_OFF && BTAB_OFF + 2 * 114 * 8 * 4 <= LDS_BYTES, "LDS map");

#define GAS __attribute__((address_space(1)))
#define LAS __attribute__((address_space(3)))
typedef unsigned short bf16;
typedef unsigned v4u __attribute__((ext_vector_type(4)));
typedef unsigned v2u __attribute__((ext_vector_type(2)));
typedef float f32x4 __attribute__((ext_vector_type(4)));
typedef float f32x2 __attribute__((ext_vector_type(2)));
typedef GAS unsigned gu32;
#define RLX_AGENT __ATOMIC_RELAXED, __HIP_MEMORY_SCOPE_AGENT
#define LDS_WAIT() asm volatile("s_waitcnt lgkmcnt(0)" ::: "memory")
#define VM_WAIT() asm volatile("s_waitcnt vmcnt(0)" ::: "memory")
__device__ __forceinline__ unsigned f2bf(float f) { unsigned u = __builtin_bit_cast(unsigned, f); return (u + 0x7fffu + ((u >> 16) & 1u)) >> 16; }
__device__ __forceinline__ unsigned pk2(float lo, float hi) { return f2bf(lo) | (f2bf(hi) << 16); }
using pg8::gelu_tanh; using pg8::sigmoidf_;

#define XB_TMO      128
#define XB_XCNT(j)  (256  + 64 * (j))
#define XB_XSUB(j)  (1280 + 64 * (j))
#define XB_XGEN(j)  (2304 + 64 * (j))
#define XB_TOP      3328
#define XB_TOPGEN   3392
#define XCD_BAR_WORDS 3456
#define XB_SPIN_CAP (1u << 18)

__device__ __forceinline__ unsigned xb_ld(unsigned* p)              { return __hip_atomic_load(p, __ATOMIC_RELAXED, __HIP_MEMORY_SCOPE_AGENT); }
__device__ __forceinline__ unsigned xb_add(unsigned* p, unsigned v) { return __hip_atomic_fetch_add(p, v, __ATOMIC_RELAXED, __HIP_MEMORY_SCOPE_AGENT); }
__device__ __forceinline__ unsigned xb_xcc_id() { return (unsigned)__builtin_amdgcn_s_getreg((3 << 11) | 20) & 0xFu; }
#define XB_SPIN(cond, bar) do { unsigned _sp = 0; while (cond) { __builtin_amdgcn_s_sleep(1); \
    if ((++_sp & 255u) == 0u) { if (xb_ld(&(bar)[XB_TMO])) break; if (_sp > XB_SPIN_CAP) { atomicAdd(&(bar)[XB_TMO], 1u); break; } } } } while (0)

struct XcdBarrier {
    unsigned* bar; unsigned x;
    volatile LAS unsigned* st;
};

__device__ __forceinline__ XcdBarrier xcd_barrier_post(unsigned* bar, volatile LAS unsigned* st) {
    XcdBarrier b; b.bar = bar; b.x = xb_xcc_id(); b.st = st;
    if (threadIdx.x == 0) (void)xb_add(&bar[XB_XCNT(b.x)], 1u);
    return b;
}
__device__ __forceinline__ void xcd_barrier_complete(unsigned* bar, unsigned x, unsigned& nloc, unsigned& nx) {
    const unsigned G = gridDim.x * gridDim.y * gridDim.z;
    unsigned sum, cnt, mine, sp = 0u;
    for (;;) {
        sum = 0u; cnt = 0u; mine = 0u;
#pragma unroll
        for (unsigned j = 0; j < 16; ++j) { const unsigned c = xb_ld(&bar[XB_XCNT(j)]); sum += c; cnt += (c > 0u) ? 1u : 0u; mine = (j == x) ? c : mine; }
        if (sum == G) break;
        __builtin_amdgcn_s_sleep(1);
        if ((++sp & 255u) == 0u) { if (xb_ld(&bar[XB_TMO])) break; if (sp > XB_SPIN_CAP) { atomicAdd(&bar[XB_TMO], 1u); break; } }
    }
    nloc = mine > 0u ? mine : 1u; nx = cnt > 0u ? cnt : 1u;
}

__device__ __forceinline__ void xcd_barrier(const XcdBarrier& b) {
    asm volatile("s_waitcnt vmcnt(0)" ::: "memory");
    __syncthreads();
    if (threadIdx.x == 0) {
        unsigned* bar = b.bar;
        __builtin_amdgcn_s_waitcnt(0);
        unsigned nloc = b.st[0], nx = b.st[1];
        if (nloc == 0u) { xcd_barrier_complete(bar, b.x, nloc, nx); b.st[0] = nloc; b.st[1] = nx; }
        const unsigned old = xb_add(&bar[XB_XSUB(b.x)], 1u);
        const unsigned gen = old / nloc;
        if (old + 1u == (gen + 1u) * nloc) {
            __builtin_amdgcn_fence(__ATOMIC_RELEASE, "agent");
            asm volatile("s_waitcnt vmcnt(0)" ::: "memory");
            const unsigned og = xb_add(&bar[XB_TOP], 1u);
            const unsigned tg = og / nx;
            if (og + 1u == (tg + 1u) * nx) xb_add(&bar[XB_TOPGEN], 1u);
            else XB_SPIN(xb_ld(&bar[XB_TOPGEN]) == tg, bar);
            __builtin_amdgcn_fence(__ATOMIC_ACQUIRE, "agent");
            xb_add(&bar[XB_XGEN(b.x)], 1u);
            asm volatile("s_waitcnt vmcnt(0)" ::: "memory");
        } else {
            XB_SPIN(xb_ld(&bar[XB_XGEN(b.x)]) == gen, bar);
            __builtin_amdgcn_fence(__ATOMIC_ACQUIRE, "agent");
            asm volatile("s_waitcnt vmcnt(0)" ::: "memory");
        }
    }
    __syncthreads();
}


struct Args { const float* in[N_IN]; float* out; unsigned char* ws; int ph_lo, ph_hi; };
struct Frame {
    LAS unsigned char* lds;
    volatile LAS unsigned* MISC;
    gu32* ctl;
    int wave;
    int vcu, G;
    float* out; unsigned char* ws;
};
__device__ __forceinline__ int lane_id_() { int l = (int)__builtin_amdgcn_mbcnt_hi(~0u, __builtin_amdgcn_mbcnt_lo(~0u, 0u)); asm volatile("" : "+v"(l)); return l; }
#define LANE() lane_id_()
#define TID() (F.wave * 64 + lane_id_())
#define WSF(off) ((float*)(F.ws + (off)))
#define WSB(off) ((bf16*)(F.ws + (off)))
#define SMP(off) ((float*)(F.ws + WS_SMP) + (off))
#define SMB(off) ((bf16*)(F.ws + WS_SMP) + (off))

__device__ __forceinline__ float wave_sum(float v) {
#pragma unroll
    for (int o = 1; o < 64; o <<= 1) v += __shfl_xor(v, o);
    return v;
}
__device__ __forceinline__ void transpose_item(const float* W, int K, int N, const float* gain, bf16* WT, LAS float* scr, int item, int lane, bool headperm = false) {
    const int nblk = (N + 31) / 32, kb = item / nblk, nb = item % nblk, k0 = 64 * kb, n0 = 32 * nb;
    const int r0 = (headperm && n0 >= 1024 && n0 < 2304) ? (n0 & ~255) + 128 * ((n0 >> 5) & 1) + 32 * ((n0 & 255) >> 6) : n0;
    {   float wv[32]; const int n = n0 + (lane & 31);
#pragma unroll
        for (int i = 0; i < 32; ++i) wv[i] = (n < N) ? W[(size_t)(k0 + 2 * i + (lane >> 5)) * N + n] : 0.f;
#pragma unroll
        for (int i = 0; i < 32; ++i) { const int kk = 2 * i + (lane >> 5); float v = wv[i]; if (gain) v *= gain[k0 + kk]; scr[kk * 33 + (lane & 31)] = v; } }
    LDS_WAIT();
    const int c = lane & 7;
#pragma unroll
    for (int j = 0; j < 4; ++j) { const int n = (lane >> 3) + 8 * j; const LAS float* s = scr + (8 * c) * 33 + n;
        v4u o; o.x = pk2(s[0 * 33], s[1 * 33]); o.y = pk2(s[2 * 33], s[3 * 33]); o.z = pk2(s[4 * 33], s[5 * 33]); o.w = pk2(s[6 * 33], s[7 * 33]);
        *(GAS v4u*)(WT + (size_t)(r0 + n) * K + k0 + 8 * c) = o; }
    LDS_WAIT();
}
__device__ __forceinline__ void x_row_to_bf16(int lane, const float* xrow, bf16* orow, float* rsrow) {
    const GAS f32x4* xr = (const GAS f32x4*)xrow + lane;
    f32x4 v[4]; float s = 0.f;
#pragma unroll
    for (int j = 0; j < 4; ++j) { v[j] = xr[64 * j]; s += (v[j].x * v[j].x + v[j].y * v[j].y) + (v[j].z * v[j].z + v[j].w * v[j].w); }
    s = wave_sum(s);
    GAS unsigned long long* o8 = (GAS unsigned long long*)orow + lane;
#pragma unroll
    for (int j = 0; j < 4; ++j) o8[64 * j] = (unsigned long long)pk2(v[j].x, v[j].y) | ((unsigned long long)pk2(v[j].z, v[j].w) << 32);
    if (lane < 16) rsrow[lane] = (lane == 0) ? s : 0.f;
}
__device__ __forceinline__ void x_row2_to_bf16(int lane, const float* xrow, bf16* orow, float* rsrow) {
    const GAS f32x4* xr = (const GAS f32x4*)xrow + lane;
    f32x4 v[8]; float s0 = 0.f, s1 = 0.f;
#pragma unroll
    for (int j = 0; j < 8; ++j) v[j] = xr[64 * j];
#pragma unroll
    for (int j = 0; j < 4; ++j) { s0 += (v[j].x * v[j].x + v[j].y * v[j].y) + (v[j].z * v[j].z + v[j].w * v[j].w); s1 += (v[4 + j].x * v[4 + j].x + v[4 + j].y * v[4 + j].y) + (v[4 + j].z * v[4 + j].z + v[4 + j].w * v[4 + j].w); }
    s0 = wave_sum(s0); s1 = wave_sum(s1);
    GAS unsigned long long* o8 = (GAS unsigned long long*)orow + lane;
#pragma unroll
    for (int j = 0; j < 8; ++j) o8[64 * j] = (unsigned long long)pk2(v[j].x, v[j].y) | ((unsigned long long)pk2(v[j].z, v[j].w) << 32);
    if (lane < 32) rsrow[lane] = (lane == 0) ? s0 : (lane == 16 ? s1 : 0.f);
}
__device__ __forceinline__ void sample_rstd(Frame& F, const float* Amat, LAS float* rs) {
#pragma unroll
    for (int i = 0; i < 4; ++i) { const int r = F.wave * 4 + i; const f32x4* p = (const f32x4*)(Amat + (size_t)r * D) + LANE(); float s = 0.f;
#pragma unroll
        for (int j = 0; j < 4; ++j) { const f32x4 v = p[64 * j]; s += (v.x * v.x + v.y * v.y) + (v.z * v.z + v.w * v.w); }
        s = wave_sum(s); if (LANE() == 0) rs[r] = 1.0f / sqrtf(s * (1.0f / D) + EPS); }
    LDS_WAIT(); __syncthreads();
}
__device__ __forceinline__ float sgemm_cg(Frame& F, const float* Amat, int lda, const float* gain, const float* W, int N, int K, int n0, LAS float* red) {
    const int r = LANE() & 31, kh = LANE() >> 5, ksl = K / 16, k0 = (F.wave * 2 + kh) * ksl;
    f32x4 acc = {0.f, 0.f, 0.f, 0.f};
    const float* ap = Amat + (size_t)r * lda + k0;
#pragma unroll 4
    for (int k = 0; k < ksl; k += 4) {
        f32x4 a = *(const f32x4*)(ap + k);
        if (gain) a = a * *(const f32x4*)(gain + k0 + k);
        const float* wp = W + (size_t)(k0 + k) * N + n0;
        const f32x4 w0 = *(const f32x4*)wp, w1 = *(const f32x4*)(wp + N), w2 = *(const f32x4*)(wp + 2 * (size_t)N), w3 = *(const f32x4*)(wp + 3 * (size_t)N);
        acc += w0 * a.x; acc += w1 * a.y; acc += w2 * a.z; acc += w3 * a.w;
    }
#pragma unroll
    for (int j = 0; j < 4; ++j) acc[j] += __shfl_xor(acc[j], 32);
    if (kh == 0) *(LAS f32x4*)(red + (F.wave * 32 + r) * 4) = acc;
    LDS_WAIT(); __syncthreads();
    float s = 0.f;
    if (TID() < 128) { const int rr = TID() & 31, cc = TID() >> 5;
#pragma unroll
        for (int w = 0; w < 8; ++w) s += red[(w * 32 + rr) * 4 + cc]; }
    LDS_WAIT(); __syncthreads();
    return s;
}

#define SG_ROW(tid_) (16 * ((tid_) >> 8) + 4 * (((tid_) >> 6) & 3) + ((tid_) & 3))
#define SG_COL(tid_) (((tid_) >> 2) & 15)
typedef short bf16x8s __attribute__((ext_vector_type(8)));
__device__ __forceinline__ float sgemm16(Frame& F, const bf16* Abf, int K, const bf16* Wt, int ct, LAS float* red, const float* rs_src = nullptr, LAS float* rsl = nullptr) {
    const int lane = LANE(), r = lane & 15, q = lane >> 4, kw = K >> 3, k0 = F.wave * kw;
    f32x4 rv[4][4];
    if (rs_src) {
#pragma unroll
        for (int i = 0; i < 4; ++i)
#pragma unroll
            for (int j = 0; j < 4; ++j) rv[i][j] = *((const f32x4*)(rs_src + (size_t)(F.wave * 4 + i) * D) + lane + 64 * j); }
    const bf16* a0 = Abf + (size_t)r * K + k0 + 8 * q; const bf16* a1 = a0 + (size_t)16 * K; const bf16* bp = Wt + (size_t)(16 * ct + r) * K + k0 + 8 * q;
    f32x4 acc0 = {0.f, 0.f, 0.f, 0.f}, acc1 = {0.f, 0.f, 0.f, 0.f};
#pragma unroll 8
    for (int k = 0; k < kw; k += 32) { const bf16x8s x0 = *(const bf16x8s*)(a0 + k), x1 = *(const bf16x8s*)(a1 + k), w = *(const bf16x8s*)(bp + k);
        acc0 = __builtin_amdgcn_mfma_f32_16x16x32_bf16(x0, w, acc0, 0, 0, 0); acc1 = __builtin_amdgcn_mfma_f32_16x16x32_bf16(x1, w, acc1, 0, 0, 0); }
    *(LAS f32x4*)(red + (F.wave * 2 + 0) * 256 + lane * 4) = acc0; *(LAS f32x4*)(red + (F.wave * 2 + 1) * 256 + lane * 4) = acc1;
    if (rs_src) {
#pragma unroll
        for (int i = 0; i < 4; ++i) { float ss = 0.f;
#pragma unroll
            for (int j = 0; j < 4; ++j) { const f32x4 v = rv[i][j]; ss += (v.x * v.x + v.y * v.y) + (v.z * v.z + v.w * v.w); }
            ss = wave_sum(ss); if (lane == 0) rsl[F.wave * 4 + i] = 1.0f / sqrtf(ss * (1.0f / D) + EPS); } }
    LDS_WAIT(); __syncthreads();
    const int tid = TID(); float s = 0.f;
#pragma unroll
    for (int w = 0; w < 8; ++w) s += red[(w * 2 + (tid >> 8)) * 256 + (tid & 255)];
    LDS_WAIT(); __syncthreads();
    return s;
}

__device__ __forceinline__ float sgemm16_f32w(Frame& F, const float* Amat, const float* gain, const float* W, int N, int ct, LAS float* red) {
    const int lane = LANE(), r = lane & 15, q = lane >> 4, k0 = F.wave * 128 + 8 * q, n = 16 * ct + r; const bool nv = n < N;
    const float* a0 = Amat + (size_t)r * D + k0; const float* a1 = a0 + (size_t)16 * D; const float* wp = W + (size_t)k0 * N + (nv ? n : 0);
    f32x4 acc0 = {0.f, 0.f, 0.f, 0.f}, acc1 = {0.f, 0.f, 0.f, 0.f};
#pragma unroll
    for (int ks = 0; ks < 4; ++ks) {
        const f32x4 g0 = *(const f32x4*)(gain + k0 + 32 * ks), g1 = *(const f32x4*)(gain + k0 + 32 * ks + 4);
        const f32x4 p0 = *(const f32x4*)(a0 + 32 * ks) * g0, p1 = *(const f32x4*)(a0 + 32 * ks + 4) * g1, p2 = *(const f32x4*)(a1 + 32 * ks) * g0, p3 = *(const f32x4*)(a1 + 32 * ks + 4) * g1;
        float wv[8];
#pragma unroll
        for (int j = 0; j < 8; ++j) wv[j] = wp[(size_t)(32 * ks + j) * N];
        const v4u x0 = {pk2(p0[0], p0[1]), pk2(p0[2], p0[3]), pk2(p1[0], p1[1]), pk2(p1[2], p1[3])}, x1 = {pk2(p2[0], p2[1]), pk2(p2[2], p2[3]), pk2(p3[0], p3[1]), pk2(p3[2], p3[3])};
        v4u w = {pk2(wv[0], wv[1]), pk2(wv[2], wv[3]), pk2(wv[4], wv[5]), pk2(wv[6], wv[7])}; if (!nv) w = (v4u){0u, 0u, 0u, 0u};
        acc0 = __builtin_amdgcn_mfma_f32_16x16x32_bf16(__builtin_bit_cast(bf16x8s, x0), __builtin_bit_cast(bf16x8s, w), acc0, 0, 0, 0);
        acc1 = __builtin_amdgcn_mfma_f32_16x16x32_bf16(__builtin_bit_cast(bf16x8s, x1), __builtin_bit_cast(bf16x8s, w), acc1, 0, 0, 0); }
    *(LAS f32x4*)(red + (F.wave * 2 + 0) * 256 + lane * 4) = acc0; *(LAS f32x4*)(red + (F.wave * 2 + 1) * 256 + lane * 4) = acc1;
    LDS_WAIT(); __syncthreads();
    const int tid = TID(); float s = 0.f;
#pragma unroll
    for (int w = 0; w < 8; ++w) s += red[(w * 2 + (tid >> 8)) * 256 + (tid & 255)];
    LDS_WAIT(); __syncthreads();
    return s;
}

__device__ __forceinline__ void rg_ab(float rp, float ip, float cv, float lam, float& a, float& b) {
    const float r = 1.0f / (1.0f + expf(-rp)), i = 1.0f / (1.0f + expf(-ip));
    const float sp = log1pf(expf(-lam)); const float la = -8.0f * r * sp;
    a = expf(la); b = sqrtf(-expm1f(2.0f * la)) * (i * cv);
}

__device__ __forceinline__ void sample_post(Frame& F, const Args& A, int b) {
    const int lane = LANE(); const float* z = SMP(SM_ZS) + (size_t)b * EIN;
    const float* convw = A.in[I_CONVW]; const float* sc = A.in[I_SCONV] + (size_t)b * 3 * LRU;
    float* convs = F.out + O_CONVS + (size_t)b * 3 * LRU;
    for (int n = 0; n < 8; ++n) {
        const int ch = n * 64 + lane; const float xa = z[ch];
        const float s0 = sc[ch], s1 = sc[LRU + ch], s2 = sc[2 * LRU + ch];
        const float cv = A.in[I_CONVB][ch] + convw[ch] * s0 + convw[LRU + ch] * s1 + convw[2 * LRU + ch] * s2 + convw[3 * LRU + ch] * xa;
        convs[ch] = s1; convs[LRU + ch] = s2; convs[2 * LRU + ch] = xa;
        float rp = A.in[I_BA][ch], ip = A.in[I_BX][ch];
        const float* wa = A.in[I_WA] + (size_t)n * 4096 + lane; const float* wx = A.in[I_WX] + (size_t)n * 4096 + lane;
        for (int c = 0; c < 64; ++c) { const float cc = __shfl(cv, c); rp += cc * wa[c * 64]; ip += cc * wx[c * 64]; }
        float a, bb; rg_ab(rp, ip, cv, A.in[I_LAM][ch], a, bb);
        const float h = a * A.in[I_SH][(size_t)b * LRU + ch] + bb;
        F.out[O_HS + (size_t)b * LRU + ch] = h;
        { const float ya = h * gelu_tanh(z[LRU + ch]); SMP(SM_YABS)[(size_t)b * D + ch] = ya; SMB(SB_YABS)[(size_t)b * D + ch] = (bf16)f2bf(ya); }
    }
    {
        const float* q = z + 1024 + lane * 8; float v[8], ss = 0.f;
#pragma unroll
        for (int j = 0; j < 8; ++j) { v[j] = q[j]; ss += v[j] * v[j]; }
        ss += __shfl_xor(ss, 1); ss += __shfl_xor(ss, 2); ss += __shfl_xor(ss, 4);
        const float rstd = 1.0f / sqrtf(ss * (1.0f / 64.0f) + EPS);
#pragma unroll
        for (int j = 0; j < 8; ++j) SMP(SM_QS)[(size_t)b * 512 + lane * 8 + j] = v[j] * rstd * A.in[I_QG][(lane & 7) * 8 + j];
    }
    for (int s = 0; s < 6; ++s) {
        const float* p = z + 1536 + s * 128 + lane * 2; float v0 = p[0], v1 = p[1];
        if (s == 2 || s == 4) { float ss = v0 * v0 + v1 * v1;
#pragma unroll
            for (int o = 1; o < 32; o <<= 1) ss += __shfl_xor(ss, o);
            const float rstd = 1.0f / sqrtf(ss * (1.0f / 64.0f) + EPS); const float* kg = A.in[I_KG] + (s == 2 ? 64 : 128) + (lane & 31) * 2;
            v0 = v0 * rstd * kg[0]; v1 = v1 * rstd * kg[1]; }
        if (s < 4) { float* o = F.out + O_KVS + (size_t)b * 512 + s * 128 + lane * 2; o[0] = v0; o[1] = v1; }
        else { float* o = SMP(SM_WNS) + (size_t)b * 256 + (s - 4) * 128 + lane * 2; o[0] = v0; o[1] = v1;
               float* w = F.out + O_WINS + ((size_t)b * 512 + 511) * 256 + (s - 4) * 128 + lane * 2; w[0] = v0; w[1] = v1; }
    }
    if (lane < 24) SMP(SM_GATES)[b * 24 + lane] = sigmoidf_(z[2304 + lane]);
}
__host__ __device__ __forceinline__ int kv_off_k(int r, int d) { return (((r >> 4) * 2 + (d >> 5)) * 64 + ((d & 31) >> 3) * 16 + (r & 15)) * 8 + (d & 7); }
__host__ __device__ __forceinline__ int kv_off_v(int s, int d) { return 4096 + (((s >> 5) * 4 + (d >> 4)) * 64 + ((s & 31) >> 3) * 16 + (d & 15)) * 8 + (s & 7); }
#if FUSE_HEADNORM
__device__ __forceinline__ void ktile_token4(Frame& F, const Args& A, int t0) {
    const int lane = LANE(), l = lane & 31;
    f32x4 a[4];
#pragma unroll
    for (int i = 0; i < 4; ++i) a[i] = *(const f32x4*)((lane < 32) ? (F.out + O_KVP + (size_t)(t0 + i) * 512 + 256 + l * 4) : (WSF(WS_WINB) + (size_t)(t0 + i) * 256 + l * 4));
#pragma unroll
    for (int i = 0; i < 4; ++i) { const int t = t0 + i;
#if SEL_FP8
        if (lane < 32) { const int r = t & 63, d = 4 * (l & 15);
            int w = __builtin_amdgcn_cvt_pk_fp8_f32(a[i].x, a[i].y, 0, false); w = __builtin_amdgcn_cvt_pk_fp8_f32(a[i].z, a[i].w, w, true);
            *(int*)((unsigned char*)(WSB(WS_KVS) + (size_t)((t >> 6) * 2 + (l >> 4)) * 8192) + ((r >> 4) * 64 + ((d & 31) >> 3) * 16 + (r & 15)) * 16 + (d >> 5) * 8 + (d & 7)) = w; }
        else
#endif
        *(v2u*)(WSB(lane < 32 ? WS_KVS : WS_KVW) + (size_t)((t >> 6) * 2 + (l >> 4)) * 8192 + kv_off_k(t & 63, 4 * (l & 15))) = (v2u){pk2(a[i].x, a[i].y), pk2(a[i].z, a[i].w)}; }
}
#endif
__device__ __forceinline__ void head_norm_token(Frame& F, const Args& A, int t) {
    const int lane = LANE();
    {   float* q = WSF(WS_QR) + (size_t)t * 512 + lane * 8; f32x4 a = *(f32x4*)q, b = *(f32x4*)(q + 4);
        float ss = pg8::dot4(a) + pg8::dot4(b); ss += __shfl_xor(ss, 1); ss += __shfl_xor(ss, 2); ss += __shfl_xor(ss, 4);
        const float rstd = 1.0f / sqrtf(ss * (1.0f / 64.0f) + EPS); const float* g = A.in[I_QG] + (lane & 7) * 8;
        a = a * rstd * *(const f32x4*)g; b = b * rstd * *(const f32x4*)(g + 4); *(f32x4*)q = a; *(f32x4*)(q + 4) = b; }
    {   const int l = lane & 31; float* p = (lane < 32) ? (F.out + O_KVP + (size_t)t * 512 + 256 + l * 4) : (WSF(WS_WINB) + (size_t)t * 256 + l * 4);
        f32x4 a = *(f32x4*)p; float ss = pg8::dot4(a);
#pragma unroll
        for (int o = 1; o < 16; o <<= 1) ss += __shfl_xor(ss, o);
        const float rstd = 1.0f / sqrtf(ss * (1.0f / 64.0f) + EPS); const float* g = A.in[I_KG] + (lane < 32 ? 64 : 128) + (l & 15) * 4;
        a = a * rstd * *(const f32x4*)g; *(f32x4*)p = a;
#if SEL_FP8
        if (lane < 32) { const int r = t & 63, d = 4 * (l & 15);
            int w = __builtin_amdgcn_cvt_pk_fp8_f32(a.x, a.y, 0, false); w = __builtin_amdgcn_cvt_pk_fp8_f32(a.z, a.w, w, true);
            *(int*)((unsigned char*)(WSB(WS_KVS) + (size_t)((t >> 6) * 2 + (l >> 4)) * 8192) + ((r >> 4) * 64 + ((d & 31) >> 3) * 16 + (r & 15)) * 16 + (d >> 5) * 8 + (d & 7)) = w; }
        else
#endif
        *(v2u*)(WSB(lane < 32 ? WS_KVS : WS_KVW) + (size_t)((t >> 6) * 2 + (l >> 4)) * 8192 + kv_off_k(t & 63, 4 * (l & 15))) = (v2u){pk2(a.x, a.y), pk2(a.z, a.w)};
        if (t >= T - 512) {
            float* wo = F.out + O_WINP + (size_t)(t - (T - 512)) * 256;
            if (lane >= 32) *(f32x4*)(wo + l * 4) = a;
            else *(f32x4*)(wo + 128 + l * 4) = *(const f32x4*)(WSF(WS_WINB) + (size_t)t * 256 + 128 + l * 4);
        }
    }
    if (t >= T - 3) {
        const float* x = WSF(WS_XA) + (size_t)t * 512 + lane * 8; float* o = F.out + O_CONVP + (size_t)(t - (T - 3)) * 512 + lane * 8;
        *(f32x4*)o = *(const f32x4*)x; *(f32x4*)(o + 4) = *(const f32x4*)(x + 4);
    }
}

__host__ __device__ __forceinline__ int vt_slot(int r);

__device__ __forceinline__ void rg1_item(Frame& F, const Args& A, int sc, int n, LAS float* wscr) {
    typedef float f32x16 __attribute__((ext_vector_type(16)));
    const int lane = LANE(), ch = n * 64 + lane, t0 = sc * 64, l31 = lane & 31, lh = lane >> 5;
    const float* cw = A.in[I_CONVW];
    const float cw0 = cw[ch], cw1 = cw[LRU + ch], cw2 = cw[2 * LRU + ch], cw3 = cw[3 * LRU + ch], cb = A.in[I_CONVB][ch];
    const bf16* xab = WSB(WS_XA); bf16* HL = WSB(WS_HL); bf16* CP = WSB(WS_CP);
    float xm3 = 0.f, xm2 = 0.f, xm1 = 0.f;
    #define XAF(i_) __builtin_bit_cast(float, (unsigned)xab[(i_)] << 16)
    if (t0 > 0) { xm3 = XAF((size_t)(t0 - 3) * LRU + ch); xm2 = XAF((size_t)(t0 - 2) * LRU + ch); xm1 = XAF((size_t)(t0 - 1) * LRU + ch); }
    float h = 0.f, cp = 1.f;
    float ba2[2], bx2[2], sp2[2];
#pragma unroll
    for (int dt = 0; dt < 2; ++dt) { const int cd = n * 64 + dt * 32 + l31; ba2[dt] = A.in[I_BA][cd]; bx2[dt] = A.in[I_BX][cd]; sp2[dt] = -8.0f * log1pf(expf(-A.in[I_LAM][cd])); }
    for (int hf = 0; hf < 2; ++hf) {
        const int tb = t0 + hf * 32;
        LDS_WAIT();
        {   float xv[32];
#pragma unroll
            for (int i = 0; i < 32; ++i) xv[i] = XAF((size_t)(tb + i) * LRU + ch);
#pragma unroll
            for (int i = 0; i < 32; ++i) { const float x = xv[i];
                const float cv = cb + cw0 * xm3 + cw1 * xm2 + cw2 * xm1 + cw3 * x; xm3 = xm2; xm2 = xm1; xm1 = x;
                wscr[i * 65 + lane] = cv; } }
        LDS_WAIT();
        float ra[2][16], rb[2][16];
#pragma unroll
        for (int dt = 0; dt < 2; ++dt) {
            f32x16 pa, px;
#pragma unroll
            for (int r = 0; r < 16; ++r) { pa[r] = 0.f; px[r] = 0.f; }
            const float* wa = A.in[I_WA] + (size_t)n * 4096 + dt * 32 + l31 + lh * 64; const float* wx = A.in[I_WX] + (size_t)n * 4096 + dt * 32 + l31 + lh * 64;
            const LAS float* ap = wscr + l31 * 65 + lh;
#pragma unroll 1
            for (int kh = 0; kh < 2; ++kh) {
                float wav[16], wxv[16];
#pragma unroll
                for (int k2 = 0; k2 < 16; ++k2) { wav[k2] = wa[(kh * 16 + k2) * 128]; wxv[k2] = wx[(kh * 16 + k2) * 128]; }
#pragma unroll
                for (int k2 = 0; k2 < 16; ++k2) { const float av = ap[2 * (kh * 16 + k2)];
                    pa = __builtin_amdgcn_mfma_f32_32x32x2f32(av, wav[k2], pa, 0, 0, 0); px = __builtin_amdgcn_mfma_f32_32x32x2f32(av, wxv[k2], px, 0, 0, 0); } }
#pragma unroll
            for (int r = 0; r < 16; ++r) { const int tt = (r & 3) + 8 * (r >> 2) + 4 * lh;
                const float cv = wscr[tt * 65 + dt * 32 + l31];
                const float rg = __builtin_amdgcn_rcpf(1.0f + __expf(-(pa[r] + ba2[dt]))), ig = __builtin_amdgcn_rcpf(1.0f + __expf(-(px[r] + bx2[dt])));
                const float la = sp2[dt] * rg, x2 = 2.0f * la;
                const float om = x2 > -0.0625f ? -x2 * (1.0f + x2 * (0.5f + x2 * (0.16666667f + x2 * 0.041666668f))) : 1.0f - __expf(x2);
                ra[dt][r] = __expf(la); rb[dt][r] = __builtin_amdgcn_sqrtf(om) * (ig * cv); }
        }
        LDS_WAIT();
#pragma unroll
        for (int dt = 0; dt < 2; ++dt)
#pragma unroll
            for (int r = 0; r < 16; ++r) { const int tt = (r & 3) + 8 * (r >> 2) + 4 * lh; wscr[tt * 64 + dt * 32 + l31] = ra[dt][r]; wscr[2048 + tt * 64 + dt * 32 + l31] = rb[dt][r]; }
        LDS_WAIT();
#pragma unroll 8
        for (int i = 0; i < 32; ++i) { const float a = wscr[i * 64 + lane], b = wscr[2048 + i * 64 + lane];
            h = a * h + b; cp *= a; HL[(size_t)(tb + i) * LRU + ch] = (bf16)f2bf(h); CP[(size_t)(tb + i) * LRU + ch] = (bf16)f2bf(cp); }
    }
    WSF(WS_SUMP)[(size_t)sc * LRU + ch] = cp; WSF(WS_SUME)[(size_t)sc * LRU + ch] = h;
}
__device__ __forceinline__ void rg3_item(Frame& F, const Args& A, int sc, int n) {
    const int lane = LANE(), ch = n * 64 + lane, t0 = sc * 64;
    const float* SP = WSF(WS_SUMP) + ch; const float* SE = WSF(WS_SUME) + ch;
    float H = 0.f;
    int s = 0;
    for (; s + 8 <= sc; s += 8) { float p[8], e[8];
#pragma unroll
        for (int j = 0; j < 8; ++j) { p[j] = SP[(size_t)(s + j) * LRU]; e[j] = SE[(size_t)(s + j) * LRU]; }
#pragma unroll
        for (int j = 0; j < 8; ++j) H = p[j] * H + e[j]; }
    for (; s < sc; ++s) H = SP[(size_t)s * LRU] * H + SE[(size_t)s * LRU];
    const bf16* HL = WSB(WS_HL); const bf16* CP = WSB(WS_CP); const bf16* GG = WSB(WS_GG); bf16* Y = WSB(WS_YAB);
    float hlast = 0.f;
#pragma unroll 8
    for (int i = 0; i < 64; ++i) { const size_t t = (size_t)(t0 + i);
        const float h = __builtin_bit_cast(float, (unsigned)HL[t * LRU + ch] << 16) + __builtin_bit_cast(float, (unsigned)CP[t * LRU + ch] << 16) * H; hlast = h;
        Y[t * D + ch] = (bf16)f2bf(h * __builtin_bit_cast(float, (unsigned)GG[t * LRU + ch] << 16)); }
    if (sc == T / 64 - 1) F.out[O_HP + ch] = hlast;
}

__device__ __forceinline__ void cmp_prompt_item(Frame& F, const Args& A, int jq, int kv, LAS float* scr) {
    const int lane = LANE(); const float* W = A.in[kv ? I_CWV : I_CWK]; const float* pe = A.in[kv ? I_PEV : I_PEK]; const float* kvp = F.out + O_KVP;
    float acc[8];
#pragma unroll
    for (int o = 0; o < 8; ++o) acc[o] = 0.f;
    for (int i = 0; i < 32; ++i) {
        const float pv = pe[i * 64 + lane];
#pragma unroll
        for (int o = 0; o < 8; ++o) scr[lane * 8 + o] = kvp[(size_t)(32 * (4 * jq + (o >> 1)) + i) * 512 + kv * 128 + (o & 1) * 64 + lane] + pv;
        LDS_WAIT();
#pragma unroll 8
        for (int c = 0; c < 64; ++c) { const float w = W[(size_t)(i * 64 + c) * 64 + lane];
            const f32x4 x0 = *(const LAS f32x4*)(scr + c * 8), x1 = *(const LAS f32x4*)(scr + c * 8 + 4);
            acc[0] += x0.x * w; acc[1] += x0.y * w; acc[2] += x0.z * w; acc[3] += x0.w * w; acc[4] += x1.x * w; acc[5] += x1.y * w; acc[6] += x1.z * w; acc[7] += x1.w * w; }
        LDS_WAIT();
    }
    float* dst = WSF(kv ? WS_VC : WS_KC);
#pragma unroll
    for (int o = 0; o < 8; ++o) { float v = acc[o];
        if (kv == 0) { const float ss = wave_sum(v * v); v = v * (1.0f / sqrtf(ss * (1.0f / 64.0f) + EPS)) * A.in[I_KG][lane]; }
        dst[(size_t)((4 * jq + (o >> 1)) * 2 + (o & 1)) * 64 + lane] = v;
        const int j = 4 * jq + (o >> 1), gg = o & 1;
        bf16* tile = WSB(WS_KVC) + (size_t)((j >> 6) * 2 + gg) * 8192;
        if (kv == 0) tile[kv_off_k(j & 63, lane)] = (bf16)f2bf(v);
        else tile[kv_off_v(vt_slot(j & 63), lane)] = (bf16)f2bf(v); }
}
__device__ __forceinline__ void cmp_sample_item(Frame& F, const Args& A, int b, int pg) {
    LAS float* xs = (LAS float*)(F.lds + RING_OFF);
    LAS float* red = (LAS float*)(F.lds + RING_OFF + 65536);
    const int lane = LANE(), phys = ((const int*)A.in[I_PT])[b * NPG + pg];
    for (int kv = 0; kv < 2; ++kv) {
        const float* W = A.in[kv ? I_CWV : I_CWK]; const float* pe = A.in[kv ? I_PEV : I_PEK];
        for (int idx = TID(); idx < 128 * 32; idx += NWAVES * 64) { const int r = idx >> 5, q = idx & 31;
            const f32x4 v = *(const f32x4*)(A.in[I_CKV] + ((size_t)(phys * 128 + r) * 4 + kv) * 128 + q * 4), p4 = *(const f32x4*)(pe + (r & 31) * 64 + (q & 15) * 4);
            *(LAS f32x4*)(xs + r * 128 + q * 4) = v + p4; }
        LDS_WAIT(); __syncthreads();
        float acc[8];
#pragma unroll
        for (int o = 0; o < 8; ++o) acc[o] = 0.f;
        for (int ii = 0; ii < 4; ++ii) { const int i = 4 * F.wave + ii;
#pragma unroll 2
            for (int c = 0; c < 64; c += 4) {
                const float w0 = W[(size_t)(i * 64 + c) * 64 + lane], w1 = W[(size_t)(i * 64 + c + 1) * 64 + lane], w2 = W[(size_t)(i * 64 + c + 2) * 64 + lane], w3 = W[(size_t)(i * 64 + c + 3) * 64 + lane];
#pragma unroll
                for (int o = 0; o < 8; ++o) { const f32x4 x = *(const LAS f32x4*)(xs + ((o >> 1) * 32 + i) * 128 + (o & 1) * 64 + c);
                    acc[o] += (x.x * w0 + x.y * w1) + (x.z * w2 + x.w * w3); }
            }
        }
#pragma unroll
        for (int o = 0; o < 8; ++o) red[(F.wave * 8 + o) * 64 + lane] = acc[o];
        LDS_WAIT(); __syncthreads();
        {   const int o = F.wave; float v = 0.f;
#pragma unroll
            for (int w = 0; w < 8; ++w) v += red[(w * 8 + o) * 64 + lane];
            if (kv == 0) { const float ss = wave_sum(v * v); v = v * (1.0f / sqrtf(ss * (1.0f / 64.0f) + EPS)) * A.in[I_KG][lane]; }
            WSF(kv ? WS_VCS : WS_KCS)[((size_t)(b * 512 + 4 * pg + (o >> 1)) * 2 + (o & 1)) * 64 + lane] = v; }
        LDS_WAIT(); __syncthreads();
    }
}

constexpr int AW_SC = 0, AW_IMP = 8192, AW_PT = 9472, AW_SEL = 9728, AW_Q = 9792;
struct SrcPromptCmp { const float* kc; const float* vc; const LAS float* btab; int t, g;
    __device__ __forceinline__ bool valid(int) const { return true; }
    __device__ __forceinline__ float bias(int k, int hh) const { int d = t - (32 * k + 31); d = d > 113 ? 113 : d; return btab[d * 8 + g * 4 + hh]; }
    __device__ __forceinline__ const float* kptr(int k) const { return kc + (size_t)(k * 2 + g) * 64; }
    __device__ __forceinline__ const float* vptr(int k) const { return vc + (size_t)(k * 2 + g) * 64; } };
struct SrcPromptSel { const float* kvp; const LAS float* btab; const LAS int* sel; int t, g;
    __device__ __forceinline__ int kpos(int k) const { return sel[k >> 6] * 64 + (k & 63); }
    __device__ __forceinline__ bool valid(int k) const { return kpos(k) <= t; }
    __device__ __forceinline__ float bias(int k, int hh) const { int d = t - kpos(k); d = d > 113 ? 113 : d; return btab[d * 8 + g * 4 + hh]; }
    __device__ __forceinline__ const float* kptr(int k) const { return kvp + (size_t)kpos(k) * 512 + 256 + g * 64; }
    __device__ __forceinline__ const float* vptr(int k) const { return kvp + (size_t)kpos(k) * 512 + 384 + g * 64; } };
struct SrcPromptWin { const float* winb; const LAS float* btab; int t, g;
    __device__ __forceinline__ bool valid(int k) const { return t - 511 + k >= 0; }
    __device__ __forceinline__ float bias(int k, int hh) const { int d = 511 - k; d = d > 113 ? 113 : d; return btab[d * 8 + g * 4 + hh]; }
    __device__ __forceinline__ const float* kptr(int k) const { return winb + (size_t)(t - 511 + k) * 256 + g * 64; }
    __device__ __forceinline__ const float* vptr(int k) const { return winb + (size_t)(t - 511 + k) * 256 + 128 + g * 64; } };
struct SrcSampleCmp { const float* kc; const float* vc; const LAS float* btab; int g;
    __device__ __forceinline__ bool valid(int) const { return true; }
    __device__ __forceinline__ float bias(int k, int hh) const { int d = T - (32 * k + 31); d = d > 113 ? 113 : d; return btab[d * 8 + g * 4 + hh]; }
    __device__ __forceinline__ const float* kptr(int k) const { return kc + (size_t)(k * 2 + g) * 64; }
    __device__ __forceinline__ const float* vptr(int k) const { return vc + (size_t)(k * 2 + g) * 64; } };
struct SrcSampleSel { const float* cache; const int* pt; const float* newrow; const LAS float* btab; const LAS int* sel; int g;
    __device__ __forceinline__ int kpos(int k) const { return sel[k >> 6] * 64 + (k & 63); }
    __device__ __forceinline__ bool valid(int k) const { return kpos(k) <= T; }
    __device__ __forceinline__ float bias(int k, int hh) const { int d = T - kpos(k); d = d > 113 ? 113 : d; return btab[d * 8 + g * 4 + hh]; }
    __device__ __forceinline__ const float* rowp(int k, int s) const { const int kp = kpos(k); if (kp >= T) return newrow + s * 128 + g * 64;
        const int phys = pt[kp >> 7]; return cache + ((size_t)(phys * 128 + (kp & 127)) * 4 + s) * 128 + g * 64; }
    __device__ __forceinline__ const float* kptr(int k) const { return rowp(k, 2); }
    __device__ __forceinline__ const float* vptr(int k) const { return rowp(k, 3); } };
struct SrcSampleWin { const float* cwin; const float* wns; const LAS float* btab; int g;
    __device__ __forceinline__ bool valid(int) const { return true; }
    __device__ __forceinline__ float bias(int k, int hh) const { int d = 511 - k; d = d > 113 ? 113 : d; return btab[d * 8 + g * 4 + hh]; }
    __device__ __forceinline__ const float* kptr(int k) const { return k < 511 ? cwin + (size_t)(k + 1) * 256 + g * 64 : wns + g * 64; }
    __device__ __forceinline__ const float* vptr(int k) const { return k < 511 ? cwin + (size_t)(k + 1) * 256 + 128 + g * 64 : wns + 128 + g * 64; } };

template <class Src, bool STASH>
__device__ __forceinline__ void attn_branch(const Src& S, int nkeys, LAS float* wscr, float& m, float& l, float (&o)[4], int lane) {
    const int kk = lane >> 2, hh = lane & 3;
    LAS float* pt = (LAS float*)((LAS unsigned char*)wscr + AW_PT); LAS float* sc = (LAS float*)((LAS unsigned char*)wscr + AW_SC);
    m = -1e30f; l = 0.f; o[0] = 0.f; o[1] = 0.f; o[2] = 0.f; o[3] = 0.f;
    for (int k0 = 0; k0 < nkeys; k0 += 16) {
        const int kidx = k0 + kk; const bool valid = kidx < nkeys && S.valid(kidx);
        float s = -1e30f;
        if (valid) { const f32x4* kr = (const f32x4*)S.kptr(kidx); const LAS f32x4* qv = (const LAS f32x4*)((LAS unsigned char*)wscr + AW_Q) + hh * 17; float d0 = 0.f, d1 = 0.f;
#pragma unroll 4
            for (int c = 0; c < 16; c += 2) { const f32x4 a = kr[c], b = kr[c + 1], qa = qv[c], qb = qv[c + 1];
                d0 += (a.x * qa.x + a.y * qa.y) + (a.z * qa.z + a.w * qa.w);
                d1 += (b.x * qb.x + b.y * qb.y) + (b.z * qb.z + b.w * qb.w); }
            s = (d0 + d1) * 0.125f + S.bias(kidx, hh); }
        if (STASH) sc[kidx * 4 + hh] = s;
        float mt = s; mt = fmaxf(mt, __shfl_xor(mt, 4)); mt = fmaxf(mt, __shfl_xor(mt, 8)); mt = fmaxf(mt, __shfl_xor(mt, 16)); mt = fmaxf(mt, __shfl_xor(mt, 32));
        const float mn = fmaxf(m, mt), alpha = __expf(m - mn), p = valid ? __expf(s - mn) : 0.f;
        float ps = p; ps += __shfl_xor(ps, 4); ps += __shfl_xor(ps, 8); ps += __shfl_xor(ps, 16); ps += __shfl_xor(ps, 32);
        l = l * alpha + ps; m = mn;
        pt[lane] = p;
        LDS_WAIT();
#pragma unroll
        for (int h = 0; h < 4; ++h) o[h] *= __shfl(alpha, h);
        const int nk = (nkeys - k0) < 16 ? (nkeys - k0) : 16;
        for (int j = 0; j < nk; ++j) { const f32x4 pj = *(const LAS f32x4*)(pt + j * 4);
            if (pj.x == 0.f && pj.y == 0.f && pj.z == 0.f && pj.w == 0.f) continue;
            const float v = S.vptr(k0 + j)[lane];
            o[0] += pj.x * v; o[1] += pj.y * v; o[2] += pj.z * v; o[3] += pj.w * v; }
        LDS_WAIT();
    }
}
template <bool EXP2 = false>
__device__ __forceinline__ void attn_importance(int nkeys, LAS float* wscr, float m, float l, int lane) {
    const int kk = lane >> 2, hh = lane & 3;
    const LAS float* sc = (const LAS float*)((LAS unsigned char*)wscr + AW_SC); LAS float* imp = (LAS float*)((LAS unsigned char*)wscr + AW_IMP);
    const float rl = l > 0.f ? 1.0f / l : 0.f;
    for (int k0 = 0; k0 < 512; k0 += 16) { const int kidx = k0 + kk;
        float p = (kidx < nkeys && l > 0.f) ? (EXP2 ? __builtin_amdgcn_exp2f(sc[kidx * 4 + hh] - m) : __expf(sc[kidx * 4 + hh] - m)) * rl : 0.f;
        p += __shfl_xor(p, 1); p += __shfl_xor(p, 2); p += __shfl_xor(p, 4);
        if ((lane & 7) == 0) imp[kidx >> 1] = p; }
    if (lane < 64) imp[256 + lane] = 0.f;
    LDS_WAIT();
}
__device__ __forceinline__ int attn_topk(int nsb, int cur, LAS float* wscr, int lane) {
    const LAS float* imp = (const LAS float*)((LAS unsigned char*)wscr + AW_IMP); LAS int* sel = (LAS int*)((LAS unsigned char*)wscr + AW_SEL);
    float v[5];
#pragma unroll
    for (int i = 0; i < 5; ++i) { const int sb = lane + 64 * i;
        v[i] = (sb >= nsb || sb > cur) ? -1.0f : ((sb == 0 || sb == cur || sb == cur - 1) ? 1.0e4f : imp[sb]); }
    int nsel = 0;
    for (int it = 0; it < 16; ++it) {
        float bv = v[0]; int bi = lane;
#pragma unroll
        for (int i = 1; i < 5; ++i) if (v[i] > bv) { bv = v[i]; bi = lane + 64 * i; }
#pragma unroll
        for (int off = 32; off >= 1; off >>= 1) { const float ov = __shfl_xor(bv, off); const int oi = __shfl_xor(bi, off);
            if (ov > bv || (ov == bv && oi < bi)) { bv = ov; bi = oi; } }
        if (bv < 0.f) break;
        if (lane == 0) sel[nsel] = bi;
        ++nsel;
#pragma unroll
        for (int i = 0; i < 5; ++i) if (bi == lane + 64 * i) v[i] = -2.0f;
    }
    LDS_WAIT();
    return nsel;
}
__device__ __forceinline__ void attn_accum(float (&of)[4], const float (&o)[4], float l, float gate_h_unused, const float* gates3, int j, int lane) {
#pragma unroll
    for (int h = 0; h < 4; ++h) { const float lh = __shfl(l, h); if (lh > 0.f) of[h] += gates3[h * 3 + j] * o[h] / lh; }
}
__device__ __forceinline__ void attn_prompt_item(Frame& F, const Args& A, int t, int g, LAS float* wscr, const LAS float* btab) {
    const int lane = LANE();
    {
        const f32x4 v = *((const f32x4*)(WSF(WS_QR) + (size_t)t * 512 + g * 256) + lane);
        *((LAS f32x4*)((LAS unsigned char*)wscr + AW_Q) + (lane >> 4) * 17 + (lane & 15)) = v; LDS_WAIT(); }
    const float* g3 = WSF(WS_GATE) + (size_t)t * 24 + g * 12;
    float of[4] = {0.f, 0.f, 0.f, 0.f}, o[4], m, l;
    const int nvis = (t + 1) >> 5, cur = t >> 6;
    {   SrcPromptCmp S{WSF(WS_KC), WSF(WS_VC), btab, t, g};
        attn_branch<SrcPromptCmp, true>(S, nvis, wscr, m, l, o, lane);
        attn_accum(of, o, l, 0.f, g3, 0, lane);
        attn_importance(nvis, wscr, m, l, lane); }
    const int nsel = attn_topk(256, cur, wscr, lane);
    {   SrcPromptSel S{F.out + O_KVP, btab, (const LAS int*)((LAS unsigned char*)wscr + AW_SEL), t, g};
        attn_branch<SrcPromptSel, false>(S, nsel * 64, wscr, m, l, o, lane);
        attn_accum(of, o, l, 0.f, g3, 1, lane); }
    {   SrcPromptWin S{WSF(WS_WINB), btab, t, g};
        attn_branch<SrcPromptWin, false>(S, 512, wscr, m, l, o, lane);
        attn_accum(of, o, l, 0.f, g3, 2, lane); }
    bf16* y = WSB(WS_YAB) + (size_t)t * D + 512 + g * 256 + lane;
#pragma unroll
    for (int h = 0; h < 4; ++h) y[h * 64] = (bf16)f2bf(of[h]);
}
__device__ __forceinline__ void attn_sample_item(Frame& F, const Args& A, int b, int g, LAS float* wscr, const LAS float* btab) {
    const int lane = LANE();
    {   const f32x4 v = *((const f32x4*)(SMP(SM_QS) + (size_t)b * 512 + g * 256) + lane);
        *((LAS f32x4*)((LAS unsigned char*)wscr + AW_Q) + (lane >> 4) * 17 + (lane & 15)) = v; LDS_WAIT(); }
    const float* g3 = SMP(SM_GATES) + b * 24 + g * 12;
    float of[4] = {0.f, 0.f, 0.f, 0.f}, o[4], m, l;
    {   SrcSampleCmp S{WSF(WS_KCS) + (size_t)b * 512 * 128, WSF(WS_VCS) + (size_t)b * 512 * 128, btab, g};
        attn_branch<SrcSampleCmp, true>(S, 512, wscr, m, l, o, lane);
        attn_accum(of, o, l, 0.f, g3, 0, lane);
        attn_importance(512, wscr, m, l, lane); }
    const int nsel = attn_topk(257, 256, wscr, lane);
    {   SrcSampleSel S{A.in[I_CKV], (const int*)A.in[I_PT] + b * NPG, F.out + O_KVS + (size_t)b * 512, btab, (const LAS int*)((LAS unsigned char*)wscr + AW_SEL), g};
        attn_branch<SrcSampleSel, false>(S, nsel * 64, wscr, m, l, o, lane);
        attn_accum(of, o, l, 0.f, g3, 1, lane); }
    {   SrcSampleWin S{A.in[I_CWIN] + (size_t)b * 512 * 256, SMP(SM_WNS) + (size_t)b * 256, btab, g};
        attn_branch<SrcSampleWin, false>(S, 512, wscr, m, l, o, lane);
        attn_accum(of, o, l, 0.f, g3, 2, lane); }
    float* y = SMP(SM_YABS) + (size_t)b * D + 512 + g * 256 + lane;
#pragma unroll
    for (int h = 0; h < 4; ++h) y[h * 64] = of[h];
}

typedef short bf16x8v __attribute__((ext_vector_type(8)));
__host__ __device__ __forceinline__ int vt_slot(int r) { const int rr = r & 31; return 32 * (r >> 5) + (rr < 16 ? 8 * (rr >> 2) + (rr & 3) : 8 * ((rr - 16) >> 2) + 4 + (rr & 3)); }
__device__ __forceinline__ void build_vt_block(const float* vsrc, int ldv, bf16* vt, int lane) {
    unsigned pk[32];
#pragma unroll
    for (int s2 = 0; s2 < 32; ++s2) {
        const int s0 = 2 * s2, i2 = s0 >> 5, q = (s0 & 31) >> 3, j = s0 & 7;
        const int r0 = 32 * i2 + (j < 4 ? 4 * q + j : 16 + 4 * q + (j - 4));
        const float a = vsrc[(size_t)r0 * ldv + lane], b = vsrc[(size_t)(r0 + 1) * ldv + lane];
        pk[s2] = pk2(a, b); }
#pragma unroll
    for (int i = 0; i < 8; ++i) *(v4u*)(vt + kv_off_v(32 * (i >> 2) + 8 * (i & 3), lane)) = (v4u){pk[4 * i], pk[4 * i + 1], pk[4 * i + 2], pk[4 * i + 3]};
}
#define MFMA16(a, b, c) __builtin_amdgcn_mfma_f32_16x16x32_bf16((a), (b), (c), 0, 0, 0)
struct KVFrag { bf16x8v kf[4][2]; bf16x8v vf[2][4]; };
#if KV_NT
#define KV_LD(p) __builtin_nontemporal_load(p)
#else
#define KV_LD(p) (*(p))
#endif
template <bool WITH_V>
__device__ __forceinline__ void kv_load(KVFrag& f, const bf16* KV, int b, int g, int lane) {
    const bf16* p = KV + (size_t)(b * 2 + g) * 8192 + lane * 8;
#pragma unroll
    for (int kt = 0; kt < 4; ++kt)
#pragma unroll
        for (int ks = 0; ks < 2; ++ks) f.kf[kt][ks] = KV_LD((const bf16x8v*)(p + (kt * 2 + ks) * 512));
    if (WITH_V) {
#pragma unroll
        for (int i2 = 0; i2 < 2; ++i2)
#pragma unroll
            for (int dt = 0; dt < 4; ++dt) f.vf[i2][dt] = KV_LD((const bf16x8v*)(p + 4096 + (i2 * 4 + dt) * 512)); }
}
template <int MODE, bool STASH>
__device__ __forceinline__ void mf_block(const KVFrag& f, int b, int t, int lo, int g, const bf16x8v (&qf)[2], const LAS float* btab2, LAS float* sc,
                                         float& l, f32x4 (&o)[4], int q4, int c) {
    const int hh = c & 3;
    f32x4 s[4];
#pragma unroll
    for (int kt = 0; kt < 4; ++kt) { s[kt] = MFMA16(f.kf[kt][0], qf[0], ((f32x4){0.f, 0.f, 0.f, 0.f})); s[kt] = MFMA16(f.kf[kt][1], qf[1], s[kt]); }
    const int kmax = b * 64 + 63, pmax = MODE == 0 ? 32 * kmax + 31 : kmax, pmin = MODE == 0 ? 32 * (b * 64) + 31 : b * 64;
    const bool far = (t - pmax >= 113) && (pmin > lo);
    if (far) { const float bb = btab2[113 * 8 + g * 4 + hh];
#pragma unroll
        for (int kt = 0; kt < 4; ++kt)
#pragma unroll
            for (int j = 0; j < 4; ++j) s[kt][j] = fminf(s[kt][j] + bb, 64.0f);
    } else {
#pragma unroll
        for (int kt = 0; kt < 4; ++kt)
#pragma unroll
            for (int j = 0; j < 4; ++j) { const int k = b * 64 + 16 * kt + 4 * q4 + j, pos = MODE == 0 ? 32 * k + 31 : k; const bool ok = pos <= t && pos > lo;
                int d = t - pos; d = d < 0 ? 0 : (d > 113 ? 113 : d);
                const float bias = btab2[d * 8 + g * 4 + hh];
                s[kt][j] = ok ? fminf(s[kt][j] + bias, 64.0f) : -1e30f; }
    }
    if (STASH) {
#pragma unroll
        for (int kt = 0; kt < 4; ++kt)
#pragma unroll
            for (int j = 0; j < 4; ++j) { if (c < 4) sc[(b * 64 + 16 * kt + 4 * q4 + j) * 4 + c] = s[kt][j]; }
    }
#pragma unroll
    for (int kt = 0; kt < 4; ++kt)
#pragma unroll
        for (int j = 0; j < 4; ++j) { const float p = __builtin_amdgcn_exp2f(s[kt][j]); s[kt][j] = p; l += p; }
    if (!STASH) {
        bf16x8v pf[2];
#pragma unroll
        for (int i2 = 0; i2 < 2; ++i2) { v4u w; w.x = pg8::cvt_pk_bf16(s[2 * i2][0], s[2 * i2][1]); w.y = pg8::cvt_pk_bf16(s[2 * i2][2], s[2 * i2][3]); w.z = pg8::cvt_pk_bf16(s[2 * i2 + 1][0], s[2 * i2 + 1][1]); w.w = pg8::cvt_pk_bf16(s[2 * i2 + 1][2], s[2 * i2 + 1][3]);
            pf[i2] = __builtin_bit_cast(bf16x8v, w); }
#pragma unroll
        for (int dt = 0; dt < 4; ++dt) { o[dt] = MFMA16(f.vf[0][dt], pf[0], o[dt]); o[dt] = MFMA16(f.vf[1][dt], pf[1], o[dt]); }
    }
}
template <int MODE, bool STASH>
__device__ __forceinline__ void mf_branch(const bf16* KV, int nblk, int b0, const LAS int* sel, int t, int lo, int g, const bf16x8v (&qf)[2],
                                          const LAS float* btab, LAS float* wscr, float& l, f32x4 (&o)[4], int lane) {
    const int q4 = lane >> 4, c = lane & 15;
    LAS float* sc = (LAS float*)((LAS unsigned char*)wscr + AW_SC);
    l = 0.f;
#pragma unroll
    for (int dt = 0; dt < 4; ++dt) o[dt] = (f32x4){0.f, 0.f, 0.f, 0.f};
#if HOTBLK
#define MF_BLK(i_) (MODE == 0 ? (i_) : (MODE == 1 ? (__builtin_amdgcn_readfirstlane(sel[(i_)]) & 1) : (b0 & 1) + ((i_) & 1)))
#else
#define MF_BLK(i_) (MODE == 0 ? (i_) : (MODE == 1 ? __builtin_amdgcn_readfirstlane(sel[(i_)]) : b0 + (i_)))
#endif
#if ATTN_DBUF
    if (!STASH) {
        KVFrag f0, f1;
        if (nblk > 0) kv_load<true>(f0, KV, MF_BLK(0), g, lane);
        for (int i = 0; i < nblk; i += 2) {
            const int bA = MF_BLK(i); const bool hasB = i + 1 < nblk; const int bB = hasB ? MF_BLK(i + 1) : bA;
            if (hasB) kv_load<true>(f1, KV, bB, g, lane);
            mf_block<MODE, STASH>(f0, bA, t, lo, g, qf, btab, sc, l, o, q4, c);
            if (hasB) { if (i + 2 < nblk) kv_load<true>(f0, KV, MF_BLK(i + 2), g, lane); mf_block<MODE, STASH>(f1, bB, t, lo, g, qf, btab, sc, l, o, q4, c); }
        }
    } else
#endif
    for (int i = 0; i < nblk; ++i) { const int bA = MF_BLK(i); KVFrag f0; kv_load<!STASH>(f0, KV, bA, g, lane); mf_block<MODE, STASH>(f0, bA, t, lo, g, qf, btab, sc, l, o, q4, c); }
#undef MF_BLK
    l += __shfl_xor(l, 16); l += __shfl_xor(l, 32);
}
__device__ __forceinline__ void mf_cmp_pv(const bf16* KV, int nblk, int g, const LAS float* wscr, f32x4 (&o)[4], int lane) {
    const int q4 = lane >> 4, c = lane & 15, hh = c & 3;
    const LAS float* sc = (const LAS float*)((const LAS unsigned char*)wscr + AW_SC);
    for (int b = 0; b < nblk; ++b) {
        const bf16* vp = KV + (size_t)(b * 2 + g) * 8192 + 4096 + lane * 8;
        bf16x8v vf[2][4];
#pragma unroll
        for (int i2 = 0; i2 < 2; ++i2)
#pragma unroll
            for (int dt = 0; dt < 4; ++dt) vf[i2][dt] = *(const bf16x8v*)(vp + (i2 * 4 + dt) * 512);
        float p[4][4];
#pragma unroll
        for (int kt = 0; kt < 4; ++kt)
#pragma unroll
            for (int j = 0; j < 4; ++j) p[kt][j] = __builtin_amdgcn_exp2f(sc[(b * 64 + 16 * kt + 4 * q4 + j) * 4 + hh]);
#pragma unroll
        for (int i2 = 0; i2 < 2; ++i2) { v4u w; w.x = pg8::cvt_pk_bf16(p[2 * i2][0], p[2 * i2][1]); w.y = pg8::cvt_pk_bf16(p[2 * i2][2], p[2 * i2][3]); w.z = pg8::cvt_pk_bf16(p[2 * i2 + 1][0], p[2 * i2 + 1][1]); w.w = pg8::cvt_pk_bf16(p[2 * i2 + 1][2], p[2 * i2 + 1][3]);
            const bf16x8v pf = __builtin_bit_cast(bf16x8v, w);
#pragma unroll
            for (int dt = 0; dt < 4; ++dt) o[dt] = MFMA16(vf[i2][dt], pf, o[dt]); }
    }
}
__device__ __forceinline__ int mf_select(int nkeys, int nsb, int cur, LAS float* wscr, float l, int lane, bool excl = false, int K = 16) {
    const LAS f32x4* sc4 = (const LAS f32x4*)((const LAS unsigned char*)wscr + AW_SC); LAS int* sel = (LAS int*)((LAS unsigned char*)wscr + AW_SEL);
    float rl[4];
#pragma unroll
    for (int h = 0; h < 4; ++h) { const float lh = __builtin_bit_cast(float, __builtin_amdgcn_readlane(__builtin_bit_cast(int, l), h)); rl[h] = lh > 0.f ? 1.0f / lh : 0.f; }
    int v[5];
#pragma unroll
    for (int i = 0; i < 5; ++i) { const int sb = lane + 64 * i; float imp = 0.f;
        if (i < 4) {
#pragma unroll
            for (int j = 0; j < 2; ++j) { const int k = 2 * sb + j; if (k < nkeys) { const f32x4 x = sc4[k];
                imp += __builtin_amdgcn_exp2f(x.x) * rl[0] + __builtin_amdgcn_exp2f(x.y) * rl[1] + __builtin_amdgcn_exp2f(x.z) * rl[2] + __builtin_amdgcn_exp2f(x.w) * rl[3]; } } }
        const float val = (sb >= nsb || sb > cur) ? -1.0f : ((sb == 0 || sb == cur || sb == cur - 1) ? (excl ? -1.0f : 1.0e4f) : imp);
        v[i] = __builtin_bit_cast(int, val); }
    int thr = 0;
#pragma unroll 1
    for (int bit = 30; bit >= 0; --bit) { const int tr = thr | (1 << bit); int cnt = 0;
#pragma unroll
        for (int i = 0; i < 5; ++i) cnt += __builtin_popcountll(__builtin_amdgcn_ballot_w64(v[i] >= tr));
        if (cnt >= K) thr = tr; }
    int n = 0;
    const unsigned lo_mask_lo = __builtin_amdgcn_mbcnt_lo(~0u, 0u);
    (void)lo_mask_lo;
#pragma unroll
    for (int pass = 0; pass < 2; ++pass)
#pragma unroll
        for (int i = 0; i < 5; ++i) { const bool pick = pass == 0 ? (v[i] > thr) : (v[i] == thr);
            const unsigned long long mk = __builtin_amdgcn_ballot_w64(pick);
            const int before = (int)__builtin_amdgcn_mbcnt_hi((unsigned)(mk >> 32), __builtin_amdgcn_mbcnt_lo((unsigned)mk, 0u));
            const int slot = n + before;
            if (pick && slot < K) sel[slot] = lane + 64 * i;
            n += __builtin_popcountll(mk); }
    LDS_WAIT();
    return n < K ? n : K;
}
__device__ __forceinline__ void attn_prompt_mfma(Frame& F, const Args& A, int t, int g, LAS float* wscr, const LAS float* btab, bf16* yab) {
    const int lane = LANE(), q4 = lane >> 4, c = lane & 15;
#if DBG_SECT >= 0
    LAS unsigned long long* tacc = (LAS unsigned long long*)((LAS unsigned char*)wscr + 16000); unsigned long long ts0 = __builtin_amdgcn_s_memrealtime(), ts1;
#define SECT(k) do { asm volatile("s_waitcnt vmcnt(0) lgkmcnt(0)" ::: "memory"); ts1 = __builtin_amdgcn_s_memrealtime(); if (lane == 0) tacc[k] += ts1 - ts0; ts0 = ts1; } while (0)
#else
#define SECT(k) do {} while (0)
#endif
    bf16x8v qf[2];
    {   const float* qp = WSF(WS_QR) + (size_t)t * 512 + (g * 4 + (c & 3)) * 64 + 8 * q4;
#pragma unroll
        for (int ks = 0; ks < 2; ++ks) { const f32x4 a = *(const f32x4*)(qp + 32 * ks), b = *(const f32x4*)(qp + 32 * ks + 4);
            v4u w; const float qs = 0.125f * 1.4426950408889634f; w.x = pk2(a.x * qs, a.y * qs); w.y = pk2(a.z * qs, a.w * qs); w.z = pk2(b.x * qs, b.y * qs); w.w = pk2(b.z * qs, b.w * qs);
            if (c >= 4) w = (v4u){0u, 0u, 0u, 0u};
            qf[ks] = __builtin_bit_cast(bf16x8v, w); } }
    SECT(0);
    const float* g3 = WSF(WS_GATE) + (size_t)t * 24 + (g * 4 + (c & 3)) * 3;
    f32x4 of[4], o[4]; float l;
#pragma unroll
    for (int dt = 0; dt < 4; ++dt) of[dt] = (f32x4){0.f, 0.f, 0.f, 0.f};
    const int nvis = (t + 1) >> 5, cur = t >> 6; float lcmp = 0.f;
    {
        const int nb = (nvis + 63) >> 6;
        mf_branch<0, true>(WSB(WS_KVC), nb, 0, nullptr, t, -1, g, qf, btab + 114 * 8, wscr, l, o, lane);
        LDS_WAIT();
        mf_cmp_pv(WSB(WS_KVC), nb, g, wscr, o, lane);
        lcmp = l;
        if (l > 0.f) { const float sc_ = g3[0] / l;
#pragma unroll
            for (int dt = 0; dt < 4; ++dt) of[dt] += o[dt] * sc_; }
    }
    SECT(1);
    const int nsel = mf_select(nvis, 256, cur, wscr, lcmp, lane);
    SECT(2);
    {   mf_branch<1, false>(WSB(WS_KVS), nsel, 0, (const LAS int*)((LAS unsigned char*)wscr + AW_SEL), t, -1, g, qf, btab + 114 * 8, wscr, l, o, lane);
        if (l > 0.f) { const float sc_ = g3[1] / l;
#pragma unroll
            for (int dt = 0; dt < 4; ++dt) of[dt] += o[dt] * sc_; } }
    SECT(3);
    {   const int bl = (t - 511) < 0 ? 0 : (t - 511) >> 6;
        mf_branch<2, false>(WSB(WS_KVW), cur - bl + 1, bl, nullptr, t, t - 512, g, qf, btab + 114 * 8, wscr, l, o, lane);
        if (l > 0.f) { const float sc_ = g3[2] / l;
#pragma unroll
            for (int dt = 0; dt < 4; ++dt) of[dt] += o[dt] * sc_; } }
    SECT(4);
    if (c < 4) { bf16* y = yab + (size_t)t * D + 512 + (g * 4 + c) * 64 + 4 * q4;
#pragma unroll
        for (int dt = 0; dt < 4; ++dt) *(v2u*)(y + 16 * dt) = (v2u){pk2(of[dt][0], of[dt][1]), pk2(of[dt][2], of[dt][3])}; }
    SECT(5);
#undef SECT
}

template <int MODE, bool STASH>
__device__ __forceinline__ void mfx_block(const KVFrag& f, int b, int tl, bool act, int tmin, int tmax, int g, const bf16x8v (&qf)[2], const LAS float* btab2, LAS float* sc,
                                          float& l, f32x4 (&o)[4], int q4, int c) {
    const int hh = c & 3;
    f32x4 s[4];
#pragma unroll
    for (int kt = 0; kt < 4; ++kt) { s[kt] = MFMA16(f.kf[kt][0], qf[0], ((f32x4){0.f, 0.f, 0.f, 0.f})); s[kt] = MFMA16(f.kf[kt][1], qf[1], s[kt]); }
    const int kmax = b * 64 + 63, pmax = MODE == 0 ? 32 * kmax + 31 : kmax, pmin = MODE == 0 ? 32 * (b * 64) + 31 : b * 64;
    const bool far = (tmin - pmax >= 113) && (MODE != 2 || pmin > tmax - 512);
    if (far) { const float bb = act ? btab2[113 * 8 + g * 4 + hh] : -1e30f;
#pragma unroll
        for (int kt = 0; kt < 4; ++kt)
#pragma unroll
            for (int j = 0; j < 4; ++j) s[kt][j] = fminf(s[kt][j] + bb, 64.0f);
    } else { const int lo = MODE == 2 ? tl - 512 : -1;
#pragma unroll
        for (int kt = 0; kt < 4; ++kt)
#pragma unroll
            for (int j = 0; j < 4; ++j) { const int k = b * 64 + 16 * kt + 4 * q4 + j, pos = MODE == 0 ? 32 * k + 31 : k; const bool ok = act && pos <= tl && pos > lo;
                int d = tl - pos; d = d < 0 ? 0 : (d > 113 ? 113 : d);
                const float bias = btab2[d * 8 + g * 4 + hh];
                s[kt][j] = ok ? fminf(s[kt][j] + bias, 64.0f) : -1e30f; }
    }
    if (STASH) {
#pragma unroll
        for (int kt = 0; kt < 4; ++kt)
#pragma unroll
            for (int j = 0; j < 4; ++j) { if (act) sc[(b * 64 + 16 * kt + 4 * q4 + j) * 4 + hh] = s[kt][j]; }
    }
#pragma unroll
    for (int kt = 0; kt < 4; ++kt)
#pragma unroll
        for (int j = 0; j < 4; ++j) { const float p = __builtin_amdgcn_exp2f(s[kt][j]); s[kt][j] = p; l += p; }
    if (!STASH) {
        bf16x8v pf[2];
#pragma unroll
        for (int i2 = 0; i2 < 2; ++i2) { v4u w; w.x = pg8::cvt_pk_bf16(s[2 * i2][0], s[2 * i2][1]); w.y = pg8::cvt_pk_bf16(s[2 * i2][2], s[2 * i2][3]); w.z = pg8::cvt_pk_bf16(s[2 * i2 + 1][0], s[2 * i2 + 1][1]); w.w = pg8::cvt_pk_bf16(s[2 * i2 + 1][2], s[2 * i2 + 1][3]);
            pf[i2] = __builtin_bit_cast(bf16x8v, w); }
#pragma unroll
        for (int dt = 0; dt < 4; ++dt) { o[dt] = MFMA16(f.vf[0][dt], pf[0], o[dt]); o[dt] = MFMA16(f.vf[1][dt], pf[1], o[dt]); }
    }
}
template <int MODE>
__device__ __forceinline__ void mfx_scores(const KVFrag& f, int b, int tl, bool act, int tmin, int tmax, int g, const bf16x8v (&qf)[2], const LAS float* btab2, int q4, int c, f32x4 (&s)[4]) {
    const int hh = c & 3;
#pragma unroll
    for (int kt = 0; kt < 4; ++kt) { s[kt] = MFMA16(f.kf[kt][0], qf[0], ((f32x4){0.f, 0.f, 0.f, 0.f})); s[kt] = MFMA16(f.kf[kt][1], qf[1], s[kt]); }
    const int kmax = b * 64 + 63, pmax = MODE == 0 ? 32 * kmax + 31 : kmax, pmin = MODE == 0 ? 32 * (b * 64) + 31 : b * 64;
    const bool far = (tmin - pmax >= 113) && (MODE != 2 || pmin > tmax - 512);
    if (far) { const float bb = act ? btab2[113 * 8 + g * 4 + hh] : -1e30f;
#pragma unroll
        for (int kt = 0; kt < 4; ++kt)
#pragma unroll
            for (int j = 0; j < 4; ++j) s[kt][j] = fminf(s[kt][j] + bb, 64.0f);
    } else { const int lo = MODE == 2 ? tl - 512 : -1;
#pragma unroll
        for (int kt = 0; kt < 4; ++kt)
#pragma unroll
            for (int j = 0; j < 4; ++j) { const int k = b * 64 + 16 * kt + 4 * q4 + j, pos = MODE == 0 ? 32 * k + 31 : k; const bool ok = act && pos <= tl && pos > lo;
                int d = tl - pos; d = d < 0 ? 0 : (d > 113 ? 113 : d);
                const float bias = btab2[d * 8 + g * 4 + hh];
                s[kt][j] = ok ? fminf(s[kt][j] + bias, 64.0f) : -1e30f; }
    }
}
__device__ __forceinline__ float dpp_xor1(float v) { return __builtin_bit_cast(float, __builtin_amdgcn_update_dpp(0, __builtin_bit_cast(int, v), 0xB1, 0xF, 0xF, true)); }
__device__ __forceinline__ float dpp_xor2(float v) { return __builtin_bit_cast(float, __builtin_amdgcn_update_dpp(0, __builtin_bit_cast(int, v), 0x4E, 0xF, 0xF, true)); }
__device__ __forceinline__ int mfx_cmp_pack(const bf16* KV, int t0, int tl, int g, const bf16x8v (&qf)[2], const LAS float* btab2, LAS float* impq, float& l, f32x4 (&o)[4], int lane) {
    const int q4 = lane >> 4, c = lane & 15, qc = c >> 2;
    const int nb = ((((t0 + 4) >> 5)) + 63) >> 6;
    l = 0.f;
#pragma unroll
    for (int dt = 0; dt < 4; ++dt) o[dt] = (f32x4){0.f, 0.f, 0.f, 0.f};
    for (int b = 0; b < nb; ++b) { KVFrag f; kv_load<false>(f, KV, b, g, lane); f32x4 s[4]; mfx_scores<0>(f, b, tl, true, t0, t0 + 3, g, qf, btab2, q4, c, s);
#pragma unroll
        for (int kt = 0; kt < 4; ++kt)
#pragma unroll
            for (int j = 0; j < 4; ++j) l += __builtin_amdgcn_exp2f(s[kt][j]); }
    l += __shfl_xor(l, 16); l += __shfl_xor(l, 32);
    const float rl = l > 0.f ? 1.0f / l : 0.f;
    for (int b = 0; b < nb; ++b) { KVFrag f; kv_load<true>(f, KV, b, g, lane); f32x4 s[4]; mfx_scores<0>(f, b, tl, true, t0, t0 + 3, g, qf, btab2, q4, c, s);
#pragma unroll
        for (int kt = 0; kt < 4; ++kt)
#pragma unroll
            for (int j = 0; j < 4; ++j) s[kt][j] = __builtin_amdgcn_exp2f(s[kt][j]);
#pragma unroll
        for (int kt = 0; kt < 4; ++kt)
#pragma unroll
            for (int jp = 0; jp < 2; ++jp) { float v = (s[kt][2 * jp] + s[kt][2 * jp + 1]) * rl; v += dpp_xor1(v); v += dpp_xor2(v);
                if ((c & 3) == 0) impq[qc * 256 + b * 32 + 8 * kt + 2 * q4 + jp] = v; }
        bf16x8v pf[2];
#pragma unroll
        for (int i2 = 0; i2 < 2; ++i2) { v4u w; w.x = pg8::cvt_pk_bf16(s[2 * i2][0], s[2 * i2][1]); w.y = pg8::cvt_pk_bf16(s[2 * i2][2], s[2 * i2][3]); w.z = pg8::cvt_pk_bf16(s[2 * i2 + 1][0], s[2 * i2 + 1][1]); w.w = pg8::cvt_pk_bf16(s[2 * i2 + 1][2], s[2 * i2 + 1][3]);
            pf[i2] = __builtin_bit_cast(bf16x8v, w); }
#pragma unroll
        for (int dt = 0; dt < 4; ++dt) { o[dt] = MFMA16(f.vf[0][dt], pf[0], o[dt]); o[dt] = MFMA16(f.vf[1][dt], pf[1], o[dt]); }
    }
    LDS_WAIT();
    return nb * 32;
}
__device__ __forceinline__ int mf_select_lds(const LAS float* imp, int nsbw, int nsb, int cur, LAS float* wscr, int lane, bool excl, int K) {
    LAS int* sel = (LAS int*)((LAS unsigned char*)wscr + AW_SEL);
    int v[5];
#pragma unroll
    for (int i = 0; i < 5; ++i) { const int sb = lane + 64 * i; const float im = (i < 4 && sb < nsbw) ? imp[sb] : 0.f;
        const float val = (sb >= nsb || sb > cur) ? -1.0f : ((sb == 0 || sb == cur || sb == cur - 1) ? (excl ? -1.0f : 1.0e4f) : im);
        v[i] = __builtin_bit_cast(int, val); }
    int thr = 0;
#pragma unroll 1
    for (int bit = 30; bit >= 0; --bit) { const int tr = thr | (1 << bit); int cnt = 0;
#pragma unroll
        for (int i = 0; i < 5; ++i) cnt += __builtin_popcountll(__builtin_amdgcn_ballot_w64(v[i] >= tr));
        if (cnt >= K) thr = tr; }
    int n = 0;
#pragma unroll
    for (int pass = 0; pass < 2; ++pass)
#pragma unroll
        for (int i = 0; i < 5; ++i) { const bool pick = pass == 0 ? (v[i] > thr) : (v[i] == thr);
            const unsigned long long mk = __builtin_amdgcn_ballot_w64(pick);
            const int before = (int)__builtin_amdgcn_mbcnt_hi((unsigned)(mk >> 32), __builtin_amdgcn_mbcnt_lo((unsigned)mk, 0u));
            const int slot = n + before;
            if (pick && slot < K) sel[slot] = lane + 64 * i;
            n += __builtin_popcountll(mk); }
    LDS_WAIT();
    return n < K ? n : K;
}
#if SEL_FP8
struct KVFrag8 { v4u k[4]; bf16x8v vf[2][4]; };
__device__ __forceinline__ void kv_load8(KVFrag8& f, const bf16* KV, int b, int g, int lane) {
    const unsigned char* p8 = (const unsigned char*)(KV + (size_t)(b * 2 + g) * 8192) + lane * 16;
#pragma unroll
    for (int kt = 0; kt < 4; ++kt) f.k[kt] = *(const v4u*)(p8 + kt * 1024);
    const bf16* p = KV + (size_t)(b * 2 + g) * 8192 + lane * 8;
#pragma unroll
    for (int i2 = 0; i2 < 2; ++i2)
#pragma unroll
        for (int dt = 0; dt < 4; ++dt) f.vf[i2][dt] = *(const bf16x8v*)(p + 4096 + (i2 * 4 + dt) * 512);
}
__device__ __forceinline__ void mfx_block8(const KVFrag8& f, int b, int tl, bool act, int tmin, int g, const long (&q8)[2], const LAS float* btab2, float& l, f32x4 (&o)[4], int q4, int c) {
    const int hh = c & 3; const float qs = 0.125f * 1.4426950408889634f;
    f32x4 s[4];
#pragma unroll
    for (int kt = 0; kt < 4; ++kt) { const long k0 = (long)(((unsigned long long)f.k[kt].y << 32) | f.k[kt].x), k1 = (long)(((unsigned long long)f.k[kt].w << 32) | f.k[kt].z);
        s[kt] = __builtin_amdgcn_mfma_f32_16x16x32_fp8_fp8(k0, q8[0], ((f32x4){0.f, 0.f, 0.f, 0.f}), 0, 0, 0); s[kt] = __builtin_amdgcn_mfma_f32_16x16x32_fp8_fp8(k1, q8[1], s[kt], 0, 0, 0); }
    const int pmax = b * 64 + 63;
    const bool far = (tmin - pmax >= 113);
    if (far) { const float bb = act ? btab2[113 * 8 + g * 4 + hh] : -1e30f;
#pragma unroll
        for (int kt = 0; kt < 4; ++kt)
#pragma unroll
            for (int j = 0; j < 4; ++j) s[kt][j] = fminf(s[kt][j] * qs + bb, 64.0f);
    } else {
#pragma unroll
        for (int kt = 0; kt < 4; ++kt)
#pragma unroll
            for (int j = 0; j < 4; ++j) { const int pos = b * 64 + 16 * kt + 4 * q4 + j; const bool ok = act && pos <= tl;
                int d = tl - pos; d = d < 0 ? 0 : (d > 113 ? 113 : d);
                const float bias = btab2[d * 8 + g * 4 + hh];
                s[kt][j] = ok ? fminf(s[kt][j] * qs + bias, 64.0f) : -1e30f; }
    }
#pragma unroll
    for (int kt = 0; kt < 4; ++kt)
#pragma unroll
        for (int j = 0; j < 4; ++j) { const float p = __builtin_amdgcn_exp2f(s[kt][j]); s[kt][j] = p; l += p; }
    bf16x8v pf[2];
#pragma unroll
    for (int i2 = 0; i2 < 2; ++i2) { v4u w; w.x = pg8::cvt_pk_bf16(s[2 * i2][0], s[2 * i2][1]); w.y = pg8::cvt_pk_bf16(s[2 * i2][2], s[2 * i2][3]); w.z = pg8::cvt_pk_bf16(s[2 * i2 + 1][0], s[2 * i2 + 1][1]); w.w = pg8::cvt_pk_bf16(s[2 * i2 + 1][2], s[2 * i2 + 1][3]);
        pf[i2] = __builtin_bit_cast(bf16x8v, w); }
#pragma unroll
    for (int dt = 0; dt < 4; ++dt) { o[dt] = MFMA16(f.vf[0][dt], pf[0], o[dt]); o[dt] = MFMA16(f.vf[1][dt], pf[1], o[dt]); }
}
#endif
template <int MODE, bool STASH, bool ACCUM = false>
__device__ __forceinline__ void mfx_branch(const bf16* KV, int nblk, int b0, const LAS int* sel, int tl, bool act, int tmin, int tmax, int g, const bf16x8v (&qf)[2],
                                           const LAS float* btab2, LAS float* wscr, float& l, f32x4 (&o)[4], int lane) {
    const int q4 = lane >> 4, c = lane & 15;
    LAS float* sc = (LAS float*)((LAS unsigned char*)wscr + AW_SC);
    if (!ACCUM) { l = 0.f;
#pragma unroll
        for (int dt = 0; dt < 4; ++dt) o[dt] = (f32x4){0.f, 0.f, 0.f, 0.f}; }
    for (int i = 0; i < nblk; ++i) { const int bA = MODE == 0 ? i : (MODE == 1 ? __builtin_amdgcn_readfirstlane(sel[i]) : b0 + i);
        KVFrag f0; kv_load<!STASH>(f0, KV, bA, g, lane); mfx_block<MODE, STASH>(f0, bA, tl, act, tmin, tmax, g, qf, btab2, sc, l, o, q4, c); }
    if (!ACCUM) { l += __shfl_xor(l, 16); l += __shfl_xor(l, 32); }
}
__device__ __forceinline__ void mfx_cmp_pv(const bf16* KV, int nblk, int g, const LAS float* wscr, bool act, f32x4 (&o)[4], int lane) {
    const int q4 = lane >> 4, c = lane & 15, hh = c & 3;
    const LAS float* sc = (const LAS float*)((const LAS unsigned char*)wscr + AW_SC);
    for (int b = 0; b < nblk; ++b) {
        const bf16* vp = KV + (size_t)(b * 2 + g) * 8192 + 4096 + lane * 8;
        bf16x8v vf[2][4];
#pragma unroll
        for (int i2 = 0; i2 < 2; ++i2)
#pragma unroll
            for (int dt = 0; dt < 4; ++dt) vf[i2][dt] = *(const bf16x8v*)(vp + (i2 * 4 + dt) * 512);
        float p[4][4];
#pragma unroll
        for (int kt = 0; kt < 4; ++kt)
#pragma unroll
            for (int j = 0; j < 4; ++j) { const float e = __builtin_amdgcn_exp2f(sc[(b * 64 + 16 * kt + 4 * q4 + j) * 4 + hh]); p[kt][j] = act ? e : 0.f; }
#pragma unroll
        for (int i2 = 0; i2 < 2; ++i2) { v4u w; w.x = pg8::cvt_pk_bf16(p[2 * i2][0], p[2 * i2][1]); w.y = pg8::cvt_pk_bf16(p[2 * i2][2], p[2 * i2][3]); w.z = pg8::cvt_pk_bf16(p[2 * i2 + 1][0], p[2 * i2 + 1][1]); w.w = pg8::cvt_pk_bf16(p[2 * i2 + 1][2], p[2 * i2 + 1][3]);
            const bf16x8v pf = __builtin_bit_cast(bf16x8v, w);
#pragma unroll
            for (int dt = 0; dt < 4; ++dt) o[dt] = MFMA16(vf[i2][dt], pf, o[dt]); }
    }
}
__device__ __forceinline__ void attn_prompt_pack(Frame& F, const Args& A, int t0, int g, LAS float* wscr, const LAS float* btab, bf16* yab) {
    const int lane = LANE(), q4 = lane >> 4, c = lane & 15, qc = c >> 2, tl = t0 + qc;
    const LAS float* btab2 = btab + 114 * 8;
    bf16x8v qf16[2];
    {   const float* qp = WSF(WS_QR) + (size_t)tl * 512 + (g * 4 + (c & 3)) * 64 + 8 * q4; const float qs = 0.125f * 1.4426950408889634f;
#pragma unroll
        for (int ks = 0; ks < 2; ++ks) { const f32x4 a = *(const f32x4*)(qp + 32 * ks), b = *(const f32x4*)(qp + 32 * ks + 4);
            v4u w; w.x = pk2(a.x * qs, a.y * qs); w.y = pk2(a.z * qs, a.w * qs); w.z = pk2(b.x * qs, b.y * qs); w.w = pk2(b.z * qs, b.w * qs);
            qf16[ks] = __builtin_bit_cast(bf16x8v, w); } }
#if SEL_FP8
    long q8[2];
    {   const float* qp = WSF(WS_QR) + (size_t)tl * 512 + (g * 4 + (c & 3)) * 64 + 8 * q4;
#pragma unroll
        for (int ks = 0; ks < 2; ++ks) { const f32x4 a = *(const f32x4*)(qp + 32 * ks), b = *(const f32x4*)(qp + 32 * ks + 4);
            int w0 = __builtin_amdgcn_cvt_pk_fp8_f32(a.x, a.y, 0, false); w0 = __builtin_amdgcn_cvt_pk_fp8_f32(a.z, a.w, w0, true);
            int w1 = __builtin_amdgcn_cvt_pk_fp8_f32(b.x, b.y, 0, false); w1 = __builtin_amdgcn_cvt_pk_fp8_f32(b.z, b.w, w1, true);
            q8[ks] = (long)(((unsigned long long)(unsigned)w1 << 32) | (unsigned)w0); } }
#endif
    const float* g3 = WSF(WS_GATE) + (size_t)tl * 24 + (g * 4 + (c & 3)) * 3;
    f32x4 of[4], o[4]; float l;
#pragma unroll
    for (int dt = 0; dt < 4; ++dt) of[dt] = (f32x4){0.f, 0.f, 0.f, 0.f};
    {
        const int bl = (t0 - 511) < 0 ? 0 : (t0 - 511) >> 6, bh = (t0 + 3) >> 6;
        mfx_branch<2, false>(WSB(WS_KVW), bh - bl + 1, bl, nullptr, tl, true, t0, t0 + 3, g, qf16, btab2, wscr, l, o, lane);
        if (l > 0.f) { const float sc_ = g3[2] / l;
#pragma unroll
            for (int dt = 0; dt < 4; ++dt) of[dt] += o[dt] * sc_; } }
    f32x4 os[4]; float ls = 0.f;
#pragma unroll
    for (int dt = 0; dt < 4; ++dt) os[dt] = (f32x4){0.f, 0.f, 0.f, 0.f};
    const int cur0 = t0 >> 6; const bool uni = cur0 == ((t0 + 3) >> 6); const int nf = uni ? (cur0 >= 2 ? 3 : cur0 + 1) : 0;
    for (int i = 0; i < nf; ++i) { const int b = i == 0 ? 0 : cur0 - (nf - 1 - i);
#if SEL_FP8
        KVFrag8 f; kv_load8(f, WSB(WS_KVS), b, g, lane); mfx_block8(f, b, tl, true, t0, g, q8, btab2, ls, os, q4, c); }
#else
        KVFrag f; kv_load<true>(f, WSB(WS_KVS), b, g, lane); mfx_block<1, false>(f, b, tl, true, t0, t0 + 3, g, qf16, btab2, nullptr, ls, os, q4, c); }
#endif
    LAS float* impq = (LAS float*)((LAS unsigned char*)wscr + AW_SC);
    const int nsbw = mfx_cmp_pack(WSB(WS_KVC), t0, tl, g, qf16, btab2, impq, l, o, lane);
    if (l > 0.f) { const float sc_ = g3[0] / l;
#pragma unroll
        for (int dt = 0; dt < 4; ++dt) of[dt] += o[dt] * sc_; }
#pragma unroll 1
    for (int qi = 0; qi < 4; ++qi) {
        const int t = t0 + qi, cur = t >> 6; const bool act = qc == qi;
        const int nsel = mf_select_lds(impq + qi * 256, nsbw, 256, cur, wscr, lane, uni, 16 - nf);
#if SEL_FP8
        {   const LAS int* sel = (const LAS int*)((LAS unsigned char*)wscr + AW_SEL);
            for (int i = 0; i < nsel; ++i) { const int bA = __builtin_amdgcn_readfirstlane(sel[i]); KVFrag8 f; kv_load8(f, WSB(WS_KVS), bA, g, lane); mfx_block8(f, bA, t, act, t, g, q8, btab2, ls, os, q4, c); } }
#else
        mfx_branch<1, false, true>(WSB(WS_KVS), nsel, 0, (const LAS int*)((LAS unsigned char*)wscr + AW_SEL), t, act, t, t, g, qf16, btab2, wscr, ls, os, lane);
#endif
        LDS_WAIT();
    }
    ls += __shfl_xor(ls, 16); ls += __shfl_xor(ls, 32);
    if (ls > 0.f) { const float sc_ = g3[1] / ls;
#pragma unroll
        for (int dt = 0; dt < 4; ++dt) of[dt] += os[dt] * sc_; }
    {   bf16* y = yab + (size_t)tl * D + 512 + (g * 4 + (c & 3)) * 64 + 4 * q4;
#pragma unroll
        for (int dt = 0; dt < 4; ++dt) *(v2u*)(y + 16 * dt) = (v2u){pk2(of[dt][0], of[dt][1]), pk2(of[dt][2], of[dt][3])}; }
}

template <bool SAMPLE>
__device__ __forceinline__ void cmp_mfma(Frame& F, const Args& A, int b, int pgp, float* kcs, float* vcs, int ks0 = 0, int ks1 = 64, LAS float* part = nullptr, int nparts = 1) {
    const int lane = LANE(), q4 = lane >> 4, r = lane & 15, pg2 = r >> 3, jj = (r >> 1) & 3, g = r & 1;
    const float* rowbase;
    if (SAMPLE) { const int phys = ((const int*)A.in[I_PT])[b * NPG + 2 * pgp + pg2]; rowbase = A.in[I_CKV] + ((size_t)(phys * 128 + 32 * jj) * 4) * 128 + g * 64 + 8 * q4; }
    else rowbase = F.out + O_KVP + (size_t)(32 * (8 * pgp + (r >> 1))) * 512 + g * 64 + 8 * q4;
    const bf16* wk = WSB(WS_WCT) + (size_t)r * 2048 + 8 * q4;
    const float* pek = A.in[I_PEK] + 8 * q4; const float* pev = A.in[I_PEV] + 8 * q4;
    f32x4 acc[2][4];
#pragma unroll
    for (int kv = 0; kv < 2; ++kv)
#pragma unroll
        for (int nt = 0; nt < 4; ++nt) acc[kv][nt] = (f32x4){0.f, 0.f, 0.f, 0.f};
#pragma unroll 2
    for (int ks = ks0; ks < ks1; ++ks) {
        const int i = ks >> 1, co = (ks & 1) * 32;
        const float* ap = rowbase + (size_t)i * 512 + co;
        const f32x4 k0 = *(const f32x4*)ap, k1 = *(const f32x4*)(ap + 4), v0 = *(const f32x4*)(ap + 128), v1 = *(const f32x4*)(ap + 132);
        const f32x4 pk0 = *(const f32x4*)(pek + i * 64 + co), pk1 = *(const f32x4*)(pek + i * 64 + co + 4), pv0 = *(const f32x4*)(pev + i * 64 + co), pv1 = *(const f32x4*)(pev + i * 64 + co + 4);
        bf16x8v bk[4], bv[4];
#pragma unroll
        for (int nt = 0; nt < 4; ++nt) { bk[nt] = *(const bf16x8v*)(wk + (size_t)nt * 16 * 2048 + ks * 32); bv[nt] = *(const bf16x8v*)(wk + (size_t)(64 + nt * 16) * 2048 + ks * 32); }
        const f32x4 a0 = k0 + pk0, a1 = k1 + pk1, c0 = v0 + pv0, c1 = v1 + pv1;
        const bf16x8v ak = __builtin_bit_cast(bf16x8v, ((v4u){pk2(a0.x, a0.y), pk2(a0.z, a0.w), pk2(a1.x, a1.y), pk2(a1.z, a1.w)}));
        const bf16x8v av = __builtin_bit_cast(bf16x8v, ((v4u){pk2(c0.x, c0.y), pk2(c0.z, c0.w), pk2(c1.x, c1.y), pk2(c1.z, c1.w)}));
#pragma unroll
        for (int nt = 0; nt < 4; ++nt) { acc[0][nt] = MFMA16(ak, bk[nt], acc[0][nt]); acc[1][nt] = MFMA16(av, bv[nt], acc[1][nt]); }
    }
    if (nparts > 1) {
        const int slot = ks0 / (ks1 - ks0);
        if (slot != 0) {
#pragma unroll
            for (int kv = 0; kv < 2; ++kv)
#pragma unroll
                for (int nt = 0; nt < 4; ++nt) *(LAS f32x4*)(part + ((slot - 1) * 8 + kv * 4 + nt) * 256 + lane * 4) = acc[kv][nt];
        }
        asm volatile("s_waitcnt vmcnt(0) lgkmcnt(0)" ::: "memory"); __syncthreads(); asm volatile("" ::: "memory");
        if (slot == 0)
        for (int sl = 0; sl < nparts - 1; ++sl)
#pragma unroll
            for (int kv = 0; kv < 2; ++kv)
#pragma unroll
                for (int nt = 0; nt < 4; ++nt) acc[kv][nt] += *(const LAS f32x4*)(part + (sl * 8 + kv * 4 + nt) * 256 + lane * 4);
    }
    if (nparts == 1 || ks0 == 0)
#pragma unroll
    for (int rg = 0; rg < 4; ++rg) { const int ro = 4 * q4 + rg, j = SAMPLE ? 4 * (2 * pgp + (ro >> 3)) + ((ro >> 1) & 3) : 8 * pgp + (ro >> 1), gg = ro & 1;
        float ss = 0.f;
#pragma unroll
        for (int nt = 0; nt < 4; ++nt) ss += acc[0][nt][rg] * acc[0][nt][rg];
        ss += __shfl_xor(ss, 1); ss += __shfl_xor(ss, 2); ss += __shfl_xor(ss, 4); ss += __shfl_xor(ss, 8);
        const float rstd = 1.0f / sqrtf(ss * (1.0f / 64.0f) + EPS);
        const size_t off = ((size_t)(b * 512 + j) * 2 + gg) * 64 + r;
#pragma unroll
        for (int nt = 0; nt < 4; ++nt) { const float kcv = acc[0][nt][rg] * rstd * A.in[I_KG][16 * nt + r], vcv = acc[1][nt][rg];
            kcs[off + 16 * nt] = kcv; vcs[off + 16 * nt] = vcv;
            bf16* tile = SAMPLE ? WSB(WS_KVCS) + (size_t)((b * 8 + (j >> 6)) * 2 + gg) * 8192 : WSB(WS_KVC) + (size_t)((j >> 6) * 2 + gg) * 8192;
            tile[kv_off_k(j & 63, 16 * nt + r)] = (bf16)f2bf(kcv); tile[kv_off_v(vt_slot(j & 63), 16 * nt + r)] = (bf16)f2bf(vcv); } }
}

__device__ __forceinline__ void cmp_sample2(Frame& F, const Args& A, int b, int pq, float* kcs, float* vcs, LAS float* wscr) {
    const int lane = LANE(), q4 = lane >> 4, r = lane & 15, pg2 = r >> 3, jj = (r >> 1) & 3, g = r & 1;
    {   f32x4 t[16];
#pragma unroll
        for (int j = 0; j < 8; ++j) { t[j] = ((const f32x4*)A.in[I_PEK])[lane + 64 * j]; t[8 + j] = ((const f32x4*)A.in[I_PEV])[lane + 64 * j]; }
#pragma unroll
        for (int j = 0; j < 16; ++j) *(LAS f32x4*)(wscr + (size_t)(lane + 64 * j) * 4) = t[j]; }
    LDS_WAIT();
    const float* rb0; const float* rb1;
    {   const int ph0 = ((const int*)A.in[I_PT])[b * NPG + 4 * pq + pg2], ph1 = ((const int*)A.in[I_PT])[b * NPG + 4 * pq + 2 + pg2];
        rb0 = A.in[I_CKV] + ((size_t)(ph0 * 128 + 32 * jj) * 4) * 128 + g * 64 + 8 * q4; rb1 = A.in[I_CKV] + ((size_t)(ph1 * 128 + 32 * jj) * 4) * 128 + g * 64 + 8 * q4; }
    const bf16* wk = WSB(WS_WCT) + (size_t)r * 2048 + 8 * q4;
    const LAS float* pel = wscr + 8 * q4;
    f32x4 acc[2][2][4];
#pragma unroll
    for (int s = 0; s < 2; ++s)
#pragma unroll
        for (int kv = 0; kv < 2; ++kv)
#pragma unroll
            for (int nt = 0; nt < 4; ++nt) acc[s][kv][nt] = (f32x4){0.f, 0.f, 0.f, 0.f};
#pragma unroll 2
    for (int ks = 0; ks < 64; ++ks) {
        const int i = ks >> 1, co = (ks & 1) * 32;
        const float* ap0 = rb0 + (size_t)i * 512 + co; const float* ap1 = rb1 + (size_t)i * 512 + co;
        const f32x4 k00 = *(const f32x4*)ap0, k01 = *(const f32x4*)(ap0 + 4), v00 = *(const f32x4*)(ap0 + 128), v01 = *(const f32x4*)(ap0 + 132);
        const f32x4 k10 = *(const f32x4*)ap1, k11 = *(const f32x4*)(ap1 + 4), v10 = *(const f32x4*)(ap1 + 128), v11 = *(const f32x4*)(ap1 + 132);
        bf16x8v bk[4], bv[4];
#pragma unroll
        for (int nt = 0; nt < 4; ++nt) { bk[nt] = *(const bf16x8v*)(wk + (size_t)nt * 16 * 2048 + ks * 32); bv[nt] = *(const bf16x8v*)(wk + (size_t)(64 + nt * 16) * 2048 + ks * 32); }
        const f32x4 pk0 = *(const LAS f32x4*)(pel + i * 64 + co), pk1 = *(const LAS f32x4*)(pel + i * 64 + co + 4), pv0 = *(const LAS f32x4*)(pel + 2048 + i * 64 + co), pv1 = *(const LAS f32x4*)(pel + 2048 + i * 64 + co + 4);
        f32x4 a0 = k00 + pk0, a1 = k01 + pk1, c0 = v00 + pv0, c1 = v01 + pv1;
        const bf16x8v ak0 = __builtin_bit_cast(bf16x8v, ((v4u){pk2(a0.x, a0.y), pk2(a0.z, a0.w), pk2(a1.x, a1.y), pk2(a1.z, a1.w)}));
        const bf16x8v av0 = __builtin_bit_cast(bf16x8v, ((v4u){pk2(c0.x, c0.y), pk2(c0.z, c0.w), pk2(c1.x, c1.y), pk2(c1.z, c1.w)}));
        a0 = k10 + pk0; a1 = k11 + pk1; c0 = v10 + pv0; c1 = v11 + pv1;
        const bf16x8v ak1 = __builtin_bit_cast(bf16x8v, ((v4u){pk2(a0.x, a0.y), pk2(a0.z, a0.w), pk2(a1.x, a1.y), pk2(a1.z, a1.w)}));
        const bf16x8v av1 = __builtin_bit_cast(bf16x8v, ((v4u){pk2(c0.x, c0.y), pk2(c0.z, c0.w), pk2(c1.x, c1.y), pk2(c1.z, c1.w)}));
#pragma unroll
        for (int nt = 0; nt < 4; ++nt) { acc[0][0][nt] = MFMA16(ak0, bk[nt], acc[0][0][nt]); acc[0][1][nt] = MFMA16(av0, bv[nt], acc[0][1][nt]);
                                         acc[1][0][nt] = MFMA16(ak1, bk[nt], acc[1][0][nt]); acc[1][1][nt] = MFMA16(av1, bv[nt], acc[1][1][nt]); }
    }
#pragma unroll
    for (int s = 0; s < 2; ++s) { const int pgp = 2 * pq + s;
#pragma unroll
    for (int rg = 0; rg < 4; ++rg) { const int ro = 4 * q4 + rg, j = 4 * (2 * pgp + (ro >> 3)) + ((ro >> 1) & 3), gg = ro & 1;
        float ss = 0.f;
#pragma unroll
        for (int nt = 0; nt < 4; ++nt) ss += acc[s][0][nt][rg] * acc[s][0][nt][rg];
        ss += __shfl_xor(ss, 1); ss += __shfl_xor(ss, 2); ss += __shfl_xor(ss, 4); ss += __shfl_xor(ss, 8);
        const float rstd = 1.0f / sqrtf(ss * (1.0f / 64.0f) + EPS);
        const size_t off = ((size_t)(b * 512 + j) * 2 + gg) * 64 + r;
#pragma unroll
        for (int nt = 0; nt < 4; ++nt) { const float kcv = acc[s][0][nt][rg] * rstd * A.in[I_KG][16 * nt + r], vcv = acc[s][1][nt][rg];
            kcs[off + 16 * nt] = kcv; vcs[off + 16 * nt] = vcv;
            bf16* tile = WSB(WS_KVCS) + (size_t)((b * 8 + (j >> 6)) * 2 + gg) * 8192;
            tile[kv_off_k(j & 63, 16 * nt + r)] = (bf16)f2bf(kcv); tile[kv_off_v(vt_slot(j & 63), 16 * nt + r)] = (bf16)f2bf(vcv); } } }
    LDS_WAIT();
}
__device__ __forceinline__ void build_win_sample(Frame& F, const Args& A, int b, int blk) {
    const int lane = LANE();
#pragma unroll 8
    for (int r = 0; r < 64; r += 2) { const int rr = r + (lane >> 5), kidx = blk * 64 + rr, l = lane & 31;
        const float* src = kidx < 511 ? A.in[I_CWIN] + ((size_t)b * 512 + kidx + 1) * 256 : SMP(SM_WNS) + (size_t)b * 256;
        const f32x4 v = *(const f32x4*)(src + l * 4);
        *(v2u*)(WSB(WS_KVWS) + (size_t)((b * 8 + blk) * 2 + (l >> 4)) * 8192 + kv_off_k(rr, 4 * (l & 15))) = (v2u){pk2(v.x, v.y), pk2(v.z, v.w)}; }
#pragma unroll 1
    for (int g = 0; g < 2; ++g) {
        unsigned pk[32];
#pragma unroll
        for (int s2 = 0; s2 < 32; ++s2) { const int s0 = 2 * s2, i2 = s0 >> 5, q = (s0 & 31) >> 3, j = s0 & 7; const int r0 = 32 * i2 + (j < 4 ? 4 * q + j : 16 + 4 * q + (j - 4));
            const int k0 = blk * 64 + r0, k1 = k0 + 1;
            const float* p0 = k0 < 511 ? A.in[I_CWIN] + ((size_t)b * 512 + k0 + 1) * 256 : SMP(SM_WNS) + (size_t)b * 256;
            const float* p1 = k1 < 511 ? A.in[I_CWIN] + ((size_t)b * 512 + k1 + 1) * 256 : SMP(SM_WNS) + (size_t)b * 256;
            pk[s2] = pk2(p0[128 + g * 64 + lane], p1[128 + g * 64 + lane]); }
        bf16* tile = WSB(WS_KVWS) + (size_t)((b * 8 + blk) * 2 + g) * 8192;
#pragma unroll
        for (int i = 0; i < 8; ++i) *(v4u*)(tile + kv_off_v(32 * (i >> 2) + 8 * (i & 3), lane)) = (v4u){pk[4 * i], pk[4 * i + 1], pk[4 * i + 2], pk[4 * i + 3]};
    }
}
__device__ __forceinline__ void attn_sample_mfma(Frame& F, const Args& A, int b, int g, LAS float* wscr, const LAS float* btab, float* yabs) {
    const int lane = LANE(), q4 = lane >> 4, c = lane & 15;
    bf16x8v qf[2];
    {   const float* qp = SMP(SM_QS) + (size_t)b * 512 + (g * 4 + (c & 3)) * 64 + 8 * q4;
#pragma unroll
        for (int ks = 0; ks < 2; ++ks) { const f32x4 a = *(const f32x4*)(qp + 32 * ks), bq = *(const f32x4*)(qp + 32 * ks + 4);
            v4u w; const float qs = 0.125f * 1.4426950408889634f; w.x = pk2(a.x * qs, a.y * qs); w.y = pk2(a.z * qs, a.w * qs); w.z = pk2(bq.x * qs, bq.y * qs); w.w = pk2(bq.z * qs, bq.w * qs);
            if (c >= 4) w = (v4u){0u, 0u, 0u, 0u};
            qf[ks] = __builtin_bit_cast(bf16x8v, w); } }
    const float* g3 = SMP(SM_GATES) + b * 24 + (g * 4 + (c & 3)) * 3;
    f32x4 of[4], o[4]; float l, lcmp = 0.f;
#pragma unroll
    for (int dt = 0; dt < 4; ++dt) of[dt] = (f32x4){0.f, 0.f, 0.f, 0.f};
    {   mf_branch<0, true>(WSB(WS_KVCS) + (size_t)b * 8 * 2 * 8192, 8, 0, nullptr, T, -1, g, qf, btab + 114 * 8, wscr, l, o, lane);
        LDS_WAIT();
        mf_cmp_pv(WSB(WS_KVCS) + (size_t)b * 8 * 2 * 8192, 8, g, wscr, o, lane);
        lcmp = l;
        if (l > 0.f) { const float sc_ = g3[0] / l;
#pragma unroll
            for (int dt = 0; dt < 4; ++dt) of[dt] += o[dt] * sc_; }
    }
    const int nsel = mf_select(512, 257, 256, wscr, lcmp, lane);
    {
        const LAS int* sel = (const LAS int*)((LAS unsigned char*)wscr + AW_SEL); LAS bf16* vt = (LAS bf16*)((LAS unsigned char*)wscr + AW_SC);
        const int* pt = (const int*)A.in[I_PT] + b * NPG;
        LAS f32x4* park = (LAS f32x4*)((LAS unsigned char*)wscr + 11264) + lane * 4;
#pragma unroll
        for (int dt = 0; dt < 4; ++dt) park[dt] = of[dt];
        l = 0.f;
#pragma unroll
        for (int dt = 0; dt < 4; ++dt) o[dt] = (f32x4){0.f, 0.f, 0.f, 0.f};
        for (int n = 0; n < nsel; ++n) {
            const int blk = __builtin_amdgcn_readfirstlane(sel[n]);
            KVFrag f;
            if (blk < 256) {
                const int phys = pt[blk >> 1]; const float* base = A.in[I_CKV] + ((size_t)(phys * 128 + (blk & 1) * 64) * 4 + 2) * 128 + g * 64;
                f32x4 ka[4][2][2], va[16];
#pragma unroll
                for (int kt = 0; kt < 4; ++kt)
#pragma unroll
                    for (int ks = 0; ks < 2; ++ks) { const float* kp = base + (size_t)(16 * kt + c) * 512 + 32 * ks + 8 * q4; ka[kt][ks][0] = *(const f32x4*)kp; ka[kt][ks][1] = *(const f32x4*)(kp + 4); }
#pragma unroll
                for (int i = 0; i < 16; ++i) va[i] = *(const f32x4*)(base + 128 + (size_t)(q4 + 4 * i) * 512 + 4 * c);
#pragma unroll
                for (int kt = 0; kt < 4; ++kt)
#pragma unroll
                    for (int ks = 0; ks < 2; ++ks) { const f32x4 x = ka[kt][ks][0], y = ka[kt][ks][1];
                        f.kf[kt][ks] = __builtin_bit_cast(bf16x8v, ((v4u){pk2(x.x, x.y), pk2(x.z, x.w), pk2(y.x, y.y), pk2(y.z, y.w)})); }
                LDS_WAIT();
#pragma unroll
                for (int i = 0; i < 16; ++i) { const int sl = vt_slot(q4 + 4 * i);
                    vt[(4 * c + 0) * 64 + sl] = (bf16)f2bf(va[i].x); vt[(4 * c + 1) * 64 + sl] = (bf16)f2bf(va[i].y); vt[(4 * c + 2) * 64 + sl] = (bf16)f2bf(va[i].z); vt[(4 * c + 3) * 64 + sl] = (bf16)f2bf(va[i].w); }
            } else {
                const float* nr = F.out + O_KVS + (size_t)b * 512 + 256 + g * 64;
#pragma unroll
                for (int kt = 0; kt < 4; ++kt)
#pragma unroll
                    for (int ks = 0; ks < 2; ++ks) { v4u w = (v4u){0u, 0u, 0u, 0u};
                        if (kt == 0 && c == 0) { const f32x4 x = *(const f32x4*)(nr + 32 * ks + 8 * q4), y = *(const f32x4*)(nr + 32 * ks + 8 * q4 + 4); w = (v4u){pk2(x.x, x.y), pk2(x.z, x.w), pk2(y.x, y.y), pk2(y.z, y.w)}; }
                        f.kf[kt][ks] = __builtin_bit_cast(bf16x8v, w); }
                LDS_WAIT();
                for (int i = lane; i < 64 * 32; i += 64) ((LAS unsigned*)vt)[i] = 0u;
                LDS_WAIT();
                vt[lane * 64 + vt_slot(0)] = (bf16)f2bf(nr[128 + lane]);
            }
            LDS_WAIT();
#pragma unroll
            for (int i2 = 0; i2 < 2; ++i2)
#pragma unroll
                for (int dt = 0; dt < 4; ++dt) f.vf[i2][dt] = *(const LAS bf16x8v*)(vt + (16 * dt + c) * 64 + 32 * i2 + 8 * q4);
            mf_block<1, false>(f, blk, T, -1, g, qf, btab + 114 * 8, nullptr, l, o, q4, c);
        }
        l += __shfl_xor(l, 16); l += __shfl_xor(l, 32);
        LDS_WAIT();
#pragma unroll
        for (int dt = 0; dt < 4; ++dt) of[dt] = park[dt];
        if (l > 0.f) { const float sc_ = g3[1] / l;
#pragma unroll
            for (int dt = 0; dt < 4; ++dt) of[dt] += o[dt] * sc_; } }
    {   mf_branch<2, false>(WSB(WS_KVWS) + (size_t)b * 8 * 2 * 8192, 8, 0, nullptr, 511, -1, g, qf, btab + 114 * 8, wscr, l, o, lane);
        if (l > 0.f) { const float sc_ = g3[2] / l;
#pragma unroll
            for (int dt = 0; dt < 4; ++dt) of[dt] += o[dt] * sc_; } }
    if (c < 4) { float* y = yabs + (size_t)b * D + 512 + (g * 4 + c) * 64 + 4 * q4; bf16* yb = SMB(SB_YABS) + (size_t)b * D + 512 + (g * 4 + c) * 64 + 4 * q4;
#pragma unroll
        for (int dt = 0; dt < 4; ++dt) { *(f32x4*)(y + 16 * dt) = of[dt]; if (yabs == SMP(SM_YABS)) *(v2u*)(yb + 16 * dt) = (v2u){pk2(of[dt][0], of[dt][1]), pk2(of[dt][2], of[dt][3])}; } }
}

__device__ __forceinline__ void p0_prologue(Frame& F, const Args& A) {
    LAS float* scr = (LAS float*)(F.lds + RING_OFF + F.wave * 16384);
    const int gw = F.vcu * NWAVES + F.wave, NGW = F.G * NWAVES, lane = LANE();
    constexpr int I_IN0 = 16 * 73, I_SQ = 16 * 32, I_UP = 16 * 128, I_DN = 64 * 32, I_PJ = 4 * 32, I_IN1 = 16 * 64;
    constexpr int I_CW = 32 * 2;
    constexpr int NITEMS = I_IN0 + I_SQ + 2 * I_UP + 2 * I_DN + 2 * I_SQ + 2 * I_PJ + I_IN1 + I_SQ + 2 * I_CW;
    for (int it = gw; it < NITEMS; it += NGW) {
        int r = it;
        if (r < I_IN0) { transpose_item(A.in[I_WINE], D, EIN, A.in[I_GMIX], WSB(WS_WIN0), scr, r, lane, true); continue; } r -= I_IN0;
        if (r < I_SQ) { transpose_item(A.in[I_WOUTE], D, D, nullptr, WSB(WS_WOUT0), scr, r, lane); continue; } r -= I_SQ;
        if (r < I_UP) { transpose_item(A.in[I_WUP], D, FF, A.in[I_GMLP], WSB(WS_WUP), scr, r, lane); continue; } r -= I_UP;
        if (r < I_UP) { transpose_item(A.in[I_WUP] + (size_t)D * FF, D, FF, A.in[I_GMLP] + D, WSB(WS_WUP) + (size_t)D * FF, scr, r, lane); continue; } r -= I_UP;
        if (r < I_DN) { transpose_item(A.in[I_WDOWN], FF, D, nullptr, WSB(WS_WDOWN), scr, r, lane); continue; } r -= I_DN;
        if (r < I_DN) { transpose_item(A.in[I_WDOWN] + (size_t)D * FF, FF, D, nullptr, WSB(WS_WDOWN) + (size_t)D * FF, scr, r, lane); continue; } r -= I_DN;
        if (r < I_SQ) { transpose_item(A.in[I_WPG], D, D, A.in[I_GPLE], WSB(WS_WGATE), scr, r, lane); continue; } r -= I_SQ;
        if (r < I_SQ) { transpose_item(A.in[I_WPG] + (size_t)D * D, D, D, A.in[I_GPLE] + D, WSB(WS_WGATE) + (size_t)D * D, scr, r, lane); continue; } r -= I_SQ;
        if (r < I_PJ) { transpose_item(A.in[I_WPP], PLE, D, nullptr, WSB(WS_WPROJ), scr, r, lane); continue; } r -= I_PJ;
        if (r < I_PJ) { transpose_item(A.in[I_WPP] + (size_t)PLE * D, PLE, D, nullptr, WSB(WS_WPROJ) + (size_t)PLE * D, scr, r, lane); continue; } r -= I_PJ;
        if (r < I_IN1) { transpose_item(A.in[I_WINO], D, 2 * D, A.in[I_GMIX] + D, WSB(WS_WIN1), scr, r, lane); continue; } r -= I_IN1;
        if (r < I_SQ) { transpose_item(A.in[I_WOUTO], D, D, nullptr, WSB(WS_WOUT1), scr, r, lane); continue; } r -= I_SQ;
        if (r < I_CW) { transpose_item(A.in[I_CWK], 2048, 64, nullptr, WSB(WS_WCT), scr, r, lane); continue; } r -= I_CW;
        transpose_item(A.in[I_CWV], 2048, 64, nullptr, WSB(WS_WCT) + (size_t)64 * 2048, scr, r, lane);
    }
    {
        v4u* z = (v4u*)(WSB(WS_WIN0) + (size_t)2336 * D); const int n16 = (EINP - 2336) * D * 2 / 16;
        for (int i = gw * 64 + lane; i < n16; i += NGW * 64) z[i] = (v4u){0u, 0u, 0u, 0u};
    }
    for (int m = 2 * gw; m < T; m += 2 * NGW) x_row2_to_bf16(lane, A.in[I_XP] + (size_t)m * D, WSB(WS_HBA) + (size_t)m * D, WSF(WS_RSA) + (size_t)m * 16);
    for (int m = 4 * gw; m < 2 * T; m += 4 * NGW) { f32x4 v[4];
#pragma unroll
        for (int i = 0; i < 4; ++i) v[i] = *((const f32x4*)(A.in[I_PP] + (size_t)(m + i) * PLE) + lane);
#pragma unroll
        for (int i = 0; i < 4; ++i) *((v2u*)(WSB(WS_PB) + (size_t)(m + i) * PLE) + lane) = (v2u){pk2(v[i].x, v[i].y), pk2(v[i].z, v[i].w)}; }
    for (int i = gw * 64 + lane; i < 8 * 128 * 128 / 4; i += NGW * 64) { const f32x4 v = ((const f32x4*)A.in[I_SGW])[i]; const int tt = (i >> 5) & 127, s0 = (i & 31) * 4;
        ((v2u*)WSB(WS_SGWB))[i] = (v2u){pk2(s0 <= tt ? v.x : 0.f, s0 + 1 <= tt ? v.y : 0.f), pk2(s0 + 2 <= tt ? v.z : 0.f, s0 + 3 <= tt ? v.w : 0.f)}; }
    for (int i = gw * 64 + lane; i < 2 * NS * PLE / 4; i += NGW * 64) { const f32x4 v = ((const f32x4*)A.in[I_PS])[i]; ((v2u*)SMB(SB_PS))[i] = (v2u){pk2(v.x, v.y), pk2(v.z, v.w)}; }
#if DBG_ZERO_OUT
    for (size_t i = (size_t)gw * 64 + lane; i < O_END / 4; i += (size_t)NGW * 64) ((f32x4*)F.out)[i] = (f32x4){0.f, 0.f, 0.f, 0.f};
#endif
    {
        LAS float* red = (LAS float*)(F.lds + RING_OFF); LAS float* rs = (LAS float*)(F.lds + RING_OFF + 16384);
        __syncthreads();
        sample_rstd(F, A.in[I_XS], rs);
        for (int ct = F.vcu; ct < (EIN + 15) / 16; ct += F.G) {
            const float s = sgemm16_f32w(F, A.in[I_XS], A.in[I_GMIX], A.in[I_WINE], EIN, ct, red);
            const int tid = TID(), r = SG_ROW(tid), n = 16 * ct + SG_COL(tid); if (n < EIN) SMP(SM_ZS)[(size_t)r * EIN + n] = s * rs[r];
        }
    }
}


__device__ __forceinline__ void sgu_item(Frame& F, const Args& A, int c, int g) {
    LAS bf16* vt = (LAS bf16*)(F.lds + RING_OFF);
    const int lane = LANE(), tid = TID();
    for (int idx = tid; idx < 128 * 32; idx += NWAVES * 64) { const int r = idx >> 5, q4 = (idx & 31) * 4; const size_t row = (size_t)c * 128 + r;
        const f32x4* lp = (const f32x4*)(WSF(WS_LNS) + row * 32); float s1 = 0.f, s2 = 0.f;
#pragma unroll
        for (int j = 0; j < 8; ++j) { const f32x4 x = lp[j]; s1 += x.x + x.z; s2 += x.y + x.w; }
        const float mu = s1 * (1.0f / 1024.0f), var = s2 * (1.0f / 1024.0f) - mu * mu, rstd = 1.0f / sqrtf(var + EPS);
        const int col = g * 128 + q4; const pg8::u32x2 vw = *(const pg8::u32x2*)(WSB(WS_V1) + row * D + col); const f32x4 v = {__uint_as_float(vw.x << 16), __uint_as_float(vw.x & 0xffff0000u), __uint_as_float(vw.y << 16), __uint_as_float(vw.y & 0xffff0000u)}, lg = *(const f32x4*)(A.in[I_LNG] + col), lb = *(const f32x4*)(A.in[I_LNB] + col);
        const f32x4 y = (v - mu) * rstd * lg + lb;
        vt[(q4 + 0) * 136 + r] = (bf16)f2bf(y.x); vt[(q4 + 1) * 136 + r] = (bf16)f2bf(y.y); vt[(q4 + 2) * 136 + r] = (bf16)f2bf(y.z); vt[(q4 + 3) * 136 + r] = (bf16)f2bf(y.w); }
    LDS_WAIT(); __syncthreads();
    const int r16 = lane & 15, q = lane >> 4, w = F.wave, nks = ((16 * w + 15) >> 5) + 1;
    const bf16* wp = WSB(WS_SGWB) + ((size_t)g * 128 + 16 * w + r16) * 128 + 8 * q;
    f32x4 acc[8];
#pragma unroll
    for (int nt = 0; nt < 8; ++nt) acc[nt] = (f32x4){0.f, 0.f, 0.f, 0.f};
    for (int ks = 0; ks < nks; ++ks) { const bf16x8s af = *(const bf16x8s*)(wp + 32 * ks);
#pragma unroll
        for (int nt = 0; nt < 8; ++nt) { const bf16x8s bfr = *(const LAS bf16x8s*)(vt + (16 * nt + r16) * 136 + 32 * ks + 8 * q); acc[nt] = __builtin_amdgcn_mfma_f32_16x16x32_bf16(af, bfr, acc[nt], 0, 0, 0); } }
#pragma unroll
    for (int rg = 0; rg < 4; ++rg) { const int t = 16 * w + 4 * q + rg; const float bb = A.in[I_SGB][g * 128 + t]; const size_t off = ((size_t)c * 128 + t) * D + g * 128 + r16;
#pragma unroll
        for (int nt = 0; nt < 8; ++nt) { const float u = __builtin_bit_cast(float, (unsigned)WSB(WS_U1)[off + 16 * nt] << 16); WSB(WS_YAB)[off + 16 * nt] = (bf16)f2bf(u * (acc[nt][rg] + bb)); } }
    __syncthreads();
}
__device__ __forceinline__ void sgu_sample(Frame& F, const Args& A, int b) {
    const int lane = LANE(); const float* v = SMP(SM_V1S) + (size_t)b * D; const float* u = SMP(SM_U1S) + (size_t)b * D;
    f32x4 x[4]; float s = 0.f;
#pragma unroll
    for (int j = 0; j < 4; ++j) { x[j] = *((const f32x4*)v + lane + 64 * j); s += pg8::sum4(x[j]); }
    const float mu = wave_sum(s) * (1.0f / D); float s2 = 0.f;
#pragma unroll
    for (int j = 0; j < 4; ++j) { x[j] = x[j] - mu; s2 += pg8::dot4(x[j]); }
    const float rstd = 1.0f / sqrtf(wave_sum(s2) * (1.0f / D) + EPS);
#pragma unroll
    for (int j = 0; j < 4; ++j) { const int col = (lane + 64 * j) * 4, g = col >> 7;
        const f32x4 vn = x[j] * rstd * *(const f32x4*)(A.in[I_LNG] + col) + *(const f32x4*)(A.in[I_LNB] + col);
        *(f32x4*)(F.out + O_VS + (size_t)b * D + col) = vn;
        const float w00 = A.in[I_SGW][(size_t)g * 128 * 128], b0 = A.in[I_SGB][g * 128];
        const f32x4 us = *(const f32x4*)(u + col) * (vn * w00 + b0);
        *(f32x4*)(SMP(SM_USS) + (size_t)b * D + col) = us; *(v2u*)(SMB(SB_USS) + (size_t)b * D + col) = (v2u){pk2(us.x, us.y), pk2(us.z, us.w)}; }
}

__global__ void __launch_bounds__(NWAVES * 64, 2) mega_fwd(Args args) {
    extern __shared__ __attribute__((aligned(16))) unsigned char lds[];
    Frame F;
    F.lds = (LAS unsigned char*)lds;
    F.MISC = (volatile LAS unsigned*)(F.lds + MISC_OFF);
    F.wave = __builtin_amdgcn_readfirstlane((int)threadIdx.x >> 6);
    F.G = gridDim.x; { const int bx = blockIdx.x; F.vcu = (F.G % 8 == 0) ? (bx % 8) * (F.G / 8) + bx / 8 : bx; }
    F.out = args.out; F.ws = args.ws;
    F.ctl = (gu32*)(args.ws + WS_CTL);
    for (int u = TID(); u < (LDS_BYTES - LDSCTL_OFF) / 4; u += NWAVES * 64) ((LAS unsigned*)(F.lds + LDSCTL_OFF))[u] = 0u;
    __syncthreads();
    XcdBarrier bar = xcd_barrier_post((unsigned*)(F.ctl + CW_BAR), F.MISC + 8);
    const int lo = args.ph_lo, hi = args.ph_hi;
#ifndef PHASE_MASK
#define PHASE_MASK 0xffffffffu
#endif
#define IN(k) (((PHASE_MASK >> (k)) & 1u) && lo <= (k) && (k) < hi)
#define BOTH(k) (IN(k) && IN((k) + 1))
#define GRID_BAR() xcd_barrier(bar)
    const int gw = F.vcu * NWAVES + F.wave, NGW = F.G * NWAVES;
#if DBG_TIME_PHASE >= 0
    unsigned long long ts_a = 0, ts_b = 0;
#define STAMP(k) do { if ((k) == DBG_TIME_PHASE) ts_a = __builtin_amdgcn_s_memrealtime(); if ((k) == DBG_TIME_PHASE + 1) ts_b = __builtin_amdgcn_s_memrealtime(); } while (0)
#else
#define STAMP(k) do {} while (0)
#endif
    STAMP(0);

    if (IN(0)) { p0_prologue(F, args); if (BOTH(0)) GRID_BAR(); }
    STAMP(1);

    if (IN(1)) {
        {
        const bool light = (F.G == 256) ? ((int)blockIdx.x >= 128) : true; const int lw = (F.G == 256) ? ((int)blockIdx.x - 128) * NWAVES + F.wave : gw, NLW = (F.G == 256) ? 128 * NWAVES : NGW;
        if (light && lw < NS) sample_post(F, args, lw);
        if (light)
        for (int it = lw * 4; it < NS * 511; it += NLW * 4) { f32x4 v[4];
#pragma unroll
            for (int i = 0; i < 4; ++i) { const int q = it + i < NS * 511 ? it + i : NS * 511 - 1, b = q / 511, r = q % 511; v[i] = *((const f32x4*)(args.in[I_CWIN] + ((size_t)b * 512 + r + 1) * 256) + LANE()); }
#pragma unroll
            for (int i = 0; i < 4; ++i) { const int q = it + i < NS * 511 ? it + i : NS * 511 - 1, b = q / 511, r = q % 511; *((f32x4*)(F.out + O_WINS + ((size_t)b * 512 + r) * 256) + LANE()) = v[i]; } }
        }
        if (F.G == 256 ? (int)blockIdx.x >= 128 : true) {
            LAS float* red1 = (LAS float*)(F.lds + RING_OFF); const int j0 = (F.G == 256) ? (int)blockIdx.x - 128 : (int)blockIdx.x, jn = (F.G == 256) ? 128 : F.G;
            for (int j = j0; j < 2 * (D / 16); j += jn) { const int l = j >> 6, ct = j & 63;
                const float s = sgemm16(F, SMB(SB_PS) + (size_t)l * NS * PLE, PLE, WSB(WS_WPROJ) + (size_t)l * PLE * D, ct, red1);
                const int tid = TID(), r = SG_ROW(tid), n = 16 * ct + SG_COL(tid); SMP(SM_PPS)[(l * NS + r) * D + n] = s; }
        }
        pg8::Gemm g{WSB(WS_HBA), WSB(WS_WIN0), T, EINP, D}; pg8::StaticOrder S; S.init(T, EINP, F.G, (int)blockIdx.x);
        pg8::EpiIn0 E{WSF(WS_RSA), WSB(WS_XA), WSB(WS_GG), WSF(WS_QR), F.out + O_KVP, WSF(WS_WINB), WSF(WS_GATE), args.in[I_QG], args.in[I_KG], WSB(WS_KVS), WSB(WS_KVW), F.out + O_WINP, F.out + O_CONVP, T};
        pg8::gemm_phase<pg8::EpiIn0, pg8::StaticOrder, PG8_ALIGN, PG8_SP2>(F.lds + RING_OFF, g, S, E, F.wave);
        if (F.G == 256 ? (int)blockIdx.x >= 128 : true) {
            __syncthreads();
            pg8::Gemm g2{WSB(WS_PB), WSB(WS_WPROJ), T, D, PLE}; pg8::StaticOrder S2;
            if (F.G == 256) S2.init(T, D, 128, (int)blockIdx.x - 128); else S2.init(T, D, F.G, (int)blockIdx.x);
            pg8::EpiProj E2{WSB(WS_PP)};
            pg8::gemm_phase<pg8::EpiProj, pg8::StaticOrder, PG8_ALIGN, PG8_SP2>(F.lds + RING_OFF, g2, S2, E2, F.wave);
        }
        if (BOTH(1)) GRID_BAR();
    }
    STAMP(2);

    const LAS float* btab = (const LAS float*)(F.lds + BTAB_OFF);
    {   for (int i = TID(); i < 114 * 8; i += NWAVES * 64) { const int n = i >> 3;
            int bk = n; if (n >= 16) { bk = 16 + (n >= 19) + (n >= 21) + (n >= 24) + (n >= 27) + (n >= 31) + (n >= 35) + (n >= 40) + (n >= 46) + (n >= 52) + (n >= 59) + (n >= 67) + (n >= 77) + (n >= 87) + (n >= 99) + (n >= 113); }
            const float bv = args.in[I_RELB][bk * 8 + (i & 7)]; ((LAS float*)(F.lds + BTAB_OFF))[i] = bv; ((LAS float*)(F.lds + BTAB_OFF))[114 * 8 + i] = bv * 1.4426950408889634f; }
        LDS_WAIT(); __syncthreads(); }
    LAS float* red = (LAS float*)(F.lds + RING_OFF); LAS float* rsl = (LAS float*)(F.lds + RING_OFF + 16384);

    if (IN(2)) {
        LAS float* wscr = (LAS float*)(F.lds + RING_OFF + F.wave * 16384);
#if DBG_SECT2 >= 0
        unsigned long long t2a = __builtin_amdgcn_s_memrealtime(), t2b; float t2v = 0.f;
#define SECT2(k) do { asm volatile("s_waitcnt vmcnt(0) lgkmcnt(0)" ::: "memory"); t2b = __builtin_amdgcn_s_memrealtime(); if ((k) == DBG_SECT2) t2v = (float)(t2b - t2a); t2a = t2b; } while (0)
#else
#define SECT2(k) do {} while (0)
#endif
#if CMPP_IMPL == 0
        for (int it = gw; it < 256; it += NGW) cmp_prompt_item(F, args, it >> 1, it & 1, wscr);
#elif CMPP_IMPL == 1
#if CMPP_SPLIT
        for (int it = F.vcu; it < 32; it += F.G) { cmp_mfma<false>(F, args, 0, 2 * it + (F.wave >> 2), WSF(WS_KC), WSF(WS_VC), (F.wave & 3) * 16, (F.wave & 3) * 16 + 16, (LAS float*)(F.lds + RING_OFF) + (F.wave >> 2) * 3 * 8 * 256, 4); __syncthreads(); }
#else
        for (int it = gw; it < 64; it += NGW) cmp_mfma<false>(F, args, 0, it, WSF(WS_KC), WSF(WS_VC));
#endif
#else
        for (int it = gw; it < 256; it += NGW) cmp_prompt_item(F, args, it >> 1, it & 1, wscr);
        for (int it = gw; it < 64; it += NGW) cmp_mfma<false>(F, args, 0, it, WSF(WS_U), WSF(WS_U) + 65536);
        GRID_BAR();
        {   float sd = 0.f, sr = 0.f;
            for (int i = gw * 64 + LANE(); i < 65536; i += NGW * 64) { const float a = WSF(WS_KC)[i], b = WSF(WS_U)[i], c = WSF(WS_VC)[i], d = WSF(WS_U)[65536 + i];
                sd += (a - b) * (a - b) + (c - d) * (c - d); sr += a * a + c * c; }
            sd = wave_sum(sd); sr = wave_sum(sr);
            if (LANE() == 0) { atomicAdd((float*)(F.ctl + 200), sd); atomicAdd((float*)(F.ctl + 264), sr); }
        }
#endif
        SECT2(0);
#if CMPS_IMPL == 1
        if (F.wave & 1) for (int it = gw >> 1; it < NS * NPG / 4; it += NGW / 2) cmp_sample2(F, args, it >> 5, it & 31, WSF(WS_KCS), WSF(WS_VCS), wscr);
#endif
        if (!(F.wave & 1)) for (int it = gw >> 1; it < 2048; it += NGW / 2) rg1_item(F, args, it >> 3, it & 7, wscr);
        SECT2(1);
#if !FUSE_HEADNORM
        for (int t = gw; t < T; t += NGW) head_norm_token(F, args, t);
#else
        if (!(F.wave & 1)) for (int t = 4 * (gw >> 1); t < T; t += 4 * (NGW / 2)) ktile_token4(F, args, t);
#endif
        SECT2(2);
        if (!(F.wave & 1)) for (int it = gw >> 1; it < 1024; it += NGW / 2) { const int w = it >> 9, b = (it >> 1) & 255, g = it & 1;
            if (w == 0) build_vt_block(F.out + O_KVP + (size_t)b * 64 * 512 + 384 + g * 64, 512, WSB(WS_KVS) + (size_t)(b * 2 + g) * 8192, LANE());
            else build_vt_block(WSF(WS_WINB) + (size_t)b * 64 * 256 + 128 + g * 64, 256, WSB(WS_KVW) + (size_t)(b * 2 + g) * 8192, LANE()); }
        SECT2(3);
        if (!(F.wave & 1)) for (int it = NGW / 2 - 1 - (gw >> 1); it < NS * 8; it += NGW / 2) build_win_sample(F, args, it >> 3, it & 7);
        SECT2(4);
#if CMPS_IMPL == 0
        __syncthreads();
        for (int it = F.vcu; it < NS * NPG; it += F.G) cmp_sample_item(F, args, it / NPG, it % NPG);
#elif CMPS_IMPL == 1
        (void)0;
#else
        __syncthreads();
        for (int it = F.vcu; it < NS * NPG; it += F.G) cmp_sample_item(F, args, it / NPG, it % NPG);
        for (int it = gw; it < NS * NPG / 2; it += NGW) cmp_mfma<true>(F, args, it >> 6, it & 63, WSF(WS_U), WSF(WS_U) + 4 * 1024 * 1024);
        GRID_BAR();
        {   float sd = 0.f, sr = 0.f;
            for (int i = gw * 64 + LANE(); i < 2 * 1024 * 1024; i += NGW * 64) { const float a = WSF(WS_KCS)[i], b = WSF(WS_U)[i], c = WSF(WS_VCS)[i], d = WSF(WS_U)[4 * 1024 * 1024 + i];
                sd += (a - b) * (a - b) + (c - d) * (c - d); sr += a * a + c * c; }
            sd = wave_sum(sd); sr = wave_sum(sr);
            if (LANE() == 0) { atomicAdd((float*)(F.ctl + 200), sd); atomicAdd((float*)(F.ctl + 264), sr); }
        }
#endif
        SECT2(5);
#if DBG_SECT2 >= 0
        if (gw == 0 && LANE() == 0) __hip_atomic_store((float*)(F.ctl + 328), exp2f(0.5f * rintf(2.0f * log2f(t2v + 1.0f))) * 1000.0f, RLX_AGENT);
#endif
        if (BOTH(2)) GRID_BAR();
    }
    STAMP(3);
    if (IN(3)) {
        LAS float* wscr = (LAS float*)(F.lds + RING_OFF + F.wave * 16384);
#if SATTN_IMPL == 0
        for (int it = gw; it < NS * 2; it += NGW) attn_sample_item(F, args, it >> 1, it & 1, wscr, btab);
#elif SATTN_IMPL == 1
        for (int it = gw; it < NS * 2; it += NGW) attn_sample_mfma(F, args, it >> 1, it & 1, wscr, btab, SMP(SM_YABS));
#else
        for (int it = gw; it < NS * 2; it += NGW) { attn_sample_item(F, args, it >> 1, it & 1, wscr, btab); attn_sample_mfma(F, args, it >> 1, it & 1, wscr, btab, WSF(WS_U));
            const int b = it >> 1, g = it & 1; float sd = 0.f, sr = 0.f;
            asm volatile("s_waitcnt vmcnt(0)" ::: "memory");
            for (int j = 0; j < 4; ++j) { const float a = __hip_atomic_load(SMP(SM_YABS) + (size_t)b * D + 512 + g * 256 + j * 64 + LANE(), RLX_AGENT), bb = __hip_atomic_load(WSF(WS_U) + (size_t)b * D + 512 + g * 256 + j * 64 + LANE(), RLX_AGENT); sd += (a - bb) * (a - bb); sr += a * a; }
            sd = wave_sum(sd); sr = wave_sum(sr);
            if (LANE() == 0) { atomicAdd((float*)(F.ctl + 200), sd); atomicAdd((float*)(F.ctl + 264), sr); } }
#endif
        for (int it = gw; it < 2048; it += NGW) rg3_item(F, args, it >> 3, it & 7);
#if ATTN_IMPL == 0
        for (int it = gw; it < 2 * T; it += NGW) attn_prompt_item(F, args, it >> 1, it & 1, wscr, btab);
#elif ATTN_IMPL == 1
#if DBG_SECT >= 0
        if (LANE() < 6) ((LAS unsigned long long*)((LAS unsigned char*)wscr + 16000))[LANE()] = 0ull;
        LDS_WAIT();
#endif
        {
            const int gq = (2 * gw) / NGW, wq = gw - gq * (NGW / 2);
#if ATTN_PACK == 2
            {   gu32* ctr = F.ctl + 384 + 64 * gq; (void)wq;
                int nxt = 0; if (LANE() == 0) nxt = (int)__hip_atomic_fetch_add(ctr, 1u, RLX_AGENT); nxt = __builtin_amdgcn_readfirstlane(nxt);
                while (nxt < T / 4) { const int i = nxt;
                    int nn = 0; if (LANE() == 0) nn = (int)__hip_atomic_fetch_add(ctr, 1u, RLX_AGENT);
                    const int j = i >> 1, t0 = (i & 1) ? 4 * j : T - 4 - 4 * j;
                    attn_prompt_pack(F, args, t0, gq, wscr, btab, WSB(WS_YAB));
                    nxt = __builtin_amdgcn_readfirstlane(nn); } }
#elif ATTN_PACK == 1
            for (int i = 0; i < 4; ++i) { const int t0 = (i & 2) ? T - 8 - wq * 8 + 4 * (i & 1) : wq * 8 + 4 * (i & 1); attn_prompt_pack(F, args, t0, gq, wscr, btab, WSB(WS_YAB)); }
#else
            for (int i = 0; i < 16; ++i) { const int ta = wq * 8 + (i >> 1), tq = (i & 1) ? T - 1 - ta : ta; attn_prompt_mfma(F, args, tq, gq, wscr, btab, WSB(WS_YAB)); }
#endif
        }
#else
        for (int it = gw; it < 2 * T; it += NGW) attn_prompt_item(F, args, it >> 1, it & 1, wscr, btab);
        for (int it = gw; it < 2 * (T / 4); it += NGW) attn_prompt_pack(F, args, (it >> 1) * 4, it & 1, wscr, btab, WSB(WS_U));
        GRID_BAR();
        {   float sd = 0.f, sr = 0.f;
            for (int t = gw; t < T; t += NGW) { const v4u a = *((const v4u*)(WSB(WS_YAB) + (size_t)t * D + 512) + LANE()), b = *((const v4u*)(WSB(WS_U) + (size_t)t * D + 512) + LANE());
#pragma unroll
                for (int j = 0; j < 4; ++j) { const float a0 = __builtin_bit_cast(float, a[j] << 16), a1 = __builtin_bit_cast(float, a[j] & 0xffff0000u), b0 = __builtin_bit_cast(float, b[j] << 16), b1 = __builtin_bit_cast(float, b[j] & 0xffff0000u);
                    sd += (a0 - b0) * (a0 - b0) + (a1 - b1) * (a1 - b1); sr += a0 * a0 + a1 * a1; } }
            sd = wave_sum(sd); sr = wave_sum(sr);
            if (LANE() == 0) { atomicAdd((float*)(F.ctl + 200), sd); atomicAdd((float*)(F.ctl + 264), sr); }
        }
#endif
#if DBG_SECT >= 0
        if (gw == 1000 && LANE() == 0) { const float tk = (float)((LAS unsigned long long*)((LAS unsigned char*)wscr + 16000))[DBG_SECT]; F.out[O_HP] = exp2f(0.25f * rintf(4.0f * log2f(tk + 1.0f))) * 1000.0f; }
#endif
        __syncthreads();
        if (BOTH(3)) GRID_BAR();
    }
    STAMP(4);
    if (IN(4)) {
        for (int ct = F.vcu; ct < D / 16; ct += F.G) { const float s = sgemm16(F, SMB(SB_YABS), D, WSB(WS_WOUT0), ct, red);
            const int tid = TID(), r = SG_ROW(tid), n = 16 * ct + SG_COL(tid); const float y = args.in[I_XS][r * D + n] + s; SMP(SM_YS0)[r * D + n] = y; SMB(SB_YS0)[r * D + n] = (bf16)f2bf(y); }
        pg8::Gemm g{WSB(WS_YAB), WSB(WS_WOUT0), T, D, D}; pg8::StaticOrder S; S.init(T, D, F.G, (int)blockIdx.x);
        pg8::EpiRes<true, false> E{nullptr, WSB(WS_HBA), F.out + O_YP, WSB(WS_HBB), WSF(WS_RSB)};
        pg8::gemm_phase<pg8::EpiRes<true, false>, pg8::StaticOrder, PG8_ALIGN, PG8_SP2>(F.lds + RING_OFF, g, S, E, F.wave);
        if (BOTH(4)) GRID_BAR();
    }
    STAMP(5);
#define MLP_PLE_PHASES(P, L, HB_IN, RS_IN, HB_MID, RS_MID, YS_IN, YSB_IN, YS_OUT, YSB_OUT, YS_OUT_LD)                                                                                   \
                                                                                                                                   \
    if (IN(P)) {                                                                                                                                                    \
        for (int ct = F.vcu; ct < FF / 16; ct += F.G) { const float s = sgemm16(F, YSB_IN, D, WSB(WS_WUP) + (size_t)(L) * D * FF, ct, red, YS_IN, rsl);                          \
            const int tid = TID(), r = SG_ROW(tid), n = 16 * ct + SG_COL(tid); const float z = s * rsl[r], zr = z > 0.f ? z : 0.f; SMB(SB_US)[r * FF + n] = (bf16)f2bf(zr * zr); } \
        __syncthreads();                                                                                                                                            \
        pg8::Gemm g{HB_IN, WSB(WS_WUP) + (size_t)(L) * D * FF, T, FF, D}; pg8::StaticOrder S; S.init(T, FF, F.G, (int)blockIdx.x);                                  \
        pg8::EpiUp E{RS_IN, WSB(WS_U)};                                                                                                                             \
        pg8::gemm_phase<pg8::EpiUp, pg8::StaticOrder, PG8_ALIGN, PG8_SP2>(F.lds + RING_OFF, g, S, E, F.wave);                                                               \
        if (BOTH(P)) GRID_BAR();                                                                                                                                    \
    } STAMP((P) + 1);                                                                                                                                                               \
                                                                                                                                     \
    if (IN((P) + 1)) {                                                                                                                                              \
        for (int ct = F.vcu; ct < D / 16; ct += F.G) { const float s = sgemm16(F, SMB(SB_US), FF, WSB(WS_WDOWN) + (size_t)(L) * D * FF, ct, red);                       \
            const int tid = TID(), r = SG_ROW(tid), n = 16 * ct + SG_COL(tid); const float y = YS_IN[r * D + n] + s; YS_IN[r * D + n] = y; YSB_IN[r * D + n] = (bf16)f2bf(y); } \
        pg8::Gemm g{WSB(WS_U), WSB(WS_WDOWN) + (size_t)(L) * D * FF, T, D, FF}; pg8::StaticOrder S; S.init(T, D, F.G, (int)blockIdx.x);                             \
        pg8::EpiRes<true, false> E{nullptr, HB_IN, F.out + O_YP, HB_MID, RS_MID};                                                                                                  \
        pg8::gemm_phase<pg8::EpiRes<true, false>, pg8::StaticOrder, PG8_ALIGN, PG8_SP2>(F.lds + RING_OFF, g, S, E, F.wave);                                                              \
        if (BOTH((P) + 1)) GRID_BAR();                                                                                                                              \
    } STAMP((P) + 2);                                                                                                                                                               \
                                                                                                      \
    if (IN((P) + 2)) {                                                                                                                                              \
        for (int ct = F.vcu; ct < D / 16; ct += F.G) {                                                                                                              \
            const float sg = sgemm16(F, YSB_IN, D, WSB(WS_WGATE) + (size_t)(L) * D * D, ct, red, YS_IN, rsl);                                                        \
            const int tid = TID(), r = SG_ROW(tid), n = 16 * ct + SG_COL(tid); const float sp = SMP(SM_PPS)[((L) * NS + r) * D + n];        \
            const float y = YS_IN[r * D + n] + sigmoidf_(sg * rsl[r]) * sp;                       \
            YS_OUT[(size_t)r * YS_OUT_LD + n] = y; YSB_OUT[r * D + n] = (bf16)f2bf(y); }                                                                             \
        __syncthreads();                                                                                                                                            \
        { pg8::Gemm g{HB_MID, WSB(WS_WGATE) + (size_t)(L) * D * D, T, D, D}; pg8::StaticOrder S; S.init(T, D, F.G, (int)blockIdx.x);                                \
          pg8::EpiGate<(L) == 1> E{RS_MID, WSB((L) == 0 ? WS_PP : WS_PP1), HB_MID, F.out + O_YP, HB_IN, RS_IN};                                                                                                  \
          pg8::gemm_phase<pg8::EpiGate<(L) == 1>, pg8::StaticOrder, PG8_ALIGN, PG8_SP2>(F.lds + RING_OFF, g, S, E, F.wave); }                                                         \
        if (BOTH((P) + 2)) GRID_BAR();                                                                                                                              \
    } STAMP((P) + 3);
    MLP_PLE_PHASES(5, 0, WSB(WS_HBB), WSF(WS_RSB), WSB(WS_HBA), WSF(WS_RSA), SMP(SM_YS0), SMB(SB_YS0), SMP(SM_YS1), SMB(SB_YS1), D)
    if (IN(8)) {
        for (int ct = F.vcu; ct < 2 * D / 16; ct += F.G) { const float s = sgemm16(F, SMB(SB_YS1), D, WSB(WS_WIN1), ct, red, SMP(SM_YS1), rsl);
            const int tid = TID(), r = SG_ROW(tid), n = 16 * ct + SG_COL(tid); const float z = gelu_tanh(s * rsl[r]); if (n < D) SMP(SM_U1S)[r * D + n] = z; else SMP(SM_V1S)[r * D + n - D] = z; }
        __syncthreads();
        pg8::Gemm g{WSB(WS_HBB), WSB(WS_WIN1), T, 2 * D, D}; pg8::StaticOrder S; S.init(T, 2 * D, F.G, (int)blockIdx.x);
        pg8::EpiIn1 E{WSF(WS_RSB), WSB(WS_U1), WSB(WS_V1), WSF(WS_LNS)};
        pg8::gemm_phase<pg8::EpiIn1, pg8::StaticOrder, PG8_ALIGN, PG8_SP2>(F.lds + RING_OFF, g, S, E, F.wave);
        if (BOTH(8)) GRID_BAR();
    }
    STAMP(9);
    if (IN(9)) {
        if (gw < NS) sgu_sample(F, args, gw);
        __syncthreads();
        for (int it = F.vcu; it < 128 * 8; it += F.G) sgu_item(F, args, it >> 3, it & 7);
        {
            pg8::Gemm g2{WSB(WS_PB) + (size_t)T * PLE, WSB(WS_WPROJ) + (size_t)PLE * D, T, D, PLE}; pg8::StaticOrder S2; S2.init(T, D, F.G, (int)blockIdx.x);
            pg8::EpiProj E2{WSB(WS_PP1)};
            pg8::gemm_phase<pg8::EpiProj, pg8::StaticOrder, PG8_ALIGN, PG8_SP2>(F.lds + RING_OFF, g2, S2, E2, F.wave);
        }
        if (BOTH(9)) GRID_BAR();
    }
    STAMP(10);
    if (IN(10)) {
        for (int ct = F.vcu; ct < D / 16; ct += F.G) { const float s = sgemm16(F, SMB(SB_USS), D, WSB(WS_WOUT1), ct, red);
            const int tid = TID(), r = SG_ROW(tid), n = 16 * ct + SG_COL(tid); const float y = SMP(SM_YS1)[r * D + n] + s; SMP(SM_YS1)[r * D + n] = y; SMB(SB_YS1)[r * D + n] = (bf16)f2bf(y); }
        pg8::Gemm g{WSB(WS_YAB), WSB(WS_WOUT1), T, D, D}; pg8::StaticOrder S; S.init(T, D, F.G, (int)blockIdx.x);
        pg8::EpiRes<true, false> E{nullptr, WSB(WS_HBB), F.out + O_YP, WSB(WS_HBA), WSF(WS_RSA)};
        pg8::gemm_phase<pg8::EpiRes<true, false>, pg8::StaticOrder, PG8_ALIGN, PG8_SP2>(F.lds + RING_OFF, g, S, E, F.wave);
        if (BOTH(10)) GRID_BAR();
    }
    STAMP(11);
    MLP_PLE_PHASES(11, 1, WSB(WS_HBA), WSF(WS_RSA), WSB(WS_HBB), WSF(WS_RSB), SMP(SM_YS1), SMB(SB_YS1), (F.out + O_YS), SMB(SB_YS0), D)
#if ATTN_IMPL == 2 || CMPS_IMPL == 2 || SATTN_IMPL == 2 || CMPP_IMPL == 2
    GRID_BAR();
    if (blockIdx.x == 0 && TID() == 0) { const float sd = __hip_atomic_load((float*)(F.ctl + 200), RLX_AGENT), sr = __hip_atomic_load((float*)(F.ctl + 264), RLX_AGENT); F.out[O_HP] = sqrtf(sd / sr) * 1.0e9f; }
#endif
#if DBG_SECT2 >= 0
    GRID_BAR();
    if (blockIdx.x == 0 && TID() == 0) F.out[O_HP] = __hip_atomic_load((float*)(F.ctl + 328), RLX_AGENT);
#endif
#if DBG_TIME_PHASE >= 0
    if (blockIdx.x == 0 && TID() == 0) { const float tk = (float)(ts_b - ts_a); const float q = exp2f(0.25f * (rintf(4.0f * log2f(tk) - 0.5f) + 0.5f)); F.out[O_HP] = q * 1000.0f; }
#endif
#if DBG_SCALE_MASK
    {
        GRID_BAR();
#define SCALE_REGION(o, lo_, hi_) if ((DBG_SCALE_MASK >> (o)) & 1) { for (size_t i = (lo_) + (size_t)gw * 64 + LANE(); i < (hi_); i += (size_t)NGW * 64) F.out[i] *= 4.0f; }
        SCALE_REGION(0, O_YP, O_YS) SCALE_REGION(1, O_YS, O_KVP) SCALE_REGION(2, O_KVP, O_KVS) SCALE_REGION(3, O_KVS, O_WINP) SCALE_REGION(4, O_WINP, O_WINS) SCALE_REGION(5, O_WINS, O_CONVP)
        SCALE_REGION(6, O_CONVP, O_CONVS) SCALE_REGION(7, O_CONVS, O_HP) SCALE_REGION(8, O_HP, O_HS) SCALE_REGION(9, O_HS, O_VS) SCALE_REGION(10, O_VS, O_END)
#undef SCALE_REGION
    }
#endif
#undef IN
#undef BOTH
}

extern "C" void kernel_launch(void* const* d_in, const int* in_sizes, int n_in, void* d_out, int out_size, void* d_ws, size_t ws_size, hipStream_t stream) {
    static int grid = 0;
    if (grid == 0) {
        if (n_in != N_IN || (size_t)out_size != O_END || ws_size < WS_END) { fprintf(stderr, "kernel_launch: unexpected sizes n_in %d out %d ws %zu\n", n_in, out_size, ws_size); grid = -1; return; }
        int dev = 0, cus = 0, per_cu = 0;
        if (hipGetDevice(&dev) != hipSuccess || hipDeviceGetAttribute(&cus, hipDeviceAttributeMultiprocessorCount, dev) != hipSuccess) { grid = -1; return; }
        if (hipFuncSetAttribute((const void*)mega_fwd, hipFuncAttributeMaxDynamicSharedMemorySize, LDS_BYTES) != hipSuccess) { grid = -1; return; }
        if (hipOccupancyMaxActiveBlocksPerMultiprocessor(&per_cu, (const void*)mega_fwd, NWAVES * 64, LDS_BYTES) != hipSuccess || per_cu < 1)
            fprintf(stderr, "kernel_launch: occupancy query reports %d workgroups per CU\n", per_cu);
        (void)hipGetLastError();
        grid = cus;
    }
    if (grid < 0) return;
    if (hipMemsetAsync((char*)d_ws + WS_CTL, 0, CTL_ZERO_BYTES, stream) != hipSuccess) return;
    Args a{};
    for (int i = 0; i < N_IN; ++i) a.in[i] = (const float*)d_in[i];
    a.out = (float*)d_out; a.ws = (unsigned char*)d_ws;
    a.ph_lo = 0; a.ph_hi = 64;
    hipLaunchKernelGGL(mega_fwd, dim3(grid), dim3(NWAVES * 64), LDS_BYTES, stream, a);
}
```
